# Optimizing an MI355X kernel written in HIP

```python
import jax, jax.numpy as jnp
from jax import lax
import numpy as np

D_MODEL = 2048
BATCH = 1
SEQ = 8192
DEPTH = 4

CHUNK = 64
N_A_LAYERS = DEPTH // 2
N_B_LAYERS = DEPTH - N_A_LAYERS
POOL_WINDOWS = (2, 4, 8, 16)
N_POOL_GROUPS = len(POOL_WINDOWS)
POOL_GROUP = D_MODEL // N_POOL_GROUPS
N_HEADS = 16
HEAD_DIM = D_MODEL // N_HEADS
LEFT_CHUNKS = 8
LEFT = LEFT_CHUNKS * CHUNK
BAND = (LEFT_CHUNKS + 1) * CHUNK
REL_MAX = 128
N_REL = (CHUNK - 1) + REL_MAX + 1
D_FF = 5504
EPS = 1e-6
NEG_INF = -1e30

kernel_name = "yoco_pool_chunked_relbias_macaron"


def rmsnorm(x, g):
    xf = x.astype(jnp.float32)
    y = xf * lax.rsqrt(jnp.mean(xf * xf, axis=-1, keepdims=True) + EPS)
    return (y * g.astype(jnp.float32)).astype(x.dtype)


def swiglu(h, w_gate, w_up, w_down):
    return (jax.nn.silu(h @ w_gate) * (h @ w_up)) @ w_down


def pool_mixer(h, w_pool, scale):
    B, S, D = h.shape
    hf = h.astype(jnp.float32).reshape(B, S, N_POOL_GROUPS, POOL_GROUP)
    cs = jnp.cumsum(hf, axis=1)
    t = jnp.arange(S)
    pooled = []
    for g, w in enumerate(POOL_WINDOWS):
        csg = cs[:, :, g]
        prev = jnp.pad(csg, ((0, 0), (w, 0), (0, 0)))[:, :S]
        cnt = jnp.minimum(t + 1, w).astype(jnp.float32)[None, :, None]
        pooled.append((csg - prev) / cnt)
    pooled = jnp.stack(pooled, axis=2)
    diff = (pooled - hf).astype(h.dtype)
    y = jnp.einsum('bsgc,gcd->bsgd', diff, w_pool).reshape(B, S, D)
    return y * scale


def head_rmsnorm(t, g):
    tf = t.astype(jnp.float32)
    y = tf * lax.rsqrt(jnp.mean(tf * tf, axis=-1, keepdims=True) + EPS)
    return (y * g.astype(jnp.float32)).astype(t.dtype)


def shared_kv(x, kv_norm, w_k, w_v, k_gain):
    B, S, _ = x.shape
    hk = rmsnorm(x, kv_norm)
    k = head_rmsnorm((hk @ w_k).reshape(B, S, N_HEADS, HEAD_DIM), k_gain)
    v = (hk @ w_v).reshape(B, S, N_HEADS, HEAD_DIM)
    pad = ((0, 0), (LEFT, 0), (0, 0), (0, 0))
    return jnp.pad(k, pad), jnp.pad(v, pad)


def chunked_attention(h, w_q, q_gain, rel_table, w_o, k_pad, v_pad):
    B, S, D = h.shape
    nc = S // CHUNK
    q = head_rmsnorm((h @ w_q).reshape(B, S, N_HEADS, HEAD_DIM), q_gain)
    qc = q.reshape(B, nc, CHUNK, N_HEADS, HEAD_DIM).transpose(1, 0, 2, 3, 4)
    r = jnp.arange(CHUNK)[:, None]
    m = jnp.arange(BAND)[None, :]
    rel = r - m + LEFT
    idx = jnp.clip(rel, -(CHUNK - 1), REL_MAX) + (CHUNK - 1)
    bias = rel_table.astype(jnp.float32)[:, idx]
    scale = HEAD_DIM ** -0.5
    key_off = jnp.arange(BAND)

    def one_chunk(args):
        q_blk, c = args
        start = c * CHUNK
        kb = lax.dynamic_slice_in_dim(k_pad, start, BAND, axis=1)
        vb = lax.dynamic_slice_in_dim(v_pad, start, BAND, axis=1)
        s = jnp.einsum('bqhd,bkhd->bhqk', q_blk.astype(jnp.float32), kb.astype(jnp.float32)) * scale
        s = s + bias[None]
        valid = (start + key_off) >= LEFT
        s = jnp.where(valid[None, None, None, :], s, NEG_INF)
        p = jax.nn.softmax(s, axis=-1)
        o = jnp.einsum('bhqk,bkhd->bqhd', p, vb.astype(jnp.float32))
        return o.astype(h.dtype)

    out = lax.map(one_chunk, (qc, jnp.arange(nc)))
    out = out.transpose(1, 0, 2, 3, 4).reshape(B, S, D)
    return out @ w_o


def setup_inputs(seed: int = 0) -> dict:
    key = jax.random.key(seed)
    ks = jax.random.split(key, 24)
    f32 = jnp.float32

    def nrm(k, shape, s):
        return jax.random.normal(k, shape, f32) * s

    def gain(k, shape):
        return jnp.ones(shape, f32) + 0.05 * jax.random.normal(k, shape, f32)

    return {
        "x": jax.random.normal(ks[0], (BATCH, SEQ, D_MODEL), f32),
        "ffn1_norm": gain(ks[1], (DEPTH, D_MODEL)),
        "ffn1_w_gate": nrm(ks[2], (DEPTH, D_MODEL, D_FF), D_MODEL ** -0.5),
        "ffn1_w_up": nrm(ks[3], (DEPTH, D_MODEL, D_FF), D_MODEL ** -0.5),
        "ffn1_w_down": nrm(ks[4], (DEPTH, D_FF, D_MODEL), D_FF ** -0.5),
        "mix_norm": gain(ks[5], (DEPTH, D_MODEL)),
        "ffn2_norm": gain(ks[6], (DEPTH, D_MODEL)),
        "ffn2_w_gate": nrm(ks[7], (DEPTH, D_MODEL, D_FF), D_MODEL ** -0.5),
        "ffn2_w_up": nrm(ks[8], (DEPTH, D_MODEL, D_FF), D_MODEL ** -0.5),
        "ffn2_w_down": nrm(ks[9], (DEPTH, D_FF, D_MODEL), D_FF ** -0.5),
        "pool_w": nrm(ks[10], (N_A_LAYERS, N_POOL_GROUPS, POOL_GROUP, POOL_GROUP), POOL_GROUP ** -0.5),
        "pool_scale": gain(ks[11], (N_A_LAYERS, D_MODEL)),
        "kv_norm": gain(ks[12], (D_MODEL,)),
        "w_k": nrm(ks[13], (D_MODEL, D_MODEL), D_MODEL ** -0.5),
        "w_v": nrm(ks[14], (D_MODEL, D_MODEL), D_MODEL ** -0.5),
        "k_gain": gain(ks[15], (HEAD_DIM,)),
        "w_q": nrm(ks[16], (N_B_LAYERS, D_MODEL, D_MODEL), D_MODEL ** -0.5),
        "q_gain": gain(ks[17], (N_B_LAYERS, HEAD_DIM)),
        "rel_bias": nrm(ks[18], (N_B_LAYERS, N_HEADS, N_REL), 0.5),
        "w_o": nrm(ks[19], (N_B_LAYERS, D_MODEL, D_MODEL), D_MODEL ** -0.5),
    }


def reference(x, ffn1_norm, ffn1_w_gate, ffn1_w_up, ffn1_w_down, mix_norm, ffn2_norm,
              ffn2_w_gate, ffn2_w_up, ffn2_w_down, pool_w, pool_scale, kv_norm, w_k, w_v,
              k_gain, w_q, q_gain, rel_bias, w_o):
    k_pad, v_pad = None, None
    for l in range(DEPTH):
        x = x + 0.5 * swiglu(rmsnorm(x, ffn1_norm[l]), ffn1_w_gate[l], ffn1_w_up[l], ffn1_w_down[l])
        h = rmsnorm(x, mix_norm[l])
        if l < N_A_LAYERS:
            x = x + pool_mixer(h, pool_w[l], pool_scale[l])
        else:
            b = l - N_A_LAYERS
            x = x + chunked_attention(h, w_q[b], q_gain[b], rel_bias[b], w_o[b], k_pad, v_pad)
        x = x + 0.5 * swiglu(rmsnorm(x, ffn2_norm[l]), ffn2_w_gate[l], ffn2_w_up[l], ffn2_w_down[l])
        if l == N_A_LAYERS - 1:
            k_pad, v_pad = shared_kv(x, kv_norm, w_k, w_v, k_gain)
    return x
```

```cpp
#include <hip/hip_runtime.h>
#include <hip/hip_bf16.h>
#include <cstdio>
#include <cstdint>

#ifndef MK_DEBUG
#define MK_DEBUG 0
#endif
#ifndef MK_PER_PHASE
#define MK_PER_PHASE MK_DEBUG
#endif

#ifndef PHMASK
#define PHMASK 0x3ff
#endif
#define PH_ON(k) (((PHMASK) >> (k)) & 1)
#ifndef MK_CLK
#define MK_CLK 0
#endif
#ifndef DUPMASK
#define DUPMASK 0
#endif
#define DUP_ON(k) (((DUPMASK) >> (k)) & 1)
#define DUP_LOOP(k) for (int rep_ = 0; rep_ < (DUP_ON(k) ? 2 : 1); ++rep_)
#define DUP3_LOOP(k) for (int rep_ = 0; rep_ < (DUP_ON(k) ? 3 : 1); ++rep_)
#define DUP3_BAR(k) if (DUP_ON(k) && rep_ < 2) GRID_BAR();
#define DUP3_SIGN (rep_ == 1 ? -1.0f : 1.0f)
#define DUP_BAR(k) if (DUP_ON(k) && rep_ == 0) GRID_BAR();
#define GAS __attribute__((address_space(1)))
#define LAS __attribute__((address_space(3)))
typedef unsigned short bf16_t;
typedef short bf16x8 __attribute__((ext_vector_type(8)));
typedef short s16x4 __attribute__((ext_vector_type(4)));
typedef float f32x4 __attribute__((ext_vector_type(4)));
typedef float f32x16 __attribute__((ext_vector_type(16)));
typedef unsigned u32x4 __attribute__((ext_vector_type(4)));
typedef unsigned u32x2 __attribute__((ext_vector_type(2)));
typedef GAS unsigned gu32;

constexpr int SEQ = 8192, DM = 2048, DFF = 5504, NH = 16, HD = 128, DEPTH = 4, NPOOL = 2, NATT = 2;
constexpr int NGU = 2 * DFF;
constexpr int NREL = 192;
#ifndef FP8_SETS
#define FP8_SETS 0x00
#endif
#ifndef FP8_O
#define FP8_O 1
#endif
#ifndef FP8_QKV
#define FP8_QKV 1
#endif
#ifndef FP8_D_SETS
#define FP8_D_SETS 0x80
#endif
#ifndef FP8_FIRST_LAYER
#define FP8_FIRST_LAYER 4
#endif
__host__ __device__ constexpr bool use8(int set) { return ((FP8_SETS >> set) & 1) != 0; }
__host__ __device__ constexpr bool use8d(int set) { return (((FP8_SETS | FP8_D_SETS) >> set) & 1) != 0; }
static_assert((FP8_D_SETS & ~0x80) == 0, "only the last half-step's down GEMM has an FP8-down code path");
static_assert(FP8_SETS == ((0xff << (2 * FP8_FIRST_LAYER)) & 0xff), "FP8_SETS = the sets of layers >= FP8_FIRST_LAYER");
constexpr int DFF8 = 5632;
constexpr float SO8 = 64.0f;
constexpr float SX8 = 0.25f, SWGU8 = 32.0f, SH8 = 8.0f, SWD8 = 64.0f;
constexpr float EPS = 1e-6f;
constexpr int NWAVES = 8;

constexpr size_t MiB = 1u << 20;
constexpr size_t WS_CTL = 0, CTL_ZERO_BYTES = 1 * MiB;
constexpr size_t WS_SSQ = 1 * MiB;
constexpr size_t WS_WGU = 2 * MiB;
constexpr size_t SZ_WGU = (size_t)NGU * DM * 2;
constexpr size_t WS_WD = WS_WGU + 8 * SZ_WGU;
constexpr size_t SZ_WD = (size_t)DM * DFF * 2;
constexpr size_t WS_WPOOL = WS_WD + 8 * SZ_WD;
constexpr size_t SZ_WPOOL = (size_t)4 * 512 * 512 * 2;
constexpr size_t WS_WKV = WS_WPOOL + 2 * SZ_WPOOL;
constexpr size_t WS_WQ = WS_WKV + (size_t)2 * DM * DM * 2;
constexpr size_t WS_WO = WS_WQ + (size_t)2 * DM * DM * 2;
constexpr size_t SZ_ACT = (size_t)SEQ * DM * 2;
constexpr size_t WS_XB = WS_WO + (size_t)2 * DM * DM * 2;
constexpr size_t WS_HB = WS_XB + SZ_ACT;
constexpr size_t WS_T1 = WS_HB + (size_t)SEQ * DFF * 2;
constexpr size_t WS_QH = WS_T1 + SZ_ACT;
constexpr size_t WS_KH = WS_QH + SZ_ACT;
constexpr size_t WS_VH = WS_KH + SZ_ACT;
constexpr size_t WS_XB8 = WS_VH + SZ_ACT;
constexpr size_t WS_H8 = WS_XB8 + (size_t)SEQ * DM;
constexpr size_t WS_END = WS_H8 + (size_t)SEQ * DFF8;
static_assert(SZ_WGU % 16 == 0 && SZ_WD % 16 == 0 && WS_XB % 256 == 0 && WS_HB % 256 == 0, "alignment");
constexpr int CW_TMO = 0, CW_CODE = 1;
constexpr int CW_BAR = 4096;

constexpr int RING_OFF = 0, RING_BYTES = 131072;
constexpr int LDSCTL_OFF = RING_BYTES, MISC_OFF = LDSCTL_OFF + 320;
constexpr int RSTD_OFF = 131584;
constexpr int HP_OFF = RSTD_OFF + 8192;
constexpr int LDS_BYTES = 155648;
static_assert(HP_OFF + 8192 <= LDS_BYTES && MISC_OFF + 128 <= RSTD_OFF, "LDS map");

#define RLX_AGENT __ATOMIC_RELAXED, __HIP_MEMORY_SCOPE_AGENT
#define LDS_WAIT() asm volatile("s_waitcnt lgkmcnt(0)" ::: "memory")
#define VM_WAIT() asm volatile("s_waitcnt vmcnt(0)" ::: "memory")
__device__ __forceinline__ unsigned f2bf(float f) { unsigned u = __builtin_bit_cast(unsigned, f); return (u + 0x7fffu + ((u >> 16) & 1u)) >> 16; }
__device__ __forceinline__ unsigned pk2(float lo, float hi) { return f2bf(lo) | (f2bf(hi) << 16); }
__device__ __forceinline__ unsigned cvt_pk_bf16(float lo, float hi) { unsigned r; asm volatile("v_cvt_pk_bf16_f32 %0, %1, %2" : "=v"(r) : "v"(lo), "v"(hi)); return r; }
__device__ __forceinline__ int lane_now() { int l; asm volatile("v_mbcnt_lo_u32_b32 %0, -1, 0\n\tv_mbcnt_hi_u32_b32 %0, -1, %0" : "=v"(l)); return l; }
__device__ __forceinline__ unsigned pk4_fp8(float a, float b, float c, float d) {
    a = __builtin_amdgcn_fmed3f(a, -448.f, 448.f); b = __builtin_amdgcn_fmed3f(b, -448.f, 448.f); c = __builtin_amdgcn_fmed3f(c, -448.f, 448.f); d = __builtin_amdgcn_fmed3f(d, -448.f, 448.f);
    int r = 0; r = __builtin_amdgcn_cvt_pk_fp8_f32(a, b, r, false); r = __builtin_amdgcn_cvt_pk_fp8_f32(c, d, r, true); return (unsigned)r; }
__device__ __forceinline__ int opaque_s(int x) { asm volatile("" : "+s"(x)); return x; }
__device__ __forceinline__ float xor16_add(float v) { return v + __builtin_bit_cast(float, __builtin_amdgcn_ds_swizzle(__builtin_bit_cast(int, v), 0x401F)); }
__device__ __forceinline__ float xor32_add(float v, int lane) { return v + __builtin_bit_cast(float, __builtin_amdgcn_ds_bpermute((lane ^ 32) << 2, __builtin_bit_cast(int, v))); }
__device__ __forceinline__ float xor1_get(float v) { return __builtin_bit_cast(float, __builtin_amdgcn_mov_dpp(__builtin_bit_cast(int, v), 0xB1, 0xF, 0xF, true)); }
__device__ __forceinline__ float wave_sum(float v, int lane) {
    v += __builtin_bit_cast(float, __builtin_amdgcn_ds_swizzle(__builtin_bit_cast(int, v), 0x041F));
    v += __builtin_bit_cast(float, __builtin_amdgcn_ds_swizzle(__builtin_bit_cast(int, v), 0x081F));
    v += __builtin_bit_cast(float, __builtin_amdgcn_ds_swizzle(__builtin_bit_cast(int, v), 0x101F));
    v += __builtin_bit_cast(float, __builtin_amdgcn_ds_swizzle(__builtin_bit_cast(int, v), 0x201F));
    v = xor16_add(v);
    return xor32_add(v, lane);
}

#ifndef PG8_ASM_DMA
#define PG8_ASM_DMA 1
#endif
namespace pg8 {
constexpr int BM = 256, BK = 64, HALF = 128, HTB = HALF * BK * 2, STAGE_BYTES = 8 * HTB, NXCD = 8, WGM = 4;
__host__ __device__ __forceinline__ int lds_byte(int r, int c) { const int st = (r >> 4) * 2 + (c >> 5), rr = r & 15, cc = c & 31, ob = rr * 64 + cc * 2; return st * 1024 + (ob ^ (((ob >> 9) & 1) << 5)); }
__host__ __device__ __forceinline__ void stage_rc(int b, int& R, int& C) { const int st = b / 1024, sb = b % 1024, swz = sb ^ (((sb >> 9) & 1) << 5); R = (st >> 1) * 16 + swz / 64; C = (st & 1) * 32 + (swz % 64) / 2; }
__host__ __device__ __forceinline__ int perm32(int rho) { const int n = rho >> 4, i = rho & 15; return 8 * (i >> 2) + 4 * n + (i & 3); }

struct Unit { int pm, pn; };
struct Gemm { const bf16_t* A; const bf16_t* Bt; int lda, ldb, K; };

struct StaticOrder {
    int nM, nN, nwg, G, c;
    __host__ __device__ void init(int M, int N, int G_, int c_) { nM = M / BM; nN = N / BM; nwg = nM * nN; G = G_; c = c_; }
    __host__ __device__ bool next(int i, Unit& u) const {
        const long L = (long)i * G + c; if (L >= nwg) return false;
        int wgid = (int)L; { const int q = nwg / NXCD, r = nwg % NXCD, xcd = wgid % NXCD, off = wgid / NXCD; wgid = (xcd < r ? xcd * (q + 1) : r * (q + 1) + (xcd - r) * q) + off; }
        const int nig = WGM * nN, gid = wgid / nig, fm = gid * WGM, gsz = (nM - fm) < WGM ? (nM - fm) : WGM;
        u.pm = fm + ((wgid % nig) % gsz); u.pn = (wgid % nig) / gsz; return true;
    }
};
struct PlainTiles {
    __device__ __forceinline__ size_t a_off(const Unit& u, int lda) const { return (size_t)u.pm * BM * lda; }
    __device__ __forceinline__ size_t b_off(const Unit& u, int ldb) const { return (size_t)u.pn * BM * ldb; }
};
struct PoolTiles {
    __device__ __forceinline__ size_t a_off(const Unit& u, int lda) const { return (size_t)u.pm * BM * lda + (size_t)(u.pn >> 1) * 512; }
    __device__ __forceinline__ size_t b_off(const Unit& u, int ldb) const { return (size_t)(u.pn >> 1) * 512 * 512 + (size_t)(u.pn & 1) * BM * ldb; }
};

typedef int i32x4v __attribute__((ext_vector_type(4)));
typedef int i32x8v __attribute__((ext_vector_type(8)));
__device__ __forceinline__ i32x8v cat8(bf16x8 a, bf16x8 b) { const i32x4v x = __builtin_bit_cast(i32x4v, a), y = __builtin_bit_cast(i32x4v, b); return __builtin_shufflevector(x, y, 0, 1, 2, 3, 4, 5, 6, 7); }
template <class Epi, class Tiles, bool F8 = false>
__device__ __forceinline__ void gemm_phase(LAS unsigned char* lds, int wave_id, const Gemm g, const StaticOrder& S, const Tiles& T, const Epi& E) {
    const int lane = lane_now(), wid = opaque_s(wave_id), tid = wid * 64 + lane, wr = wid >> 2, wc = wid & 3, fr = lane & 15, fq = lane >> 4;
    const int K = g.K, nt = K / BK;
    unsigned voffA[2], voffB[2];
#pragma unroll
    for (int i = 0; i < 2; ++i) { int R, C; stage_rc(tid * 16 + i * 8192, R, C); const int Rb = Epi::PERM ? ((R & ~31) + perm32(R & 31)) : R;
        voffA[i] = (unsigned)(R * g.lda + C) * 2u; voffB[i] = (unsigned)(Rb * g.ldb + C) * 2u; }
    const size_t kstep = (size_t)(BK * 2);
    const size_t hstepA = (size_t)HALF * g.lda * 2, hstepB = (size_t)HALF * g.ldb * 2;
    const unsigned ldsw = (unsigned)wid * 1024u;
    const unsigned lds_base32 = (unsigned)(size_t)lds;
    const int aoff = lds_byte(wr * 64 + fr, fq * 8), boff = lds_byte(wc * 32 + fr, fq * 8);
#define PG8_SA(b, h) (((b) * 2 + (h)) * HTB)
#define PG8_SB(b, h) ((4 + (b) * 2 + (h)) * HTB)
#define PG8_STAGE(bufoff, gbase, voff) do { if constexpr (F8 || PG8_ASM_DMA) { _Pragma("unroll") for (int _i = 0; _i < 2; ++_i) { unsigned _keep; \
        asm volatile("s_mov_b32 %0, m0\n\ts_mov_b32 m0, %3\n\ts_nop 0\n\tglobal_load_lds_dwordx4 %1, %2\n\ts_mov_b32 m0, %0" : "=&s"(_keep) : "v"((voff)[_i]), "s"((const char*)(gbase)), "s"(lds_base32 + (unsigned)(bufoff) + ldsw + (unsigned)(_i * 8192)) : "memory"); } } \
    else { _Pragma("unroll") for (int _i = 0; _i < 2; ++_i) \
        __builtin_amdgcn_global_load_lds((const unsigned*)((const char*)(gbase) + (voff)[_i]), (LAS unsigned*)(lds + (bufoff) + ldsw + _i * 8192), 16, 0, 0); } } while (0)
#define PG8_LDA(dst, b, h) do { if constexpr (F8) { _Pragma("unroll") for (int m = 0; m < 4; ++m) dst##_8[m] = cat8(*(const LAS bf16x8*)(lds + PG8_SA(b, h) + aoff + m * 2048), *(const LAS bf16x8*)(lds + PG8_SA(b, h) + aoff + m * 2048 + 1024)); } \
        else { _Pragma("unroll") for (int m = 0; m < 4; ++m) _Pragma("unroll") for (int k = 0; k < 2; ++k) dst[m][k] = *(const LAS bf16x8*)(lds + PG8_SA(b, h) + aoff + m * 2048 + k * 1024); } } while (0)
#define PG8_LDB(dst, b, h) do { if constexpr (F8) { _Pragma("unroll") for (int n = 0; n < 2; ++n) dst##_8[n] = cat8(*(const LAS bf16x8*)(lds + PG8_SB(b, h) + boff + n * 2048), *(const LAS bf16x8*)(lds + PG8_SB(b, h) + boff + n * 2048 + 1024)); } \
        else { _Pragma("unroll") for (int n = 0; n < 2; ++n) _Pragma("unroll") for (int k = 0; k < 2; ++k) dst[n][k] = *(const LAS bf16x8*)(lds + PG8_SB(b, h) + boff + n * 2048 + k * 1024); } } while (0)
#define PG8_MMA(ai, bj, At, Bt) do { __builtin_amdgcn_s_setprio(1); if constexpr (F8) { _Pragma("unroll") for (int m = 0; m < 4; ++m) _Pragma("unroll") for (int n = 0; n < 2; ++n) \
        acc[ai][bj][m][n] = __builtin_amdgcn_mfma_scale_f32_16x16x128_f8f6f4(Bt##_8[n], At##_8[m], acc[ai][bj][m][n], 0, 0, 0, 0x7F7F7F7F, 0, 0x7F7F7F7F); } \
        else { _Pragma("unroll") for (int m = 0; m < 4; ++m) _Pragma("unroll") for (int n = 0; n < 2; ++n) _Pragma("unroll") for (int k = 0; k < 2; ++k) \
        acc[ai][bj][m][n] = __builtin_amdgcn_mfma_f32_16x16x32_bf16(Bt[n][k], At[m][k], acc[ai][bj][m][n], 0, 0, 0); } __builtin_amdgcn_s_setprio(0); } while (0)
#define PG8_WAIT_V(n) asm volatile("s_waitcnt vmcnt(" #n ")" ::: "memory")
#define PG8_WAIT_L(n) asm volatile("s_waitcnt lgkmcnt(" #n ")" ::: "memory")
#define PG8_BAR __builtin_amdgcn_s_barrier()
#define PG8_SCHED __builtin_amdgcn_sched_barrier(0)
    Unit cur, nxt; int ui = 0;
    if (!S.next(0, cur)) return;
    f32x4 acc[2][2][4][2];
#pragma unroll
    for (int a = 0; a < 2; ++a)
#pragma unroll
        for (int b = 0; b < 2; ++b)
#pragma unroll
            for (int m = 0; m < 4; ++m)
#pragma unroll
                for (int n = 0; n < 2; ++n) acc[a][b][m][n] = (f32x4){0.f, 0.f, 0.f, 0.f};
    bf16x8 At[4][2], B0[2][2], B1[2][2];
    i32x8v At_8[4], B0_8[2], B1_8[2];
    const char* cA = (const char*)(g.A + T.a_off(cur, g.lda)); const char* cB = (const char*)(g.Bt + T.b_off(cur, g.ldb));
    PG8_STAGE(PG8_SB(0, 0), cB, voffB); PG8_STAGE(PG8_SB(0, 1), cB + hstepB, voffB); PG8_STAGE(PG8_SA(0, 0), cA, voffA); PG8_STAGE(PG8_SA(0, 1), cA + hstepA, voffA);
    if (wr == 1) PG8_BAR;
    PG8_WAIT_V(2); PG8_BAR;
    PG8_STAGE(PG8_SB(1, 0), cB + kstep, voffB); PG8_STAGE(PG8_SA(1, 0), cA + kstep, voffA); PG8_STAGE(PG8_SB(1, 1), cB + hstepB + kstep, voffB);
    PG8_WAIT_V(6); PG8_BAR;
    for (;;) {
        const bool has_next = S.next(ui + 1, nxt);
        const char* nA = has_next ? (const char*)(g.A + T.a_off(nxt, g.lda)) : cA; const char* nB = has_next ? (const char*)(g.Bt + T.b_off(nxt, g.ldb)) : cB;
        for (int t = 0; t < nt; t += 2) {
            const bool last = (t == nt - 2);
            const char* a1 = cA + (size_t)(t + 1) * kstep;
            const char* a2 = last ? nA : cA + (size_t)(t + 2) * kstep; const char* b2 = last ? nB : cB + (size_t)(t + 2) * kstep;
            const char* a3 = a2 + kstep; const char* b3 = b2 + kstep;
            PG8_LDB(B0, 0, 0); PG8_LDB(B1, 0, 1); PG8_SCHED; PG8_LDA(At, 0, 0); PG8_STAGE(PG8_SA(1, 1), a1 + hstepA, voffA);
            PG8_WAIT_V(8); PG8_WAIT_L(0); PG8_BAR; PG8_MMA(0, 0, At, B0); PG8_MMA(0, 1, At, B1); PG8_BAR; PG8_SCHED;
            PG8_LDA(At, 0, 1); PG8_STAGE(PG8_SB(0, 0), b2, voffB); PG8_STAGE(PG8_SB(0, 1), b2 + hstepB, voffB); PG8_STAGE(PG8_SA(0, 0), a2, voffA);
            PG8_WAIT_V(8); PG8_WAIT_L(0); PG8_BAR; PG8_MMA(1, 0, At, B0); PG8_MMA(1, 1, At, B1); PG8_BAR; PG8_SCHED;
            PG8_LDB(B0, 1, 0); PG8_LDB(B1, 1, 1); PG8_SCHED; PG8_LDA(At, 1, 0); PG8_STAGE(PG8_SA(0, 1), a2 + hstepA, voffA);
            PG8_WAIT_V(8); PG8_WAIT_L(0); PG8_BAR; PG8_MMA(0, 0, At, B0); PG8_MMA(0, 1, At, B1); PG8_BAR; PG8_SCHED;
            PG8_LDA(At, 1, 1); PG8_STAGE(PG8_SB(1, 0), b3, voffB); PG8_STAGE(PG8_SB(1, 1), b3 + hstepB, voffB); PG8_STAGE(PG8_SA(1, 0), a3, voffA);
            PG8_WAIT_V(8); PG8_WAIT_L(0); PG8_BAR; PG8_MMA(1, 0, At, B0); PG8_MMA(1, 1, At, B1); PG8_BAR; PG8_SCHED;
        }
        if (Epi::ALIGN) { if (wr == 0) PG8_BAR; }
        E(acc, cur, ui, wr, wc, fr, fq, lds);
        if (!Epi::ALIGN) { if (wr == 0) PG8_BAR; }
        if (!has_next) break;
#pragma unroll
        for (int a = 0; a < 2; ++a)
#pragma unroll
            for (int b = 0; b < 2; ++b)
#pragma unroll
                for (int m = 0; m < 4; ++m)
#pragma unroll
                    for (int n = 0; n < 2; ++n) acc[a][b][m][n] = (f32x4){0.f, 0.f, 0.f, 0.f};
        cur = nxt; cA = nA; cB = nB; ++ui;
        if (wr == 1) PG8_BAR;
    }
    PG8_WAIT_V(0);
    PG8_BAR;
#undef PG8_SA
#undef PG8_SB
#undef PG8_STAGE
#undef PG8_LDA
#undef PG8_LDB
#undef PG8_MMA
#undef PG8_WAIT_V
#undef PG8_WAIT_L
#undef PG8_BAR
#undef PG8_SCHED
}

__device__ __forceinline__ float silu_mul(float g, float u) {
    const float e = __builtin_amdgcn_exp2f(g * -1.4426950408889634f);
    return g * u * __builtin_amdgcn_rcpf(1.0f + e);
}
__device__ __forceinline__ f32x4 swiglu4(const f32x4 g, const f32x4 u, float c1, float rs2) {
    const f32x4 t = g * c1;
    f32x4 e = {__builtin_amdgcn_exp2f(t[0]), __builtin_amdgcn_exp2f(t[1]), __builtin_amdgcn_exp2f(t[2]), __builtin_amdgcn_exp2f(t[3])};
    e = e + 1.0f;
    const f32x4 r = {__builtin_amdgcn_rcpf(e[0]), __builtin_amdgcn_rcpf(e[1]), __builtin_amdgcn_rcpf(e[2]), __builtin_amdgcn_rcpf(e[3])};
    return ((g * u) * rs2) * r;
}
struct EpiSwiGLU {
    static constexpr bool PERM = true, ALIGN = false;
    bf16_t* H; unsigned char* H8; float desc;
    __device__ __forceinline__ void operator()(const f32x4 (&acc)[2][2][4][2], const Unit& u, int ui, int wr, int wc, int fr, int fq, LAS unsigned char* lds) const {
        const LAS float* tab = (const LAS float*)(lds + RSTD_OFF) + ui * 256;
        int fr_ = fr; asm volatile("" : "+v"(fr_));
        const int rl0 = wr * 64 + fr_, col0 = u.pn * 128 + wc * 32 + 8 * fq;
#pragma unroll
        for (int ai = 0; ai < 2; ++ai)
#pragma unroll
            for (int m = 0; m < 4; ++m) {
                const int rl = ai * HALF + rl0 + m * 16; const float rs = tab[rl] * desc;
                const float c1 = rs * -1.4426950408889634f, rs2 = (rs * rs) * (H8 ? SH8 : 1.0f);
                const f32x4 h0 = swiglu4(acc[ai][0][m][0], acc[ai][1][m][0], c1, rs2), h1 = swiglu4(acc[ai][0][m][1], acc[ai][1][m][1], c1, rs2);
                if (H8) {
                    u32x2 w8; w8.x = pk4_fp8(h0[0], h0[1], h0[2], h0[3]); w8.y = pk4_fp8(h1[0], h1[1], h1[2], h1[3]);
                    *(u32x2*)(H8 + (size_t)(u.pm * BM + rl) * DFF8 + col0) = w8;
                } else {
                    u32x4 w;
                    w.x = cvt_pk_bf16(h0[0], h0[1]); w.y = cvt_pk_bf16(h0[2], h0[3]); w.z = cvt_pk_bf16(h1[0], h1[1]); w.w = cvt_pk_bf16(h1[2], h1[3]);
                    *(u32x4*)(H + (size_t)(u.pm * BM + rl) * DFF + col0) = w;
                }
            }
    }
};
__device__ __forceinline__ f32x4 bf4_lo(unsigned a, unsigned b) { return (f32x4){__builtin_bit_cast(float, a << 16), __builtin_bit_cast(float, a & 0xffff0000u), __builtin_bit_cast(float, b << 16), __builtin_bit_cast(float, b & 0xffff0000u)}; }
struct EpiRes {
    static constexpr bool PERM = true, ALIGN = false;
    const bf16_t* baseb; const float* basef; bf16_t* xb; float* outf; float* ssq; const float* cscale; float alpha; unsigned char* xb8;
    __device__ __forceinline__ void operator()(const f32x4 (&acc)[2][2][4][2], const Unit& u, int ui, int wr, int wc, int fr, int fq, LAS unsigned char* lds) const {
        const int ln_ = lane_now(), fr_ = ln_ & 15, fq_ = ln_ >> 4;
        const int rl0 = wr * 64 + fr_, col0 = u.pn * BM + wc * 32 + 8 * fq_;
        f32x4 cs[2][2];
        const float al = __builtin_bit_cast(float, opaque_s(__builtin_bit_cast(int, alpha)));
#pragma unroll
        for (int bj = 0; bj < 2; ++bj)
#pragma unroll
            for (int n = 0; n < 2; ++n) { cs[bj][n] = cscale ? *(const f32x4*)(cscale + col0 + bj * HALF + n * 4) * al : (f32x4){al, al, al, al}; }
#pragma unroll
        for (int ai = 0; ai < 2; ++ai)
#pragma unroll
            for (int m = 0; m < 4; ++m) {
                const int row = u.pm * BM + ai * HALF + rl0 + m * 16; const size_t off = (size_t)row * DM + col0; float ss = 0.f;
#pragma unroll
                for (int bj = 0; bj < 2; ++bj) {
                    f32x4 b0, b1;
                    if (basef) { b0 = *(const f32x4*)(basef + off + bj * HALF); b1 = *(const f32x4*)(basef + off + bj * HALF + 4); }
                    else { const u32x4 w = *(const u32x4*)(baseb + off + bj * HALF); b0 = bf4_lo(w.x, w.y); b1 = bf4_lo(w.z, w.w); }
                    const f32x4 o0 = b0 + acc[ai][bj][m][0] * cs[bj][0], o1 = b1 + acc[ai][bj][m][1] * cs[bj][1];
                    if (outf) { *(f32x4*)(outf + off + bj * HALF) = o0; *(f32x4*)(outf + off + bj * HALF + 4) = o1; }
                    u32x4 r; r.x = cvt_pk_bf16(o0[0], o0[1]); r.y = cvt_pk_bf16(o0[2], o0[3]); r.z = cvt_pk_bf16(o1[0], o1[1]); r.w = cvt_pk_bf16(o1[2], o1[3]);
                    *(u32x4*)(xb + off + bj * HALF) = r;
                    if (xb8) { u32x2 r8; r8.x = pk4_fp8(o0[0] * SX8, o0[1] * SX8, o0[2] * SX8, o0[3] * SX8); r8.y = pk4_fp8(o1[0] * SX8, o1[1] * SX8, o1[2] * SX8, o1[3] * SX8); *(u32x2*)(xb8 + off + bj * HALF) = r8; }
                    const f32x4 v0 = bf4_lo(r.x, r.y), v1 = bf4_lo(r.z, r.w);
                    ss += ((v0[0] * v0[0] + v0[1] * v0[1]) + (v0[2] * v0[2] + v0[3] * v0[3])) + ((v1[0] * v1[0] + v1[1] * v1[1]) + (v1[2] * v1[2] + v1[3] * v1[3]));
                }
                ss = xor16_add(ss); ss = xor32_add(ss, ln_);
                if (fq_ == 0) ssq[(size_t)row * 32 + u.pn * 4 + wc] = ss;
                asm volatile("" ::: "memory");
            }
    }
};
struct EpiHead {
    static constexpr bool PERM = true, ALIGN = true;
    bf16_t* dst0; bf16_t* dst1; const float* gain; int nnorm; float desc;
    __device__ __forceinline__ void operator()(const f32x4 (&acc)[2][2][4][2], const Unit& u, int ui, int wr, int wc, int fr, int fq, LAS unsigned char* lds) const {
        const LAS float* tab = (const LAS float*)(lds + RSTD_OFF) + ui * 256;
        LAS float* HP = (LAS float*)(lds + HP_OFF);
        const int ln_ = lane_now(), fr_ = ln_ & 15, fq_ = ln_ >> 4;
        const int rl0 = wr * 64 + fr_, d0 = wc * 32 + 8 * fq_;
        const bool norm = u.pn < nnorm; const int pnl = norm ? u.pn : u.pn - nnorm; bf16_t* dst = norm ? dst0 : dst1;
        if (norm) {
#pragma unroll
            for (int ai = 0; ai < 2; ++ai)
#pragma unroll
                for (int m = 0; m < 4; ++m) {
                    const int rl = ai * HALF + rl0 + m * 16; const float rs = tab[rl] * desc;
#pragma unroll
                    for (int bj = 0; bj < 2; ++bj) {
                        const f32x4 a = acc[ai][bj][m][0] * rs, b = acc[ai][bj][m][1] * rs;
                        float s = ((a[0] * a[0] + a[1] * a[1]) + (a[2] * a[2] + a[3] * a[3])) + ((b[0] * b[0] + b[1] * b[1]) + (b[2] * b[2] + b[3] * b[3]));
                        s = xor16_add(s); s = xor32_add(s, fq_ * 16 + fr_);
                        if (fq_ == 0) HP[(rl * 2 + bj) * 4 + wc] = s;
                    }
                }
            asm volatile("s_waitcnt lgkmcnt(0)" ::: "memory"); __builtin_amdgcn_s_barrier(); asm volatile("" ::: "memory");
        }
        f32x4 gv0 = {1.f, 1.f, 1.f, 1.f}, gv1 = {1.f, 1.f, 1.f, 1.f};
        if (norm) { gv0 = *(const f32x4*)(gain + d0); gv1 = *(const f32x4*)(gain + d0 + 4); }
#pragma unroll
        for (int ai = 0; ai < 2; ++ai)
#pragma unroll
            for (int m = 0; m < 4; ++m) {
                const int rl = ai * HALF + rl0 + m * 16; const float rs = tab[rl] * desc;
#pragma unroll
                for (int bj = 0; bj < 2; ++bj) {
                    float sc = rs;
                    if (norm) { const f32x4 p = *(const LAS f32x4*)(HP + (rl * 2 + bj) * 4); sc = rs * __builtin_amdgcn_rsqf(((p[0] + p[1]) + (p[2] + p[3])) * (1.0f / 128.0f) + EPS); }
                    const f32x4 a = acc[ai][bj][m][0] * sc * gv0, b = acc[ai][bj][m][1] * sc * gv1;
                    u32x4 w; w.x = cvt_pk_bf16(a[0], a[1]); w.y = cvt_pk_bf16(a[2], a[3]); w.z = cvt_pk_bf16(b[0], b[1]); w.w = cvt_pk_bf16(b[2], b[3]);
                    *(u32x4*)(dst + ((size_t)(2 * pnl + bj) * SEQ + (size_t)(u.pm * BM + rl)) * HD + d0) = w;
                }
            }
    }
};
}

namespace att {
constexpr int NW = 8, QBLK = 32, KVBLK = 64, QB = NW * QBLK, D = 128;
constexpr int SHM_V = KVBLK * D * 2, SHM_K = KVBLK * D * 2;
constexpr int WS_OFF = 2 * SHM_V + 2 * SHM_K, ETAB_OFF = WS_OFF + NW * 64 * 4, ATT_LDS = ETAB_OFF + 256 * 4;
static_assert(ATT_LDS <= RING_BYTES, "attention LDS inside the ring region");
constexpr float SCALE = 0.08838834764831845f, THR = 8.f;
#define KSWZ(row, colB) ((row) * 256 + ((colB) ^ (((row) & 7) << 4)))
#define SBAR() __builtin_amdgcn_sched_barrier(0)
__device__ __forceinline__ int v_st(int k, int c) { const int kk = (k & ~0xC) | ((k & 4) << 1) | ((k & 8) >> 1); return ((kk >> 3) * 4 + (c >> 5)) * 512 + ((kk & 7) * 32 + (c & 31)) * 2; }
__device__ __forceinline__ int v_rd_base(int lane) { return ((lane & 3) << 3) | (((lane >> 2) & 3) << 6) | (((lane >> 4) & 1) << 5) | (((lane >> 5) & 1) << 8); }
constexpr int v_rd_off(int d0, int ks, int half) { return d0 * 512 + ks * 4096 + half * 2048; }
__device__ __forceinline__ int crow(int r, int hi) { return (r & 3) + 8 * (r >> 2) + 4 * hi; }
__device__ __forceinline__ unsigned cvtpk(float lo, float hi) { unsigned r; asm volatile("v_cvt_pk_bf16_f32 %0, %1, %2" : "=v"(r) : "v"(lo), "v"(hi)); return r; }
__device__ __forceinline__ bf16x8 load8(const bf16_t* p) { return *reinterpret_cast<const bf16x8*>(p); }

__device__ __forceinline__ void partialSM(f32x16& p0, f32x16& p1, float& m_reg, float& mn, float& alpha) {
    float pmax = p0[0]; for (int r = 1; r < 16; ++r) pmax = fmaxf(pmax, p0[r]); for (int r = 0; r < 16; ++r) pmax = fmaxf(pmax, p1[r]);
    { auto rr = __builtin_amdgcn_permlane32_swap(__float_as_uint(pmax), __float_as_uint(pmax), false, false);
      pmax = fmaxf(__uint_as_float(rr[0]), __uint_as_float(rr[1])); }
    constexpr float C2 = 1.4426950408889634f * SCALE;
    if (__builtin_expect(__all((pmax - m_reg) * SCALE <= THR), 1)) { mn = m_reg; alpha = 1.f; }
    else { mn = fmaxf(m_reg, pmax); alpha = __builtin_amdgcn_exp2f((m_reg - mn) * C2); m_reg = mn; }
    const float mnL = -mn * C2;
    for (int r = 0; r < 16; ++r) p0[r] = fmaf(p0[r], C2, mnL); for (int r = 0; r < 16; ++r) p1[r] = fmaf(p1[r], C2, mnL);
    for (int r = 0; r < 16; ++r) p0[r] = __builtin_amdgcn_exp2f(p0[r]);
}
__device__ __forceinline__ void finishSM(f32x16& p0, f32x16& p1, float alpha, float& l_reg, bf16x8& pa0, bf16x8& pa1, bf16x8& pa2, bf16x8& pa3) {
    for (int r = 0; r < 16; ++r) p1[r] = __builtin_amdgcn_exp2f(p1[r]);
    float ps = 0; for (int r = 0; r < 16; ++r) ps += p0[r]; for (int r = 0; r < 16; ++r) ps += p1[r];
    { auto rr = __builtin_amdgcn_permlane32_swap(__float_as_uint(ps), __float_as_uint(ps), false, false);
      ps = __uint_as_float(rr[0]) + __uint_as_float(rr[1]); }
    l_reg = l_reg * alpha + ps;
#define PK4(P, B_, OUT) do { unsigned a0 = cvtpk(P[B_+0], P[B_+1]), a1 = cvtpk(P[B_+2], P[B_+3]);                          \
        unsigned b0 = cvtpk(P[B_+4], P[B_+5]), b1 = cvtpk(P[B_+6], P[B_+7]);                                             \
        auto r0 = __builtin_amdgcn_permlane32_swap(a0, b0, false, false); auto r1 = __builtin_amdgcn_permlane32_swap(a1, b1, false, false); \
        u32x4 w = {r0[0], r1[0], r0[1], r1[1]}; OUT = *reinterpret_cast<bf16x8*>(&w); } while (0)
    PK4(p0, 0, pa0); PK4(p0, 8, pa1); PK4(p1, 0, pa2); PK4(p1, 8, pa3);
#undef PK4
}
template <int KB>
__device__ __forceinline__ void qkt(f32x16& p0, f32x16& p1, const char* K_lds, int r32, int hi, const bf16x8* qr, bool act, int delta, const float* etab, int wodd, float c191) {
    if (!act) { const float NEG = -__builtin_inff();
#pragma unroll
        for (int r = 0; r < 16; ++r) { p0[r] = NEG; p1[r] = NEG; } return; }
    if (delta >= 3) {
#pragma unroll
        for (int r = 0; r < 16; ++r) { p0[r] = c191; p1[r] = c191; }
    } else {
        const float* e = etab + (wodd * 32 + r32 + 4 - 4 * hi) + 64 * delta;
#pragma unroll
        for (int r = 0; r < 16; ++r) { const int c = (r & 3) + 8 * (r >> 2); p0[r] = e[59 - c]; p1[r] = e[27 - c]; }
    }
    const char* kb[4];
#pragma unroll
    for (int dd = 0; dd < 4; ++dd) kb[dd] = K_lds + KB * SHM_K + KSWZ(r32, (dd * 16 + hi * 8) * 2);
#pragma unroll
    for (int d0 = 0; d0 < 8; ++d0) { const char* a = kb[d0 & 3] + (d0 >> 2) * 128;
        bf16x8 b0 = *reinterpret_cast<const bf16x8*>(a);
        bf16x8 b1 = *reinterpret_cast<const bf16x8*>(a + 32 * 256);
        p0 = __builtin_amdgcn_mfma_f32_32x32x16_bf16(b0, qr[d0], p0, 0, 0, 0);
        p1 = __builtin_amdgcn_mfma_f32_32x32x16_bf16(b1, qr[d0], p1, 0, 0, 0); }
}
template <int VB>
__device__ __forceinline__ void pv_tile(f32x16* o, int vb0, bf16x8 pa0, bf16x8 pa1, bf16x8 pa2, bf16x8 pa3, bool act) {
    if (!act) return;
#define TRRD(dst, off) asm volatile("ds_read_b64_tr_b16 %0, %1 offset:%2" : "=&v"(dst) : "v"(vb0), "i"(off) : "memory")
#define PV_D0(d0) do { s16x4 l0, l1, l2, l3, h0, h1, h2, h3; constexpr int b_ = VB * SHM_V + v_rd_off(d0, 0, 0); \
        TRRD(l0, b_); TRRD(h0, b_ + 2048); TRRD(l1, b_ + 4096); TRRD(h1, b_ + 6144); TRRD(l2, b_ + 8192); TRRD(h2, b_ + 10240); TRRD(l3, b_ + 12288); TRRD(h3, b_ + 14336); \
        asm volatile("s_waitcnt lgkmcnt(0)" ::: "memory"); SBAR();   \
        o[d0] = __builtin_amdgcn_mfma_f32_32x32x16_bf16(pa0, (bf16x8){l0[0], l0[1], l0[2], l0[3], h0[0], h0[1], h0[2], h0[3]}, o[d0], 0, 0, 0);   \
        o[d0] = __builtin_amdgcn_mfma_f32_32x32x16_bf16(pa1, (bf16x8){l1[0], l1[1], l1[2], l1[3], h1[0], h1[1], h1[2], h1[3]}, o[d0], 0, 0, 0);   \
        o[d0] = __builtin_amdgcn_mfma_f32_32x32x16_bf16(pa2, (bf16x8){l2[0], l2[1], l2[2], l2[3], h2[0], h2[1], h2[2], h2[3]}, o[d0], 0, 0, 0);   \
        o[d0] = __builtin_amdgcn_mfma_f32_32x32x16_bf16(pa3, (bf16x8){l3[0], l3[1], l3[2], l3[3], h3[0], h3[1], h3[2], h3[3]}, o[d0], 0, 0, 0); } while (0)
    PV_D0(0); PV_D0(1); PV_D0(2); PV_D0(3);
#undef PV_D0
#undef TRRD
}
struct BlockRef { const bf16_t* Q; const bf16_t* K; const bf16_t* V; bf16_t* O; const float* rel; int P0; };
struct Seam { bf16x8 qr[8]; bf16x8 st_v0, st_v1, st_k0, st_k1; };
__device__ __forceinline__ int jlo_of(int P0) { const int c = P0 / KVBLK - 8; return c > 0 ? c : 0; }
#define ROW(p, k0, rr) ((p) + (size_t)((k0) + (rr)) * D + sc)
#define VMW() asm volatile("s_waitcnt vmcnt(0)" ::: "memory")
#define VMWN(n) asm volatile("s_waitcnt vmcnt(%0)" :: "i"(n) : "memory")
#define SLOAD_H(Kp, Vp, k0) do { S.st_v0 = load8(ROW(Vp, k0, sr)); S.st_v1 = load8(ROW(Vp, k0, 32 + sr));              \
                         S.st_k0 = load8(ROW(Kp, k0, sr)); S.st_k1 = load8(ROW(Kp, k0, 32 + sr)); } while (0)
#define SWRITE_HK(bf) do { *(bf16x8*)(K_lds + (bf) * SHM_K + kws) = S.st_k0; *(bf16x8*)(K_lds + (bf) * SHM_K + kws + 32 * 256) = S.st_k1; } while (0)
#define SWRITE_HV(bf) do { *(bf16x8*)(V_lds + (bf) * SHM_V + vst0) = S.st_v0; *(bf16x8*)(V_lds + (bf) * SHM_V + vst1) = S.st_v1; } while (0)
#define SWRITE_H(bf) do { SWRITE_HV(bf); SWRITE_HK(bf); } while (0)
__device__ __forceinline__ void etab_write(char* lds, const float* rel, int tid) {
    if (tid < 256) { const int i = tid < NREL - 1 ? tid : NREL - 1; ((float*)(lds + ETAB_OFF))[tid] = rel[i] * (1.0f / SCALE); }
}
__device__ __forceinline__ void attn_prime(const BlockRef& cur, char* lds, Seam& S, int wid) {
    const int lane = lane_now(), tid = wid * 64 + lane, r32 = lane & 31, hi = lane >> 5;
    const int sr = tid >> 4, sc = (tid & 15) * 8, kws = KSWZ(sr, sc * 2); char* K_lds = lds + 2 * SHM_V;
    const int kb0 = jlo_of(cur.P0) * KVBLK;
    for (int d0 = 0; d0 < 8; ++d0) S.qr[d0] = load8(cur.Q + (size_t)(wid * QBLK + r32) * D + d0 * 16 + hi * 8);
    SLOAD_H(cur.K, cur.V, kb0); VMW(); SWRITE_HK(0);
    etab_write(lds, cur.rel, tid);
    __syncthreads();
}
__device__ __forceinline__ void attn_block(const BlockRef& cur, const BlockRef& nxt, char* lds, Seam& S, int wid) {
    const int lane = lane_now(), tid = wid * 64 + lane, r32 = lane & 31, hi = lane >> 5;
    const int j_lo = jlo_of(cur.P0), j_hi = cur.P0 / KVBLK + QB / KVBLK;
    const int NT = j_hi - j_lo;
    const int kbn = jlo_of(nxt.P0) * KVBLK;
    const int cw = cur.P0 / KVBLK + (wid >> 1);
    char* V_lds = lds; char* K_lds = lds + 2 * SHM_V;
    float* ws = (float*)(lds + WS_OFF) + wid * 64; float* li_l = ws, * al_l = ws + 32;
    const float* etab = (const float*)(lds + ETAB_OFF); const int wodd = wid & 1;
    const float c191 = __builtin_bit_cast(float, __builtin_amdgcn_readfirstlane(__builtin_bit_cast(int, etab[255])));
    float m_reg = -1e30f, l_reg = 0; f32x16 o[4] = {};
    const int sr = tid >> 4, sc = (tid & 15) * 8, vst0 = v_st(sr, sc), vst1 = v_st(32 + sr, sc), kws = KSWZ(sr, sc * 2);
    const int vb0 = (int)(uintptr_t)V_lds + v_rd_base(lane);
    const bf16_t* Kh = cur.K; const bf16_t* Vh = cur.V;
#define RESC(a) do { if (__any((a) < 1.f)) { if (hi == 0) al_l[r32] = (a); asm volatile("s_waitcnt lgkmcnt(0)" ::: "memory");              \
                     for (int d_ = 0; d_ < 4; ++d_) for (int r = 0; r < 16; ++r) o[d_][r] *= al_l[crow(r, hi)]; } } while (0)
#define KBASE(t) ((j_lo + (t)) * KVBLK)
#define DLT(t) (cw - (j_lo + (t)))
#define ACT(t) (DLT(t) >= 0 && DLT(t) <= 8)
    constexpr int NQL = 8;
#define SEAM_K0() do { VMWN(NQL); SWRITE_HK(0); SBAR(); } while (0)
    f32x16 pA0, pA1, pB0, pB1; float mnA, mnB, alA, alB; bf16x8 pa0, pa1, pa2, pa3;
    SWRITE_HV(0); SBAR();
    if (NT > 1) { SLOAD_H(Kh, Vh, KBASE(1)); }
    SBAR(); qkt<0>(pA0, pA1, K_lds, r32, hi, S.qr, ACT(0), DLT(0), etab, wodd, c191);
    partialSM(pA0, pA1, m_reg, mnA, alA);
    if (NT > 1) { VMW(); SWRITE_H(1); }
    __syncthreads();
#define HALF_STEP(PX0, PX1, mnX, alX, PY0, PY1, alY, t, KB, VB, SB) do {                                                      \
        SBAR(); qkt<KB>(PX0, PX1, K_lds, r32, hi, S.qr, ACT(t), DLT(t), etab, wodd, c191);                                             \
        finishSM(PY0, PY1, alY, l_reg, pa0, pa1, pa2, pa3); SBAR();                                                           \
        if ((t) + 1 < NT) { SLOAD_H(Kh, Vh, KBASE((t) + 1)); SBAR(); }                                                         \
        pv_tile<VB>(o, vb0, pa0, pa1, pa2, pa3, ACT((t) - 1)); partialSM(PX0, PX1, m_reg, mnX, alX);                           \
        __syncthreads();                                                                                                      \
        if ((t) + 1 < NT) { VMW(); SWRITE_H(SB); }                                                                            \
        RESC(alX); __syncthreads(); } while (0)
    for (int t = 1; t + 1 < NT; t += 2) {
        HALF_STEP(pB0, pB1, mnB, alB, pA0, pA1, alA, t, 1, 0, 0);
        HALF_STEP(pA0, pA1, mnA, alA, pB0, pB1, alB, t + 1, 0, 1, 1);
    }
    const bool even = (NT & 1) == 0;
    if (even) { SBAR(); qkt<1>(pB0, pB1, K_lds, r32, hi, S.qr, ACT(NT - 1), DLT(NT - 1), etab, wodd, c191); SBAR(); }
    SLOAD_H(nxt.K, nxt.V, kbn); SBAR();
#pragma unroll
    for (int d0 = 0; d0 < 8; ++d0) S.qr[d0] = load8(nxt.Q + (size_t)(wid * QBLK + r32) * D + d0 * 16 + hi * 8);
    SBAR();
    finishSM(pA0, pA1, alA, l_reg, pa0, pa1, pa2, pa3); SBAR();
    pv_tile<0>(o, vb0, pa0, pa1, pa2, pa3, ACT(even ? NT - 2 : NT - 1));
    if (even) { partialSM(pB0, pB1, m_reg, mnB, alB); __syncthreads(); RESC(alB);
        finishSM(pB0, pB1, alB, l_reg, pa0, pa1, pa2, pa3); SBAR(); pv_tile<1>(o, vb0, pa0, pa1, pa2, pa3, ACT(NT - 1)); }
    SBAR(); SEAM_K0();
    if (nxt.rel != cur.rel) etab_write(lds, nxt.rel, tid);
    if (hi == 0) li_l[r32] = l_reg; asm volatile("s_waitcnt lgkmcnt(0)" ::: "memory");
    float rli[16];
#pragma unroll
    for (int r = 0; r < 16; ++r) rli[r] = __builtin_amdgcn_rcpf(li_l[crow(r, hi)]);
    if constexpr (FP8_O != 0) {
        unsigned char* Ow8 = (unsigned char*)cur.O + (size_t)(wid * QBLK) * DM;
#pragma unroll
        for (int r = 0; r < 16; ++r) { const int orow = crow(r, hi);
#pragma unroll
            for (int d0 = 0; d0 < 4; ++d0) { const float v = o[d0][r] * (rli[r] * SO8);
                const float v1 = __builtin_bit_cast(float, __builtin_amdgcn_mov_dpp(__builtin_bit_cast(int, v), 0x39, 0xF, 0xF, true));
                const float v2 = __builtin_bit_cast(float, __builtin_amdgcn_mov_dpp(__builtin_bit_cast(int, v), 0x4E, 0xF, 0xF, true));
                const float v3 = __builtin_bit_cast(float, __builtin_amdgcn_mov_dpp(__builtin_bit_cast(int, v), 0x93, 0xF, 0xF, true));
                if ((r32 & 3) == 0) *(unsigned*)(Ow8 + (size_t)orow * DM + d0 * 32 + r32) = pk4_fp8(v, v1, v2, v3); } }
    } else {
    bf16_t* Ow = cur.O + (size_t)(wid * QBLK) * DM;
#pragma unroll
    for (int r = 0; r < 16; ++r) { const int orow = crow(r, hi);
#pragma unroll
        for (int d0 = 0; d0 < 4; ++d0) { const float v = o[d0][r] * rli[r];
            const float vn = xor1_get(v);
            if ((r32 & 1) == 0) *(unsigned*)(Ow + (size_t)orow * DM + d0 * 32 + r32) = cvtpk(v, vn); } }
    }
    __syncthreads();
#undef RESC
#undef KBASE
#undef DLT
#undef ACT
#undef SEAM_K0
#undef HALF_STEP
}
#undef ROW
#undef VMW
#undef VMWN
#undef SLOAD_H
#undef SWRITE_HK
#undef SWRITE_HV
#undef SWRITE_H
}

#define XB_TMO      128
#define XB_XCNT(j)  (256  + 64 * (j))
#define XB_XSUB(j)  (1280 + 64 * (j))
#define XB_XGEN(j)  (2304 + 64 * (j))
#define XB_TOP      3328
#define XB_TOPGEN   3392
#define XCD_BAR_WORDS 3456
#define XB_SPIN_CAP (1u << 18)
__device__ __forceinline__ unsigned xb_ld(unsigned* p)              { return __hip_atomic_load(p, __ATOMIC_RELAXED, __HIP_MEMORY_SCOPE_AGENT); }
__device__ __forceinline__ unsigned xb_add(unsigned* p, unsigned v) { return __hip_atomic_fetch_add(p, v, __ATOMIC_RELAXED, __HIP_MEMORY_SCOPE_AGENT); }
__device__ __forceinline__ unsigned xb_xcc_id() { return (unsigned)__builtin_amdgcn_s_getreg((3 << 11) | 20) & 0xFu; }
#define XB_SPIN(cond, bar) do { unsigned _sp = 0; while (cond) { __builtin_amdgcn_s_sleep(1); \
    if ((++_sp & 255u) == 0u) { if (xb_ld(&(bar)[XB_TMO])) break; if (_sp > XB_SPIN_CAP) { atomicAdd(&(bar)[XB_TMO], 1u); break; } } } } while (0)
struct XcdBarrier { unsigned* bar; unsigned x; volatile LAS unsigned* st; };
__device__ __forceinline__ XcdBarrier xcd_barrier_post(unsigned* bar, volatile LAS unsigned* st, int tid0) {
    XcdBarrier b; b.bar = bar; b.x = xb_xcc_id(); b.st = st;
    if (tid0 == 0) (void)xb_add(&bar[XB_XCNT(b.x)], 1u);
    return b;
}
__device__ __forceinline__ void xcd_barrier_complete(unsigned* bar, unsigned x, unsigned& nloc, unsigned& nx) {
    const unsigned G = gridDim.x * gridDim.y * gridDim.z;
    unsigned sum, cnt, mine, sp = 0u;
    for (;;) {
        sum = 0u; cnt = 0u; mine = 0u;
#pragma unroll
        for (unsigned j = 0; j < 16; ++j) { const unsigned c = xb_ld(&bar[XB_XCNT(j)]); sum += c; cnt += (c > 0u) ? 1u : 0u; mine = (j == x) ? c : mine; }
        if (sum == G) break;
        __builtin_amdgcn_s_sleep(1);
        if ((++sp & 255u) == 0u) { if (xb_ld(&bar[XB_TMO])) break; if (sp > XB_SPIN_CAP) { atomicAdd(&bar[XB_TMO], 1u); break; } }
    }
    nloc = mine > 0u ? mine : 1u; nx = cnt > 0u ? cnt : 1u;
}
__device__ __forceinline__ void xcd_barrier(const XcdBarrier& b, int wave) {
    asm volatile("s_waitcnt vmcnt(0)" ::: "memory");
    __syncthreads();
    if (wave == 0 && lane_now() == 0) {
        unsigned* bar = b.bar;
        __builtin_amdgcn_s_waitcnt(0);
        unsigned nloc = b.st[0], nx = b.st[1];
        if (nloc == 0u) { xcd_barrier_complete(bar, b.x, nloc, nx); b.st[0] = nloc; b.st[1] = nx; }
        const unsigned old = xb_add(&bar[XB_XSUB(b.x)], 1u);
        const unsigned gen = old / nloc;
        if (old + 1u == (gen + 1u) * nloc) {
            __builtin_amdgcn_fence(__ATOMIC_RELEASE, "agent");
            asm volatile("s_waitcnt vmcnt(0)" ::: "memory");
            const unsigned og = xb_add(&bar[XB_TOP], 1u);
            const unsigned tg = og / nx;
            if (og + 1u == (tg + 1u) * nx) xb_add(&bar[XB_TOPGEN], 1u);
            else XB_SPIN(xb_ld(&bar[XB_TOPGEN]) == tg, bar);
            __builtin_amdgcn_fence(__ATOMIC_ACQUIRE, "agent");
            xb_add(&bar[XB_XGEN(b.x)], 1u);
            asm volatile("s_waitcnt vmcnt(0)" ::: "memory");
        } else {
            XB_SPIN(xb_ld(&bar[XB_XGEN(b.x)]) == gen, bar);
            __builtin_amdgcn_fence(__ATOMIC_ACQUIRE, "agent");
            asm volatile("s_waitcnt vmcnt(0)" ::: "memory");
        }
    }
    __syncthreads();
}

struct Frame {
    LAS unsigned char* lds;
    volatile LAS unsigned* MISC;
    gu32* ctl;
    int wave;
    int vcu, G;
};
struct Args { const float* in[20]; float* out; unsigned char* ws; int ph_lo, ph_hi; };
__device__ __forceinline__ const void* ldptr(LAS unsigned char* lds, int i) {
    volatile LAS unsigned* p = (volatile LAS unsigned*)(lds + LDSCTL_OFF) + 2 * i;
    const unsigned lo = __builtin_amdgcn_readfirstlane(p[0]), hi = __builtin_amdgcn_readfirstlane(p[1]);
    const GAS void* q = (const GAS void*)(((unsigned long long)hi << 32) | lo);
    return (const void*)q;
}
#define IN_PTR(i) ((const float*)ldptr(F.lds, (i)))
#define OUT_PTR() ((float*)ldptr(F.lds, 20))
#define WS_PTR() ((unsigned char*)ldptr(F.lds, 21))

struct TItem { const float* src; const float* gain; bf16_t* dst; int ldw, ldt; unsigned char* dst8; float sc8; };
constexpr int I_GU = (DM / 64) * (DFF / 32);
constexpr int I_D = (DFF / 64) * (DM / 32);
constexpr int I_FFN = 2 * I_GU + I_D;
constexpr int I_P = (512 / 64) * (512 / 32);
constexpr int I_S = (DM / 64) * (DM / 32);
constexpr int N_SMALL = 8 * I_P + 6 * I_S;
__device__ __forceinline__ TItem dec_ffn(Frame& F, int set, int r) {
    TItem t; const int l = set >> 1, f = set & 1; unsigned char* ws = WS_PTR();
    if (r < 2 * I_GU) { const int up = r >= I_GU, item = r - up * I_GU, nnb = DFF / 32, kb = item / nnb, nb = item - kb * nnb, n0 = nb * 32, k0 = kb * 64;
        t.src = IN_PTR((f ? 7 : 2) + up) + (size_t)l * DM * DFF + (size_t)k0 * DFF + n0; t.gain = IN_PTR(f ? 6 : 1) + (size_t)l * DM + k0;
        t.dst = (bf16_t*)(ws + WS_WGU + (size_t)set * SZ_WGU) + (size_t)(256 * (n0 >> 7) + (n0 & 127) + up * 128) * DM + k0; t.ldw = DFF; t.ldt = DM; t.dst8 = nullptr; t.sc8 = 1.f;
        if (use8(set)) { t.dst8 = (ws + WS_WGU + (size_t)set * SZ_WGU) + (size_t)(256 * (n0 >> 7) + (n0 & 127) + up * 128) * DM + k0; t.sc8 = SWGU8; } }
    else { const int item = r - 2 * I_GU, nnb = DM / 32, kb = item / nnb, nb = item - kb * nnb, n0 = nb * 32, k0 = kb * 64;
        t.src = IN_PTR(f ? 9 : 4) + (size_t)l * DFF * DM + (size_t)k0 * DM + n0; t.gain = nullptr;
        t.dst = (bf16_t*)(ws + WS_WD + (size_t)set * SZ_WD) + (size_t)n0 * DFF + k0; t.ldw = DM; t.ldt = DFF; t.dst8 = nullptr; t.sc8 = 1.f;
        if (use8d(set)) { t.dst8 = (ws + WS_WD + (size_t)set * SZ_WD) + (size_t)n0 * DFF8 + k0; t.ldt = DFF8; t.sc8 = SWD8; } }
    return t;
}
__device__ __forceinline__ TItem dec_small(Frame& F, int r) {
    TItem t; unsigned char* ws = WS_PTR();
    if (r < 8 * I_P) { const int q = r / I_P, item = r - q * I_P, l = q >> 2, g = q & 3, kb = item >> 4, nb = item & 15, n0 = nb * 32, k0 = kb * 64;
        t.src = IN_PTR(10) + (size_t)q * 512 * 512 + (size_t)k0 * 512 + n0; t.gain = IN_PTR(5) + (size_t)l * DM + g * 512 + k0;
        t.dst = (bf16_t*)(ws + WS_WPOOL + (size_t)l * SZ_WPOOL) + (size_t)g * 512 * 512 + (size_t)n0 * 512 + k0; t.ldw = 512; t.ldt = 512; t.dst8 = nullptr; t.sc8 = 1.f; }
    else { const int rr = r - 8 * I_P, q = rr / I_S, item = rr - q * I_S, kb = item >> 6, nb = item & 63, n0 = nb * 32, k0 = kb * 64; const float* W; const float* gn; bf16_t* WT;
        if (q == 0) { W = IN_PTR(13); gn = IN_PTR(12); WT = (bf16_t*)(ws + WS_WKV); }
        else if (q == 1) { W = IN_PTR(14); gn = IN_PTR(12); WT = (bf16_t*)(ws + WS_WKV) + (size_t)DM * DM; }
        else if (q < 4) { W = IN_PTR(16) + (size_t)(q - 2) * DM * DM; gn = IN_PTR(5) + (size_t)(NPOOL + q - 2) * DM; WT = (bf16_t*)(ws + WS_WQ) + (size_t)(q - 2) * DM * DM; }
        else { W = IN_PTR(19) + (size_t)(q - 4) * DM * DM; gn = nullptr; WT = (bf16_t*)(ws + WS_WO) + (size_t)(q - 4) * DM * DM; }
        t.src = W + (size_t)k0 * DM + n0; t.gain = gn ? gn + k0 : nullptr; t.dst = WT + (size_t)n0 * DM + k0; t.ldw = DM; t.ldt = DM; t.dst8 = nullptr; t.sc8 = 1.f;
        if (FP8_O && q >= 4) { t.dst8 = (unsigned char*)WT + (size_t)n0 * DM + k0; t.sc8 = SWGU8; }
        if (FP8_QKV && q < 4) { t.dst8 = (q == 1 ? ws + WS_WKV + (size_t)DM * DM : (unsigned char*)WT) + (size_t)n0 * DM + k0; t.sc8 = SWGU8; } }
    return t;
}
template <bool GAIN>
__device__ __forceinline__ void titem_load(const TItem& t, float (&v)[32], f32x4& g0, f32x4& g1, int lane) {
    if constexpr (GAIN) { g0 = *(const f32x4*)(t.gain + 8 * (lane & 7)); g1 = *(const f32x4*)(t.gain + 8 * (lane & 7) + 4); }
    const float* p = t.src + (size_t)(lane >> 5) * t.ldw + (lane & 31);
#pragma unroll
    for (int i = 0; i < 32; ++i) v[i] = __builtin_nontemporal_load(p + (size_t)(2 * i) * t.ldw);
}
template <bool GAIN>
__device__ __forceinline__ void titem_store(const TItem& t, const float (&v)[32], const f32x4& g0, const f32x4& g1, LAS float* scr, int lane) {
    const int c = lane & 7;
#pragma unroll
    for (int i = 0; i < 32; ++i) scr[(2 * i + (lane >> 5)) * 33 + (lane & 31)] = v[i];
    LDS_WAIT(); asm volatile("" ::: "memory");
#pragma unroll
    for (int j = 0; j < 4; ++j) { const int n = (lane >> 3) + 8 * j; const LAS float* s = scr + (8 * c) * 33 + n;
        float e[8];
#pragma unroll
        for (int q = 0; q < 8; ++q) e[q] = s[q * 33];
        if constexpr (GAIN) { e[0] *= g0[0]; e[1] *= g0[1]; e[2] *= g0[2]; e[3] *= g0[3]; e[4] *= g1[0]; e[5] *= g1[1]; e[6] *= g1[2]; e[7] *= g1[3]; }
        if ((FP8_SETS != 0 || FP8_QKV || FP8_O) && t.dst8) { u32x2 o8; o8.x = pk4_fp8(e[0] * t.sc8, e[1] * t.sc8, e[2] * t.sc8, e[3] * t.sc8); o8.y = pk4_fp8(e[4] * t.sc8, e[5] * t.sc8, e[6] * t.sc8, e[7] * t.sc8);
            *(GAS u32x2*)(t.dst8 + (size_t)n * t.ldt + 8 * c) = o8; }
        else { u32x4 o; o.x = cvt_pk_bf16(e[0], e[1]); o.y = cvt_pk_bf16(e[2], e[3]); o.z = cvt_pk_bf16(e[4], e[5]); o.w = cvt_pk_bf16(e[6], e[7]);
            *(GAS u32x4*)(t.dst + (size_t)n * t.ldt + 8 * c) = o; } }
    LDS_WAIT(); asm volatile("" ::: "memory");
}
template <bool SMALL, bool GAIN>
__device__ __forceinline__ void convert_items(Frame& F, int set, int first, int end, int stride) {
    LAS float* scr = (LAS float*)(F.lds + RING_OFF + F.wave * 16384);
    const int lane = lane_now();
    int it = first; if (it >= end) return;
    const float z_ = __builtin_bit_cast(float, opaque_s(0));
    float va[32], vb[32]; f32x4 ga0 = {z_, z_, z_, z_}, ga1 = ga0, gb0 = ga0, gb1 = ga0;
    TItem ta = SMALL ? dec_small(F, it) : dec_ffn(F, set, it);
    titem_load<GAIN>(ta, va, ga0, ga1, lane);
    for (;;) {
        const int nxt = it + stride; const bool more = nxt < end;
        const TItem tb = SMALL ? dec_small(F, more ? nxt : it) : dec_ffn(F, set, more ? nxt : it);
        titem_load<GAIN>(tb, vb, gb0, gb1, lane);
        titem_store<GAIN>(ta, va, ga0, ga1, scr, lane);
        if (!more) break;
        ta = tb; ga0 = gb0; ga1 = gb1;
#pragma unroll
        for (int i = 0; i < 32; ++i) va[i] = vb[i];
        it = nxt;
    }
}
constexpr int N_SMALL_G = 8 * I_P + 4 * I_S;
__device__ __forceinline__ void convert_ffn_set(Frame& F, int set, int worker, int nworkers) {
    convert_items<false, true>(F, set, worker, 2 * I_GU, nworkers);
    convert_items<false, false>(F, set, 2 * I_GU + worker, I_FFN, nworkers);
    if (use8d(set)) {
        unsigned char* wd8 = WS_PTR() + WS_WD + (size_t)set * SZ_WD; const int lane = lane_now(); const unsigned z0 = (unsigned)opaque_s(0);
        for (int r = worker; r < DM; r += nworkers) if (lane < (DFF8 - DFF) / 16) *(GAS u32x4*)(wd8 + (size_t)r * DFF8 + DFF + lane * 16) = (u32x4){z0, z0, z0, z0};
    }
}
__device__ __forceinline__ void p0_prologue(Frame& F) {
    const int lane = lane_now();
    const int gw = F.vcu * NWAVES + F.wave, NGW = F.G * NWAVES;
    unsigned char* ws = WS_PTR();
    convert_ffn_set(F, 0, gw, NGW);
    convert_items<true, true>(F, 0, gw, N_SMALL_G, NGW);
    convert_items<true, false>(F, 0, N_SMALL_G + gw, N_SMALL, NGW);
    const float* x = IN_PTR(0); bf16_t* XB = (bf16_t*)(ws + WS_XB); float* SSQ = (float*)(ws + WS_SSQ);
    for (int m = gw; m < SEQ; m += NGW) {
        const GAS f32x4* xr = (const GAS f32x4*)(x + (size_t)m * DM) + lane;
        GAS u32x2* o8 = (GAS u32x2*)(XB + (size_t)m * DM) + lane;
        float s = 0.f;
#pragma unroll
        for (int j = 0; j < 8; ++j) { const f32x4 v = xr[64 * j]; s += (v[0] * v[0] + v[1] * v[1]) + (v[2] * v[2] + v[3] * v[3]);
            u32x2 w; w.x = pk2(v[0], v[1]); w.y = pk2(v[2], v[3]); o8[64 * j] = w; }
        s = wave_sum(s, lane);
        if (lane < 32) SSQ[(size_t)m * 32 + lane] = lane == 0 ? s : 0.f;
        if ((FP8_SETS | FP8_D_SETS) != 0 && lane < (DFF8 - DFF) / 16) *(GAS u32x4*)(ws + WS_H8 + (size_t)m * DFF8 + DFF + lane * 16) = (u32x4){0u, 0u, 0u, 0u};
    }
}
__device__ __forceinline__ void tail_convert(Frame& F, const pg8::StaticOrder& S, int next_set) {
    if (next_set >= 2 * DEPTH) return;
    const int rounds = (S.nwg + S.G - 1) / S.G, nfull = S.nwg - (rounds - 1) * S.G;
    int worker, nworkers;
    if (nfull >= S.G) { worker = S.c * NWAVES + F.wave; nworkers = S.G * NWAVES; }
    else { if (S.c < nfull) return; worker = (S.c - nfull) * NWAVES + F.wave; nworkers = (S.G - nfull) * NWAVES; }
    convert_ffn_set(F, next_set, worker, nworkers);
}
__device__ __forceinline__ void prep_rstd(Frame& F, const pg8::StaticOrder& S, const float* ssq) {
    LAS float* tab = (LAS float*)(F.lds + RSTD_OFF);
    const int tid_ = F.wave * 64 + lane_now();
    const int row = tid_ >> 1, half = tid_ & 1;
    pg8::Unit u;
    int pm_prev = -1; float v_prev = 0.f;
#pragma unroll 1
    for (int i = 0; i < 8 && S.next(i, u); ++i) {
        if (u.pm != pm_prev) {
            const f32x4* p = (const f32x4*)(ssq + (size_t)(u.pm * 256 + row) * 32 + half * 16);
            const f32x4 a = p[0], b = p[1], c = p[2], d = p[3];
            float s = ((a[0] + a[1]) + (a[2] + a[3])) + ((b[0] + b[1]) + (b[2] + b[3])) + ((c[0] + c[1]) + (c[2] + c[3])) + ((d[0] + d[1]) + (d[2] + d[3]));
            s += xor1_get(s);
            v_prev = __builtin_amdgcn_rsqf(s * (1.0f / DM) + EPS); pm_prev = u.pm;
        }
        if (half == 0) tab[i * 256 + row] = v_prev;
    }
    LDS_WAIT(); __syncthreads();
}
__device__ __forceinline__ float half_sum(float v) {
    v += __builtin_bit_cast(float, __builtin_amdgcn_ds_swizzle(__builtin_bit_cast(int, v), 0x041F));
    v += __builtin_bit_cast(float, __builtin_amdgcn_ds_swizzle(__builtin_bit_cast(int, v), 0x081F));
    v += __builtin_bit_cast(float, __builtin_amdgcn_ds_swizzle(__builtin_bit_cast(int, v), 0x101F));
    v += __builtin_bit_cast(float, __builtin_amdgcn_ds_swizzle(__builtin_bit_cast(int, v), 0x201F));
    return xor16_add(v);
}
template <int W>
__device__ __forceinline__ void pool_diff_block(Frame& F, const bf16_t* x, const float* ssq, bf16_t* diff, int t0, int tid_) {
    LAS float* rt = (LAS float*)(F.lds + RING_OFF);
    const int c4 = tid_ * 4, rr = tid_ >> 5, part = tid_ & 31;
    float pv[3];
#pragma unroll
    for (int j = 0; j < 3; ++j) { const int r = t0 - 16 + rr + 16 * j; pv[j] = ssq[(size_t)(r < 0 ? 0 : r) * 32 + part]; }
    u32x2 xr[31 + W];
#pragma unroll
    for (int i = 0; i < 31 + W; ++i) { const int sr = t0 - W + 1 + i; xr[i] = *(const u32x2*)(x + (size_t)(sr < 0 ? 0 : sr) * DM + c4); }
#pragma unroll
    for (int j = 0; j < 3; ++j) { const int r = t0 - 16 + rr + 16 * j; const float sm = half_sum(pv[j]);
        if (part == 0) rt[rr + 16 * j] = r >= 0 ? __builtin_amdgcn_rsqf(sm * (1.0f / DM) + EPS) : 0.f; }
    LDS_WAIT(); __syncthreads();
    const float z_ = __builtin_bit_cast(float, opaque_s(0));
    f32x4 sum = {z_, z_, z_, z_};
#pragma unroll
    for (int i = 0; i < W - 1; ++i) sum += pg8::bf4_lo(xr[i].x, xr[i].y) * rt[17 - W + i];
    const bool head = t0 == 0;
#pragma unroll
    for (int t = 0; t < 32; ++t) {
        const f32x4 a = pg8::bf4_lo(xr[W - 1 + t].x, xr[W - 1 + t].y) * rt[16 + t];
        sum += a;
        const float inv = __builtin_bit_cast(float, opaque_s(__builtin_bit_cast(int, (t + 1 < W && head) ? 1.0f / (float)(t + 1) : 1.0f / (float)W)));
        const f32x4 o = sum * inv - a;
        u32x2 pk; pk.x = pk2(o[0], o[1]); pk.y = pk2(o[2], o[3]);
        *(u32x2*)(diff + (size_t)(t0 + t) * DM + c4) = pk;
        sum -= pg8::bf4_lo(xr[t].x, xr[t].y) * rt[17 - W + t];
    }
    __syncthreads();
}
__device__ __forceinline__ void pool_diff_phase(Frame& F, const bf16_t* x, const float* ssq, bf16_t* diff) {
    const int lane = lane_now(), tid_ = F.wave * 64 + lane;
    const int g = F.wave >> 1;
    const int vcu_ = opaque_s(F.vcu), G_ = opaque_s(F.G);
    for (int blk = vcu_; blk < SEQ / 32; blk += G_) {
        const int t0 = blk * 32;
        if (g == 0) pool_diff_block<2>(F, x, ssq, diff, t0, tid_);
        else if (g == 1) pool_diff_block<4>(F, x, ssq, diff, t0, tid_);
        else if (g == 2) pool_diff_block<8>(F, x, ssq, diff, t0, tid_);
        else pool_diff_block<16>(F, x, ssq, diff, t0, tid_);
    }
}
__device__ __forceinline__ att::BlockRef attn_ref(int l, const bf16_t* QH, const bf16_t* KH, const bf16_t* VH, bf16_t* AO, const float* rel) {
    att::BlockRef r; const int h = l >> 5, qb = l & 31;
    r.Q = QH + ((size_t)h * SEQ + (size_t)qb * att::QB) * HD; r.K = KH + (size_t)h * SEQ * HD; r.V = VH + (size_t)h * SEQ * HD;
    r.O = FP8_O ? (bf16_t*)((unsigned char*)AO + (size_t)qb * att::QB * DM + h * HD) : AO + (size_t)qb * att::QB * DM + h * HD; r.rel = rel + h * NREL; r.P0 = qb * att::QB; return r;
}
__device__ __forceinline__ void attn_phase(Frame& F, char* lds, const bf16_t* QH, const bf16_t* KH, const bf16_t* VH, bf16_t* AO, const float* rel) {
    const int total = NH * (SEQ / att::QB);
    const int G_ = opaque_s(F.G);
    int L = opaque_s(F.vcu); if (L >= total) return;
    att::BlockRef cur = attn_ref(L, QH, KH, VH, AO, rel);
    att::Seam S;
    att::attn_prime(cur, lds, S, F.wave);
    for (;;) {
        const bool more = L + G_ < total;
        const att::BlockRef nxt = more ? attn_ref(L + G_, QH, KH, VH, AO, rel) : cur;
        att::attn_block(cur, nxt, lds, S, F.wave);
        if (!more) break;
        cur = nxt; L += G_;
    }
}

__global__ void __launch_bounds__(NWAVES * 64, 2) fwd_kernel(Args args) {
    extern __shared__ __attribute__((aligned(16))) unsigned char lds[];
    Frame F;
    F.lds = (LAS unsigned char*)lds;
    F.MISC = (volatile LAS unsigned*)(F.lds + MISC_OFF);
    const int tid0 = threadIdx.x; F.wave = __builtin_amdgcn_readfirstlane(tid0 >> 6);
    F.G = gridDim.x; { const int bx = blockIdx.x; F.vcu = (F.G % 8 == 0) ? (bx % 8) * (F.G / 8) + bx / 8 : bx; }
    if (tid0 < 32) ((LAS unsigned*)(F.lds + MISC_OFF))[tid0] = 0u;
    if (tid0 >= 64 && tid0 < 64 + 44) {
        const __attribute__((address_space(4))) unsigned* ka = (const __attribute__((address_space(4))) unsigned*)__builtin_amdgcn_kernarg_segment_ptr();
        ((LAS unsigned*)(F.lds + LDSCTL_OFF))[tid0 - 64] = ka[tid0 - 64]; }
    __syncthreads();
    F.ctl = (gu32*)(WS_PTR() + WS_CTL);
#if MK_PER_PHASE
#define GRID_BAR() do { } while (0)
#else
    XcdBarrier bar = xcd_barrier_post((unsigned*)(F.ctl + CW_BAR), F.MISC + 8, tid0);
#define GRID_BAR() xcd_barrier(bar, F.wave)
#endif
    const int lo = args.ph_lo, hi = args.ph_hi;
    int pi = 0;
#define PHASE_BEGIN if (pi >= lo && pi < hi) {
#define PHASE_END   if (pi + 1 < hi) GRID_BAR(); } ++pi;
#define WSP(off) (WS_PTR() + (off))

    PHASE_BEGIN if (PH_ON(0)) DUP_LOOP(0) { p0_prologue(F); DUP_BAR(0) } PHASE_END

#define LAYER_BODY(K8, KD8, F0, F1, WITH_KV) \
        for (int f = F0; f < F1; ++f) { \
            PHASE_BEGIN if (PH_ON(1)) DUP_LOOP(1) { \
                pg8::StaticOrder S; S.init(SEQ, NGU, opaque_s(F.G), opaque_s((int)blockIdx.x)); \
                prep_rstd(F, S, (const float*)WSP(WS_SSQ)); \
                if constexpr (K8) { \
                    pg8::Gemm g{(const bf16_t*)WSP(WS_XB8), (const bf16_t*)WSP(WS_WGU + (size_t)(l * 2 + f) * SZ_WGU), DM / 2, DM / 2, DM / 2}; \
                    pg8::EpiSwiGLU E{nullptr, (unsigned char*)WSP(WS_H8), 1.0f / (SX8 * SWGU8)}; \
                    pg8::gemm_phase<pg8::EpiSwiGLU, pg8::PlainTiles, true>(F.lds + RING_OFF, F.wave, g, S, pg8::PlainTiles{}, E); \
                } else { \
                    pg8::Gemm g{(const bf16_t*)WSP(WS_XB), (const bf16_t*)WSP(WS_WGU + (size_t)(l * 2 + f) * SZ_WGU), DM, DM, DM}; \
                    pg8::EpiSwiGLU E{KD8 ? nullptr : (bf16_t*)WSP(WS_HB), KD8 ? (unsigned char*)WSP(WS_H8) : nullptr, 1.0f}; \
                    pg8::gemm_phase(F.lds + RING_OFF, F.wave, g, S, pg8::PlainTiles{}, E); \
                } \
                tail_convert(F, S, l * 2 + f + 1); \
                DUP_BAR(1) \
            } PHASE_END \
            PHASE_BEGIN if (PH_ON(2)) DUP3_LOOP(2) { \
                pg8::StaticOrder S; S.init(SEQ, DM, opaque_s(F.G), opaque_s((int)blockIdx.x)); \
                const bool first = (l == 0 && f == 0 && rep_ == 0), lastp = (l == DEPTH - 1 && f == 1); \
                bf16_t* XB = (bf16_t*)WSP(WS_XB); \
                unsigned char* nx8 = ((f == 1 && l + 1 < DEPTH && use8((l + 1) * 2)) || (FP8_QKV && ((l == NPOOL - 1 && f == 1) || (l >= NPOOL && f == 0)))) ? (unsigned char*)WSP(WS_XB8) : nullptr; \
                if constexpr (K8 || KD8) { \
                    pg8::Gemm g{(const bf16_t*)WSP(WS_H8), (const bf16_t*)WSP(WS_WD + (size_t)(l * 2 + f) * SZ_WD), DFF8 / 2, DFF8 / 2, DFF8 / 2}; \
                    pg8::EpiRes E{first ? nullptr : (const bf16_t*)XB, first ? IN_PTR(0) : nullptr, XB, lastp ? OUT_PTR() : nullptr, (float*)WSP(WS_SSQ), nullptr, 0.5f * DUP3_SIGN / (SH8 * SWD8), nx8}; \
                    pg8::gemm_phase<pg8::EpiRes, pg8::PlainTiles, true>(F.lds + RING_OFF, F.wave, g, S, pg8::PlainTiles{}, E); \
                } else { \
                    pg8::Gemm g{(const bf16_t*)WSP(WS_HB), (const bf16_t*)WSP(WS_WD + (size_t)(l * 2 + f) * SZ_WD), DFF, DFF, DFF}; \
                    pg8::EpiRes E{first ? nullptr : (const bf16_t*)XB, first ? IN_PTR(0) : nullptr, XB, lastp ? OUT_PTR() : nullptr, (float*)WSP(WS_SSQ), nullptr, 0.5f * DUP3_SIGN, nx8}; \
                    pg8::gemm_phase(F.lds + RING_OFF, F.wave, g, S, pg8::PlainTiles{}, E); \
                } \
                DUP3_BAR(2) \
            } PHASE_END \
            if (f == 0) { \
                if (l < NPOOL) { \
                    PHASE_BEGIN if (PH_ON(3)) DUP_LOOP(3) { pool_diff_phase(F, (const bf16_t*)WSP(WS_XB), (const float*)WSP(WS_SSQ), (bf16_t*)WSP(WS_T1)); DUP_BAR(3) } PHASE_END \
                    PHASE_BEGIN if (PH_ON(4)) DUP3_LOOP(4) { \
                        pg8::StaticOrder S; S.init(SEQ, DM, opaque_s(F.G), opaque_s((int)blockIdx.x)); \
                        pg8::Gemm g{(const bf16_t*)WSP(WS_T1), (const bf16_t*)WSP(WS_WPOOL + (size_t)l * SZ_WPOOL), DM, 512, 512}; \
                        bf16_t* XB = (bf16_t*)WSP(WS_XB); \
                        pg8::EpiRes E{XB, nullptr, XB, nullptr, (float*)WSP(WS_SSQ), IN_PTR(11) + (size_t)l * DM, DUP3_SIGN, use8(l * 2 + 1) ? (unsigned char*)WSP(WS_XB8) : nullptr}; \
                        pg8::gemm_phase(F.lds + RING_OFF, F.wave, g, S, pg8::PoolTiles{}, E); \
                        DUP3_BAR(4) \
                    } PHASE_END \
                } else { \
                    const int b = l - NPOOL; \
                    PHASE_BEGIN if (PH_ON(5)) DUP_LOOP(5) { \
                        pg8::StaticOrder S; S.init(SEQ, DM, opaque_s(F.G), opaque_s((int)blockIdx.x)); \
                        prep_rstd(F, S, (const float*)WSP(WS_SSQ)); \
                        bf16_t* QH = (bf16_t*)WSP(WS_QH); \
                        if constexpr (FP8_QKV != 0) { \
                            pg8::Gemm g{(const bf16_t*)WSP(WS_XB8), (const bf16_t*)WSP(WS_WQ) + (size_t)b * DM * DM, DM / 2, DM / 2, DM / 2}; \
                            pg8::EpiHead E{QH, QH, IN_PTR(17) + (size_t)b * HD, 8, 1.0f / (SX8 * SWGU8)}; \
                            pg8::gemm_phase<pg8::EpiHead, pg8::PlainTiles, true>(F.lds + RING_OFF, F.wave, g, S, pg8::PlainTiles{}, E); \
                        } else { \
                            pg8::Gemm g{(const bf16_t*)WSP(WS_XB), (const bf16_t*)WSP(WS_WQ) + (size_t)b * DM * DM, DM, DM, DM}; \
                            pg8::EpiHead E{QH, QH, IN_PTR(17) + (size_t)b * HD, 8, 1.0f}; \
                            pg8::gemm_phase(F.lds + RING_OFF, F.wave, g, S, pg8::PlainTiles{}, E); \
                        } \
                        DUP_BAR(5) \
                    } PHASE_END \
                    PHASE_BEGIN if (PH_ON(6)) DUP_LOOP(6) { attn_phase(F, (char*)lds + RING_OFF, (const bf16_t*)WSP(WS_QH), (const bf16_t*)WSP(WS_KH), (const bf16_t*)WSP(WS_VH), (bf16_t*)WSP(WS_T1), IN_PTR(18) + (size_t)b * NH * NREL); DUP_BAR(6) } PHASE_END \
                    PHASE_BEGIN if (PH_ON(7)) DUP3_LOOP(7) { \
                        pg8::StaticOrder S; S.init(SEQ, DM, opaque_s(F.G), opaque_s((int)blockIdx.x)); \
                        bf16_t* XB = (bf16_t*)WSP(WS_XB); \
                        if constexpr (FP8_O != 0) { \
                            pg8::Gemm g{(const bf16_t*)WSP(WS_T1), (const bf16_t*)WSP(WS_WO) + (size_t)b * DM * DM, DM / 2, DM / 2, DM / 2}; \
                            pg8::EpiRes E{XB, nullptr, XB, nullptr, (float*)WSP(WS_SSQ), nullptr, DUP3_SIGN / (SO8 * SWGU8), use8(l * 2 + 1) ? (unsigned char*)WSP(WS_XB8) : nullptr}; \
                            pg8::gemm_phase<pg8::EpiRes, pg8::PlainTiles, true>(F.lds + RING_OFF, F.wave, g, S, pg8::PlainTiles{}, E); \
                        } else { \
                            pg8::Gemm g{(const bf16_t*)WSP(WS_T1), (const bf16_t*)WSP(WS_WO) + (size_t)b * DM * DM, DM, DM, DM}; \
                            pg8::EpiRes E{XB, nullptr, XB, nullptr, (float*)WSP(WS_SSQ), nullptr, DUP3_SIGN, use8(l * 2 + 1) ? (unsigned char*)WSP(WS_XB8) : nullptr}; \
                            pg8::gemm_phase(F.lds + RING_OFF, F.wave, g, S, pg8::PlainTiles{}, E); \
                        } \
                        DUP3_BAR(7) \
                    } PHASE_END \
                } \
            } \
        } \
        if (WITH_KV && l == NPOOL - 1) { \
            PHASE_BEGIN if (PH_ON(8)) DUP_LOOP(8) { \
                pg8::StaticOrder S; S.init(SEQ, 2 * DM, opaque_s(F.G), opaque_s((int)blockIdx.x)); \
                prep_rstd(F, S, (const float*)WSP(WS_SSQ)); \
                if constexpr (FP8_QKV != 0) { \
                    pg8::Gemm g{(const bf16_t*)WSP(WS_XB8), (const bf16_t*)WSP(WS_WKV), DM / 2, DM / 2, DM / 2}; \
                    pg8::EpiHead E{(bf16_t*)WSP(WS_KH), (bf16_t*)WSP(WS_VH), IN_PTR(15), 8, 1.0f / (SX8 * SWGU8)}; \
                    pg8::gemm_phase<pg8::EpiHead, pg8::PlainTiles, true>(F.lds + RING_OFF, F.wave, g, S, pg8::PlainTiles{}, E); \
                } else { \
                    pg8::Gemm g{(const bf16_t*)WSP(WS_XB), (const bf16_t*)WSP(WS_WKV), DM, DM, DM}; \
                    pg8::EpiHead E{(bf16_t*)WSP(WS_KH), (bf16_t*)WSP(WS_VH), IN_PTR(15), 8, 1.0f}; \
                    pg8::gemm_phase(F.lds + RING_OFF, F.wave, g, S, pg8::PlainTiles{}, E); \
                } \
                DUP_BAR(8) \
            } PHASE_END \
        }
#if FP8_D_SETS
    static_assert(FP8_FIRST_LAYER == DEPTH, "FP8-down of the last half-step: the layers' FFNs are otherwise bf16");
    for (int l = 0; l < DEPTH; ++l) {
        LAYER_BODY(false, false, 0, (l == DEPTH - 1 ? 1 : 2), true)
    }
    {   const int l = opaque_s(DEPTH - 1);
        LAYER_BODY(false, true, 1, 2, false)
    }
#else
    for (int l = 0; l < FP8_FIRST_LAYER; ++l) {
        LAYER_BODY(false, false, 0, 2, true)
    }
    for (int l = FP8_FIRST_LAYER; l < DEPTH; ++l) {
        LAYER_BODY(true, false, 0, 2, true)
    }
#endif
#undef LAYER_BODY
#undef PHASE_BEGIN
#undef PHASE_END
}
constexpr int N_PHASES = 1 + 2 * 6 + 1 + 2 * 7;


#ifndef MK_DEBUG
#define MK_DEBUG 0
#endif
#if MK_DEBUG
constexpr size_t WS_XOLD = WS_END, WS_RES = WS_END + (size_t)SEQ * DM * 4;
struct ChkArgs { const float* in[20]; float* out; unsigned char* ws; int phase, kind, l, f; };
__device__ __forceinline__ float bf2f(bf16_t b) { return __uint_as_float(((unsigned)b) << 16); }
__device__ __forceinline__ float bfr(float x) { return __uint_as_float(f2bf(x) << 16); }
__device__ __forceinline__ unsigned hash32(unsigned x) { x ^= x >> 16; x *= 0x7feb352du; x ^= x >> 15; x *= 0x846ca68bu; x ^= x >> 16; return x; }
__device__ __forceinline__ float wsum(float v) { for (int o = 32; o >= 1; o >>= 1) v += __shfl_xor(v, o); return v; }
__device__ __forceinline__ float row_rstd_b(const bf16_t* XBp, int row, int lane) { float s = 0.f; for (int k = lane; k < DM; k += 64) { const float v = bf2f(XBp[(size_t)row * DM + k]); s += v * v; } s = wsum(s); return 1.0f / sqrtf(s / DM + EPS); }
__device__ __forceinline__ float row_rstd(const float* X, int row, int lane) { float s = 0.f; for (int k = lane; k < DM; k += 64) { const float v = X[(size_t)row * DM + k]; s += v * v; } s = wsum(s); return 1.0f / sqrtf(s / DM + EPS); }
__device__ __forceinline__ void rec(unsigned* res, int phase, float got, float ref, float floor_) { float e = fabsf(got - ref) / (fabsf(ref) + floor_); if (!(e == e)) e = 1e30f; atomicMax(res + phase, __float_as_uint(e)); }
__device__ void chk_ffn_set(const ChkArgs& a, unsigned* res, int slot, int set, unsigned t) {
    unsigned char* ws = a.ws; const int ll = set >> 1, ff = set & 1;
    { const int up = t & 1; const int n = hash32(t + 1) % DFF, k = hash32(t + 2) % DM;
      const float w = a.in[(ff ? 7 : 2) + up][(size_t)ll * DM * DFF + (size_t)k * DFF + n] * a.in[ff ? 6 : 1][ll * DM + k];
      const bf16_t g = ((const bf16_t*)(ws + WS_WGU + (size_t)set * SZ_WGU))[(size_t)(256 * (n >> 7) + (n & 127) + up * 128) * DM + k]; rec(res, slot, bf2f(g), bfr(w), 1e-3f); }
    { const int n = hash32(t + 3) % DM, k = hash32(t + 4) % DFF;
      const float w = a.in[ff ? 9 : 4][(size_t)ll * DFF * DM + (size_t)k * DM + n];
      const bf16_t g = ((const bf16_t*)(ws + WS_WD + (size_t)set * SZ_WD))[(size_t)n * DFF + k]; rec(res, slot, bf2f(g), bfr(w), 1e-3f); }
}
__global__ void chk_kernel(ChkArgs a) {
    const int lane = threadIdx.x & 63, gw = blockIdx.x * (blockDim.x >> 6) + (threadIdx.x >> 6);
    unsigned char* ws = a.ws; unsigned* res = (unsigned*)(ws + WS_RES);
    const bf16_t* XOLD = (const bf16_t*)(ws + WS_XOLD);
    const bf16_t* XB = (const bf16_t*)(ws + WS_XB); const bf16_t* HB = (const bf16_t*)(ws + WS_HB); const bf16_t* T1 = (const bf16_t*)(ws + WS_T1);
    const float* SSQ = (const float*)(ws + WS_SSQ);
    const unsigned h0 = hash32(gw * 7919u + a.phase * 104729u + 17u);
    const int l = a.l, f = a.f;
    if (a.kind == 0) {
        const unsigned t = hash32(h0 + lane * 31u);
        chk_ffn_set(a, res, 28, 0, t); chk_ffn_set(a, res, 29, 0, hash32(t + 99));
        { const int q = t % 8, ll = q >> 2, gg = q & 3; const int d = hash32(t + 5) % 512, c = hash32(t + 6) % 512;
          const float w = a.in[10][(size_t)q * 512 * 512 + (size_t)c * 512 + d] * a.in[5][ll * DM + gg * 512 + c];
          const bf16_t g = ((const bf16_t*)(ws + WS_WPOOL + (size_t)ll * SZ_WPOOL))[(size_t)gg * 512 * 512 + (size_t)d * 512 + c]; rec(res, 30, bf2f(g), bfr(w), 1e-3f); }
        { const int q = t % 6; const int n = hash32(t + 7) % DM, k = hash32(t + 8) % DM; float w; bf16_t g;
          if (q == 0) { w = a.in[13][(size_t)k * DM + n] * a.in[12][k]; g = ((const bf16_t*)(ws + WS_WKV))[(size_t)n * DM + k]; }
          else if (q == 1) { w = a.in[14][(size_t)k * DM + n] * a.in[12][k]; g = ((const bf16_t*)(ws + WS_WKV))[(size_t)(DM + n) * DM + k]; }
          else if (q < 4) { w = a.in[16][(size_t)(q - 2) * DM * DM + (size_t)k * DM + n] * a.in[5][(NPOOL + q - 2) * DM + k]; g = ((const bf16_t*)(ws + WS_WQ))[(size_t)(q - 2) * DM * DM + (size_t)n * DM + k]; }
          else { w = a.in[19][(size_t)(q - 4) * DM * DM + (size_t)k * DM + n]; g = ((const bf16_t*)(ws + WS_WO))[(size_t)(q - 4) * DM * DM + (size_t)n * DM + k]; }
          rec(res, 31, bf2f(g), bfr(w), 1e-3f); }
        { const int row = h0 % SEQ; float s = 0.f, sq = 0.f; for (int k = lane; k < DM; k += 64) { const float v = a.in[0][(size_t)row * DM + k]; sq += v * v; rec(res, 32, bf2f(XB[(size_t)row * DM + k]), bfr(v), 1e-3f); }
          sq = wsum(sq); s = lane < 32 ? SSQ[(size_t)row * 32 + lane] : 0.f; s = wsum(s); if (lane == 0) rec(res, 33, s, sq, 1e-3f); }
        return;
    }
    const bool firstD = (l == 0 && f == 0);
    if (a.kind == 1) {
        const int row = h0 % SEQ, col = hash32(h0 + 1) % DFF; const float rs = firstD ? row_rstd(a.in[0], row, lane) : row_rstd_b(XB, row, lane);
        const bf16_t* W = (const bf16_t*)(ws + WS_WGU + (size_t)(l * 2 + f) * SZ_WGU); const size_t rg = (size_t)(256 * (col >> 7) + (col & 127)) * DM, ru = rg + (size_t)128 * DM;
        float g = 0.f, u = 0.f; for (int k = lane; k < DM; k += 64) { const float xv = bf2f(XB[(size_t)row * DM + k]); g += xv * bf2f(W[rg + k]); u += xv * bf2f(W[ru + k]); }
        g = wsum(g) * rs; u = wsum(u) * rs; const float hh = g / (1.f + expf(-g)) * u;
        if (lane == 0) rec(res, a.phase, bf2f(HB[(size_t)row * DFF + col]), hh, 0.05f);
        if (l * 2 + f + 1 < 2 * DEPTH) chk_ffn_set(a, res, a.phase, l * 2 + f + 1, hash32(h0 + lane * 31u));
        return;
    }
    if (a.kind == 2 || a.kind == 7 || a.kind == 4) {
        const int row = h0 % SEQ, col = hash32(h0 + 1) % DM; float s = 0.f; float mul;
        if (a.kind == 2) { const bf16_t* W = (const bf16_t*)(ws + WS_WD + (size_t)(l * 2 + f) * SZ_WD); for (int k = lane; k < DFF; k += 64) s += bf2f(HB[(size_t)row * DFF + k]) * bf2f(W[(size_t)col * DFF + k]); mul = 0.5f; }
        else if (a.kind == 7) { const bf16_t* W = (const bf16_t*)(ws + WS_WO) + (size_t)(l - NPOOL) * DM * DM; for (int k = lane; k < DM; k += 64) s += bf2f(T1[(size_t)row * DM + k]) * bf2f(W[(size_t)col * DM + k]); mul = 1.0f; }
        else { const int gg = col >> 9, d = col & 511; const bf16_t* W = (const bf16_t*)(ws + WS_WPOOL + (size_t)l * SZ_WPOOL) + (size_t)gg * 512 * 512; for (int c = lane; c < 512; c += 64) s += bf2f(T1[(size_t)row * DM + gg * 512 + c]) * bf2f(W[(size_t)d * 512 + c]); mul = a.in[11][l * DM + col]; }
        s = wsum(s); const float bv = (a.kind == 2 && firstD) ? a.in[0][(size_t)row * DM + col] : bf2f(XOLD[(size_t)row * DM + col]); const float ref = bv + mul * s;
        if (lane == 0) { rec(res, a.phase, bf2f(XB[(size_t)row * DM + col]), bfr(ref), 0.05f); if (a.phase == N_PHASES - 1) rec(res, a.phase, a.out[(size_t)row * DM + col], ref, 0.05f); }
        float sq = 0.f; for (int k = lane; k < DM; k += 64) { const float v = bf2f(XB[(size_t)row * DM + k]); sq += v * v; } sq = wsum(sq);
        float sp = lane < 32 ? SSQ[(size_t)row * 32 + lane] : 0.f; sp = wsum(sp); if (lane == 0) rec(res, a.phase, sp, sq, 1e-3f);
        return;
    }
    if (a.kind == 3) {
        const int t = (gw & 1) ? (h0 % 40) : (h0 % SEQ), c = hash32(h0 + 1) % DM, w = 2 << (c >> 9); float sum = 0.f, self = 0.f;
        for (int s = t - w + 1; s <= t; ++s) if (s >= 0) { const float rs = row_rstd_b(XB, s, lane); const float z = bf2f(XB[(size_t)s * DM + c]) * rs; sum += z; if (s == t) self = z; }
        const int cnt = (t + 1 < w) ? t + 1 : w; if (lane == 0) rec(res, a.phase, bf2f(T1[(size_t)t * DM + c]), sum / cnt - self, 0.02f);
        return;
    }
    if (a.kind == 5 || a.kind == 8) {
        const int row = h0 % SEQ, hh = hash32(h0 + 1) % NH, which = (a.kind == 8) ? (int)(hash32(h0 + 2) & 1) : 0;
        const float rs = row_rstd_b(XB, row, lane);
        const bf16_t* W = (a.kind == 5) ? (const bf16_t*)(ws + WS_WQ) + (size_t)(l - NPOOL) * DM * DM : (const bf16_t*)(ws + WS_WKV) + (size_t)which * DM * DM;
        const float* gain = (a.kind == 5) ? a.in[17] + (l - NPOOL) * HD : a.in[15];
        const bf16_t* O = (const bf16_t*)(ws + (a.kind == 5 ? WS_QH : (which ? WS_VH : WS_KH)));
        float v0 = 0.f, v1 = 0.f;
        for (int k = 0; k < DM; ++k) { const float xv = bf2f(XB[(size_t)row * DM + k]); v0 += xv * bf2f(W[(size_t)(hh * HD + lane) * DM + k]); v1 += xv * bf2f(W[(size_t)(hh * HD + lane + 64) * DM + k]); }
        v0 *= rs; v1 *= rs;
        if (!(a.kind == 8 && which == 1)) { const float ss = wsum(v0 * v0 + v1 * v1); const float rn = 1.0f / sqrtf(ss / HD + EPS); v0 *= rn * gain[lane]; v1 *= rn * gain[lane + 64]; }
        rec(res, a.phase, bf2f(O[((size_t)hh * SEQ + row) * HD + lane]), v0, 0.05f); rec(res, a.phase, bf2f(O[((size_t)hh * SEQ + row) * HD + lane + 64]), v1, 0.05f);
        return;
    }
    if (a.kind == 6) {
        const int row = (gw & 1) ? (h0 % 700) : (h0 % SEQ), hh = hash32(h0 + 1) % NH, c = row >> 6, k0 = (c - 8) * 64 > 0 ? (c - 8) * 64 : 0, k1 = (c + 1) * 64;
        const bf16_t* Q = (const bf16_t*)(ws + WS_QH) + ((size_t)hh * SEQ + row) * HD; const bf16_t* K = (const bf16_t*)(ws + WS_KH) + (size_t)hh * SEQ * HD; const bf16_t* V = (const bf16_t*)(ws + WS_VH) + (size_t)hh * SEQ * HD;
        const float* rel = a.in[18] + ((size_t)(l - NPOOL) * NH + hh) * NREL;
        float sc[9]; float mx = -1e30f;
        for (int j = 0; j < 9; ++j) { const int k = k0 + lane + 64 * j; sc[j] = -1e30f; if (k < k1) { float d = 0.f; for (int e = 0; e < HD; ++e) d += bf2f(Q[e]) * bf2f(K[(size_t)k * HD + e]);
            int r = row - k; r = r < -63 ? -63 : (r > 128 ? 128 : r); sc[j] = d * 0.08838834764831845f + rel[r + 63]; mx = fmaxf(mx, sc[j]); } }
        for (int o = 32; o >= 1; o >>= 1) mx = fmaxf(mx, __shfl_xor(mx, o));
        float den = 0.f; for (int j = 0; j < 9; ++j) { sc[j] = (sc[j] > -1e29f) ? expf(sc[j] - mx) : 0.f; den += sc[j]; } den = wsum(den);
        float o0 = 0.f, o1 = 0.f;
        for (int j = 0; j < 9; ++j) for (int src = 0; src < 64; ++src) { const float p = __shfl(sc[j], src); const int k = k0 + src + 64 * j; if (k < k1) { o0 += p * bf2f(V[(size_t)k * HD + lane]); o1 += p * bf2f(V[(size_t)k * HD + lane + 64]); } }
        rec(res, a.phase, bf2f(T1[(size_t)row * DM + hh * HD + lane]), o0 / den, 0.05f); rec(res, a.phase, bf2f(T1[(size_t)row * DM + hh * HD + lane + 64]), o1 / den, 0.05f);
        return;
    }
}
__global__ void chk_final(unsigned char* ws, float* out, int nph) {
    const unsigned* res = (const unsigned*)(ws + WS_RES);
    if (threadIdx.x == 0 && blockIdx.x == 0) { for (int p = 28; p < 34; ++p) { const float e = __uint_as_float(res[p]); if (e > 0.06f) { out[0] = (float)(p + 1) * 1e6f; return; } }
        for (int p = 0; p < nph; ++p) { const float e = __uint_as_float(res[p]); const float tol = 0.06f; if (e > tol) { out[0] = (float)(p + 1) * 1e6f; break; } } }
}
#endif

extern "C" void kernel_launch(void* const* d_in, const int* in_sizes, int n_in, void* d_out, int out_size, void* d_ws, size_t ws_size, hipStream_t stream) {
    static int grid = 0;
    if (grid == 0) {
        if (n_in != 20 || in_sizes[0] != SEQ * DM || out_size != SEQ * DM || ws_size < WS_END + (DUPMASK ? 100 * MiB : 0)) {
            fprintf(stderr, "kernel_launch: unexpected shapes (n_in %d, in0 %d, out %d, ws %zu < %zu); nothing launched\n", n_in, n_in > 0 ? in_sizes[0] : -1, out_size, ws_size, (size_t)WS_END); grid = -1; return; }
        int dev = 0, cus = 0, per_cu = 0;
        if (hipGetDevice(&dev) != hipSuccess || hipDeviceGetAttribute(&cus, hipDeviceAttributeMultiprocessorCount, dev) != hipSuccess) { fprintf(stderr, "kernel_launch: device query failed\n"); grid = -1; return; }
        if (hipFuncSetAttribute((const void*)fwd_kernel, hipFuncAttributeMaxDynamicSharedMemorySize, LDS_BYTES) != hipSuccess) { fprintf(stderr, "kernel_launch: hipFuncSetAttribute failed\n"); grid = -1; return; }
        if (hipOccupancyMaxActiveBlocksPerMultiprocessor(&per_cu, (const void*)fwd_kernel, NWAVES * 64, LDS_BYTES) != hipSuccess || per_cu < 1)
            fprintf(stderr, "kernel_launch: note: occupancy query reports %d workgroups per CU\n", per_cu);
        (void)hipGetLastError();
        grid = cus;
    }
    if (grid < 0) return;
    if (hipMemsetAsync((char*)d_ws + WS_CTL, 0, CTL_ZERO_BYTES, stream) != hipSuccess) { fprintf(stderr, "kernel_launch: memset failed\n"); return; }
    Args a{};
    for (int i = 0; i < 20; ++i) a.in[i] = (const float*)d_in[i];
    a.out = (float*)d_out; a.ws = (unsigned char*)d_ws;
#if MK_DEBUG
    {
        int kinds[N_PHASES], ls[N_PHASES], fs[N_PHASES], n = 0;
        kinds[n] = 0; ls[n] = 0; fs[n] = 0; ++n;
        for (int l = 0; l < DEPTH; ++l) { for (int f = 0; f < 2; ++f) { kinds[n] = 1; ls[n] = l; fs[n] = f; ++n; kinds[n] = 2; ls[n] = l; fs[n] = f; ++n;
            if (f == 0) { if (l < NPOOL) { kinds[n] = 3; ls[n] = l; fs[n] = f; ++n; kinds[n] = 4; ls[n] = l; fs[n] = f; ++n; } else { kinds[n] = 5; ls[n] = l; fs[n] = f; ++n; kinds[n] = 6; ls[n] = l; fs[n] = f; ++n; kinds[n] = 7; ls[n] = l; fs[n] = f; ++n; } } }
            if (l == NPOOL - 1) { kinds[n] = 8; ls[n] = l; fs[n] = 1; ++n; } }
        if (ws_size < WS_RES + 4096) { fprintf(stderr, "debug build: workspace too small\n"); return; }
        hipMemsetAsync((char*)d_ws + WS_RES, 0, 4096, stream);
        for (int p = 0; p < N_PHASES; ++p) {
            if ((kinds[p] == 2 || kinds[p] == 4 || kinds[p] == 7) && !(kinds[p] == 2 && ls[p] == 0 && fs[p] == 0)) hipMemcpyAsync((char*)d_ws + WS_XOLD, (char*)d_ws + WS_XB, (size_t)SEQ * DM * 2, hipMemcpyDeviceToDevice, stream);
            a.ph_lo = p; a.ph_hi = p + 1; hipLaunchKernelGGL(fwd_kernel, dim3(grid), dim3(NWAVES * 64), LDS_BYTES, stream, a);
            ChkArgs c{}; for (int i = 0; i < 20; ++i) c.in[i] = (const float*)d_in[i]; c.out = (float*)d_out; c.ws = (unsigned char*)d_ws; c.phase = p; c.kind = kinds[p]; c.l = ls[p]; c.f = fs[p];
            hipLaunchKernelGGL(chk_kernel, dim3(256), dim3(256), 0, stream, c);
        }
        hipLaunchKernelGGL(chk_final, dim3(1), dim3(64), 0, stream, (unsigned char*)d_ws, (float*)d_out, (int)N_PHASES);
    }
#elif MK_PER_PHASE
    for (int p = 0; p < N_PHASES; ++p) { a.ph_lo = p; a.ph_hi = p + 1; hipLaunchKernelGGL(fwd_kernel, dim3(grid), dim3(NWAVES * 64), LDS_BYTES, stream, a); }
#else
    a.ph_lo = 0; a.ph_hi = N_PHASES;
    hipLaunchKernelGGL(fwd_kernel, dim3(grid), dim3(NWAVES * 64), LDS_BYTES, stream, a);
#endif
    const hipError_t le = hipPeekAtLastError();
    if (le != hipSuccess) fprintf(stderr, "kernel_launch: launch failed: %s\n", hipGetErrorName(le));
}
```

```cpp
#include <hip/hip_runtime.h>
#include <hip/hip_bf16.h>
#include <cstdio>
#include <cstdint>

#ifndef MK_DEBUG
#define MK_DEBUG 0
#endif
#ifndef MK_PER_PHASE
#define MK_PER_PHASE MK_DEBUG
#endif

#ifndef PHMASK
#define PHMASK 0x3ff
#endif
#define PH_ON(k) (((PHMASK) >> (k)) & 1)
#ifndef MK_CLK
#define MK_CLK 0
#endif
#ifndef DUPMASK
#define DUPMASK 0
#endif
#define DUP_ON(k) (((DUPMASK) >> (k)) & 1)
#define DUP_LOOP(k) for (int rep_ = 0; rep_ < (DUP_ON(k) ? 2 : 1); ++rep_)
#define DUP3_LOOP(k) for (int rep_ = 0; rep_ < (DUP_ON(k) ? 3 : 1); ++rep_)
#define DUP3_BAR(k) if (DUP_ON(k) && rep_ < 2) GRID_BAR();
#define DUP3_SIGN (rep_ == 1 ? -1.0f : 1.0f)
#define DUP_BAR(k) if (DUP_ON(k) && rep_ == 0) GRID_BAR();
#define GAS __attribute__((address_space(1)))
#define LAS __attribute__((address_space(3)))
typedef unsigned short bf16_t;
typedef short bf16x8 __attribute__((ext_vector_type(8)));
typedef short s16x4 __attribute__((ext_vector_type(4)));
typedef float f32x4 __attribute__((ext_vector_type(4)));
typedef float f32x16 __attribute__((ext_vector_type(16)));
typedef unsigned u32x4 __attribute__((ext_vector_type(4)));
typedef unsigned u32x2 __attribute__((ext_vector_type(2)));
typedef GAS unsigned gu32;

constexpr int SEQ = 8192, DM = 2048, DFF = 5504, NH = 16, HD = 128, DEPTH = 4, NPOOL = 2, NATT = 2;
constexpr int NGU = 2 * DFF;
constexpr int NREL = 192;
#ifndef FP8_SETS
#define FP8_SETS 0x00
#endif
#ifndef FP8_O
#define FP8_O 1
#endif
#ifndef FP8_QKV
#define FP8_QKV 1
#endif
#ifndef FP8_D_SETS
#define FP8_D_SETS 0x80
#endif
#ifndef FP8_FIRST_LAYER
#define FP8_FIRST_LAYER 4
#endif
__host__ __device__ constexpr bool use8(int set) { return ((FP8_SETS >> set) & 1) != 0; }
__host__ __device__ constexpr bool use8d(int set) { return (((FP8_SETS | FP8_D_SETS) >> set) & 1) != 0; }
static_assert((FP8_D_SETS & ~0x80) == 0, "only the last half-step's down GEMM has an FP8-down code path");
static_assert(FP8_SETS == ((0xff << (2 * FP8_FIRST_LAYER)) & 0xff), "FP8_SETS = the sets of layers >= FP8_FIRST_LAYER");
constexpr int DFF8 = 5632;
constexpr float SO8 = 64.0f;
constexpr float SX8 = 0.25f, SWGU8 = 32.0f, SH8 = 8.0f, SWD8 = 64.0f;
constexpr float EPS = 1e-6f;
constexpr int NWAVES = 8;

constexpr size_t MiB = 1u << 20;
constexpr size_t WS_CTL = 0, CTL_ZERO_BYTES = 1 * MiB;
constexpr size_t WS_SSQ = 1 * MiB;
constexpr size_t WS_WGU = 2 * MiB;
constexpr size_t SZ_WGU = (size_t)NGU * DM * 2;
constexpr size_t WS_WD = WS_WGU + 8 * SZ_WGU;
constexpr size_t SZ_WD = (size_t)DM * DFF * 2;
constexpr size_t WS_WPOOL = WS_WD + 8 * SZ_WD;
constexpr size_t SZ_WPOOL = (size_t)4 * 512 * 512 * 2;
constexpr size_t WS_WKV = WS_WPOOL + 2 * SZ_WPOOL;
constexpr size_t WS_WQ = WS_WKV + (size_t)2 * DM * DM * 2;
constexpr size_t WS_WO = WS_WQ + (size_t)2 * DM * DM * 2;
constexpr size_t SZ_ACT = (size_t)SEQ * DM * 2;
constexpr size_t WS_XB = WS_WO + (size_t)2 * DM * DM * 2;
constexpr size_t WS_HB = WS_XB + SZ_ACT;
constexpr size_t WS_T1 = WS_HB + (size_t)SEQ * DFF * 2;
constexpr size_t WS_QH = WS_T1 + SZ_ACT;
constexpr size_t WS_KH = WS_QH + SZ_ACT;
constexpr size_t WS_VH = WS_KH + SZ_ACT;
constexpr size_t WS_XB8 = WS_VH + SZ_ACT;
constexpr size_t WS_H8 = WS_XB8 + (size_t)SEQ * DM;
constexpr size_t WS_END = WS_H8 + (size_t)SEQ * DFF8;
static_assert(SZ_WGU % 16 == 0 && SZ_WD % 16 == 0 && WS_XB % 256 == 0 && WS_HB % 256 == 0, "alignment");
constexpr int CW_TMO = 0, CW_CODE = 1;
constexpr int CW_BAR = 4096;

constexpr int RING_OFF = 0, RING_BYTES = 131072;
constexpr int LDSCTL_OFF = RING_BYTES, MISC_OFF = LDSCTL_OFF + 320;
constexpr int RSTD_OFF = 131584;
constexpr int HP_OFF = RSTD_OFF + 8192;
constexpr int LDS_BYTES = 155648;
static_assert(HP_OFF + 8192 <= LDS_BYTES && MISC_OFF + 128 <= RSTD_OFF, "LDS map");

#define RLX_AGENT __ATOMIC_RELAXED, __HIP_MEMORY_SCOPE_AGENT
#define LDS_WAIT() asm volatile("s_waitcnt lgkmcnt(0)" ::: "memory")
#define VM_WAIT() asm volatile("s_waitcnt vmcnt(0)" ::: "memory")
__device__ __forceinline__ unsigned f2bf(float f) { unsigned u = __builtin_bit_cast(unsigned, f); return (u + 0x7fffu + ((u >> 16) & 1u)) >> 16; }
__device__ __forceinline__ unsigned pk2(float lo, float hi) { return f2bf(lo) | (f2bf(hi) << 16); }
__device__ __forceinline__ unsigned cvt_pk_bf16(float lo, float hi) { unsigned r; asm volatile("v_cvt_pk_bf16_f32 %0, %1, %2" : "=v"(r) : "v"(lo), "v"(hi)); return r; }
__device__ __forceinline__ int lane_now() { int l; asm volatile("v_mbcnt_lo_u32_b32 %0, -1, 0\n\tv_mbcnt_hi_u32_b32 %0, -1, %0" : "=v"(l)); return l; }
__device__ __forceinline__ unsigned pk4_fp8(float a, float b, float c, float d) {
    a = __builtin_amdgcn_fmed3f(a, -448.f, 448.f); b = __builtin_amdgcn_fmed3f(b, -448.f, 448.f); c = __builtin_amdgcn_fmed3f(c, -448.f, 448.f); d = __builtin_amdgcn_fmed3f(d, -448.f, 448.f);
    int r = 0; r = __builtin_amdgcn_cvt_pk_fp8_f32(a, b, r, false); r = __builtin_amdgcn_cvt_pk_fp8_f32(c, d, r, true); return (unsigned)r; }
__device__ __forceinline__ int opaque_s(int x) { asm volatile("" : "+s"(x)); return x; }
__device__ __forceinline__ float xor16_add(float v) { return v + __builtin_bit_cast(float, __builtin_amdgcn_ds_swizzle(__builtin_bit_cast(int, v), 0x401F)); }
__device__ __forceinline__ float xor32_add(float v, int lane) { return v + __builtin_bit_cast(float, __builtin_amdgcn_ds_bpermute((lane ^ 32) << 2, __builtin_bit_cast(int, v))); }
__device__ __forceinline__ float xor1_get(float v) { return __builtin_bit_cast(float, __builtin_amdgcn_mov_dpp(__builtin_bit_cast(int, v), 0xB1, 0xF, 0xF, true)); }
__device__ __forceinline__ float wave_sum(float v, int lane) {
    v += __builtin_bit_cast(float, __builtin_amdgcn_ds_swizzle(__builtin_bit_cast(int, v), 0x041F));
    v += __builtin_bit_cast(float, __builtin_amdgcn_ds_swizzle(__builtin_bit_cast(int, v), 0x081F));
    v += __builtin_bit_cast(float, __builtin_amdgcn_ds_swizzle(__builtin_bit_cast(int, v), 0x101F));
    v += __builtin_bit_cast(float, __builtin_amdgcn_ds_swizzle(__builtin_bit_cast(int, v), 0x201F));
    v = xor16_add(v);
    return xor32_add(v, lane);
}

#ifndef PG8_ASM_DMA
#define PG8_ASM_DMA 1
#endif
namespace pg8 {
constexpr int BM = 256, BK = 64, HALF = 128, HTB = HALF * BK * 2, STAGE_BYTES = 8 * HTB, NXCD = 8, WGM = 4;
__host__ __device__ __forceinline__ int lds_byte(int r, int c) { const int st = (r >> 4) * 2 + (c >> 5), rr = r & 15, cc = c & 31, ob = rr * 64 + cc * 2; return st * 1024 + (ob ^ (((ob >> 9) & 1) << 5)); }
__host__ __device__ __forceinline__ void stage_rc(int b, int& R, int& C) { const int st = b / 1024, sb = b % 1024, swz = sb ^ (((sb >> 9) & 1) << 5); R = (st >> 1) * 16 + swz / 64; C = (st & 1) * 32 + (swz % 64) / 2; }
__host__ __device__ __forceinline__ int perm32(int rho) { const int n = rho >> 4, i = rho & 15; return 8 * (i >> 2) + 4 * n + (i & 3); }

struct Unit { int pm, pn; };
struct Gemm { const bf16_t* A; const bf16_t* Bt; int lda, ldb, K; };

struct StaticOrder {
    int nM, nN, nwg, G, c;
    __host__ __device__ void init(int M, int N, int G_, int c_) { nM = M / BM; nN = N / BM; nwg = nM * nN; G = G_; c = c_; }
    __host__ __device__ bool next(int i, Unit& u) const {
        const long L = (long)i * G + c; if (L >= nwg) return false;
        int wgid = (int)L; { const int q = nwg / NXCD, r = nwg % NXCD, xcd = wgid % NXCD, off = wgid / NXCD; wgid = (xcd < r ? xcd * (q + 1) : r * (q + 1) + (xcd - r) * q) + off; }
        const int nig = WGM * nN, gid = wgid / nig, fm = gid * WGM, gsz = (nM - fm) < WGM ? (nM - fm) : WGM;
        u.pm = fm + ((wgid % nig) % gsz); u.pn = (wgid % nig) / gsz; return true;
    }
};
struct PlainTiles {
    __device__ __forceinline__ size_t a_off(const Unit& u, int lda) const { return (size_t)u.pm * BM * lda; }
    __device__ __forceinline__ size_t b_off(const Unit& u, int ldb) const { return (size_t)u.pn * BM * ldb; }
};
struct PoolTiles {
    __device__ __forceinline__ size_t a_off(const Unit& u, int lda) const { return (size_t)u.pm * BM * lda + (size_t)(u.pn >> 1) * 512; }
    __device__ __forceinline__ size_t b_off(const Unit& u, int ldb) const { return (size_t)(u.pn >> 1) * 512 * 512 + (size_t)(u.pn & 1) * BM * ldb; }
};

typedef int i32x4v __attribute__((ext_vector_type(4)));
typedef int i32x8v __attribute__((ext_vector_type(8)));
__device__ __forceinline__ i32x8v cat8(bf16x8 a, bf16x8 b) { const i32x4v x = __builtin_bit_cast(i32x4v, a), y = __builtin_bit_cast(i32x4v, b); return __builtin_shufflevector(x, y, 0, 1, 2, 3, 4, 5, 6, 7); }
template <class Epi, class Tiles, bool F8 = false>
__device__ __forceinline__ void gemm_phase(LAS unsigned char* lds, int wave_id, const Gemm g, const StaticOrder& S, const Tiles& T, const Epi& E) {
    const int lane = lane_now(), wid = opaque_s(wave_id), tid = wid * 64 + lane, wr = wid >> 2, wc = wid & 3, fr = lane & 15, fq = lane >> 4;
    const int K = g.K, nt = K / BK;
    unsigned voffA[2], voffB[2];
#pragma unroll
    for (int i = 0; i < 2; ++i) { int R, C; stage_rc(tid * 16 + i * 8192, R, C); const int Rb = Epi::PERM ? ((R & ~31) + perm32(R & 31)) : R;
        voffA[i] = (unsigned)(R * g.lda + C) * 2u; voffB[i] = (unsigned)(Rb * g.ldb + C) * 2u; }
    const size_t kstep = (size_t)(BK * 2);
    const size_t hstepA = (size_t)HALF * g.lda * 2, hstepB = (size_t)HALF * g.ldb * 2;
    const unsigned ldsw = (unsigned)wid * 1024u;
    const unsigned lds_base32 = (unsigned)(size_t)lds;
    const int aoff = lds_byte(wr * 64 + fr, fq * 8), boff = lds_byte(wc * 32 + fr, fq * 8);
#define PG8_SA(b, h) (((b) * 2 + (h)) * HTB)
#define PG8_SB(b, h) ((4 + (b) * 2 + (h)) * HTB)
#define PG8_STAGE(bufoff, gbase, voff) do { if constexpr (F8 || PG8_ASM_DMA) { _Pragma("unroll") for (int _i = 0; _i < 2; ++_i) { unsigned _keep; \
        asm volatile("s_mov_b32 %0, m0\n\ts_mov_b32 m0, %3\n\ts_nop 0\n\tglobal_load_lds_dwordx4 %1, %2\n\ts_mov_b32 m0, %0" : "=&s"(_keep) : "v"((voff)[_i]), "s"((const char*)(gbase)), "s"(lds_base32 + (unsigned)(bufoff) + ldsw + (unsigned)(_i * 8192)) : "memory"); } } \
    else { _Pragma("unroll") for (int _i = 0; _i < 2; ++_i) \
        __builtin_amdgcn_global_load_lds((const unsigned*)((const char*)(gbase) + (voff)[_i]), (LAS unsigned*)(lds + (bufoff) + ldsw + _i * 8192), 16, 0, 0); } } while (0)
#define PG8_LDA(dst, b, h) do { if constexpr (F8) { _Pragma("unroll") for (int m = 0; m < 4; ++m) dst##_8[m] = cat8(*(const LAS bf16x8*)(lds + PG8_SA(b, h) + aoff + m * 2048), *(const LAS bf16x8*)(lds + PG8_SA(b, h) + aoff + m * 2048 + 1024)); } \
        else { _Pragma("unroll") for (int m = 0; m < 4; ++m) _Pragma("unroll") for (int k = 0; k < 2; ++k) dst[m][k] = *(const LAS bf16x8*)(lds + PG8_SA(b, h) + aoff + m * 2048 + k * 1024); } } while (0)
#define PG8_LDB(dst, b, h) do { if constexpr (F8) { _Pragma("unroll") for (int n = 0; n < 2; ++n) dst##_8[n] = cat8(*(const LAS bf16x8*)(lds + PG8_SB(b, h) + boff + n * 2048), *(const LAS bf16x8*)(lds + PG8_SB(b, h) + boff + n * 2048 + 1024)); } \
        else { _Pragma("unroll") for (int n = 0; n < 2; ++n) _Pragma("unroll") for (int k = 0; k < 2; ++k) dst[n][k] = *(const LAS bf16x8*)(lds + PG8_SB(b, h) + boff + n * 2048 + k * 1024); } } while (0)
#define PG8_MMA(ai, bj, At, Bt) do { __builtin_amdgcn_s_setprio(1); if constexpr (F8) { _Pragma("unroll") for (int m = 0; m < 4; ++m) _Pragma("unroll") for (int n = 0; n < 2; ++n) \
        acc[ai][bj][m][n] = __builtin_amdgcn_mfma_scale_f32_16x16x128_f8f6f4(Bt##_8[n], At##_8[m], acc[ai][bj][m][n], 0, 0, 0, 0x7F7F7F7F, 0, 0x7F7F7F7F); } \
        else { _Pragma("unroll") for (int m = 0; m < 4; ++m) _Pragma("unroll") for (int n = 0; n < 2; ++n) _Pragma("unroll") for (int k = 0; k < 2; ++k) \
        acc[ai][bj][m][n] = __builtin_amdgcn_mfma_f32_16x16x32_bf16(Bt[n][k], At[m][k], acc[ai][bj][m][n], 0, 0, 0); } __builtin_amdgcn_s_setprio(0); } while (0)
#define PG8_WAIT_V(n) asm volatile("s_waitcnt vmcnt(" #n ")" ::: "memory")
#define PG8_WAIT_L(n) asm volatile("s_waitcnt lgkmcnt(" #n ")" ::: "memory")
#define PG8_BAR __builtin_amdgcn_s_barrier()
#define PG8_SCHED __builtin_amdgcn_sched_barrier(0)
    Unit cur, nxt; int ui = 0;
    if (!S.next(0, cur)) return;
    f32x4 acc[2][2][4][2];
#pragma unroll
    for (int a = 0; a < 2; ++a)
#pragma unroll
        for (int b = 0; b < 2; ++b)
#pragma unroll
            for (int m = 0; m < 4; ++m)
#pragma unroll
                for (int n = 0; n < 2; ++n) acc[a][b][m][n] = (f32x4){0.f, 0.f, 0.f, 0.f};
    bf16x8 At[4][2], B0[2][2], B1[2][2];
    i32x8v At_8[4], B0_8[2], B1_8[2];
    const char* cA = (const char*)(g.A + T.a_off(cur, g.lda)); const char* cB = (const char*)(g.Bt + T.b_off(cur, g.ldb));
    PG8_STAGE(PG8_SB(0, 0), cB, voffB); PG8_STAGE(PG8_SB(0, 1), cB + hstepB, voffB); PG8_STAGE(PG8_SA(0, 0), cA, voffA); PG8_STAGE(PG8_SA(0, 1), cA + hstepA, voffA);
    if (wr == 1) PG8_BAR;
    PG8_WAIT_V(2); PG8_BAR;
    PG8_STAGE(PG8_SB(1, 0), cB + kstep, voffB); PG8_STAGE(PG8_SA(1, 0), cA + kstep, voffA); PG8_STAGE(PG8_SB(1, 1), cB + hstepB + kstep, voffB);
    PG8_WAIT_V(6); PG8_BAR;
    for (;;) {
        const bool has_next = S.next(ui + 1, nxt);
        const char* nA = has_next ? (const char*)(g.A + T.a_off(nxt, g.lda)) : cA; const char* nB = has_next ? (const char*)(g.Bt + T.b_off(nxt, g.ldb)) : cB;
        for (int t = 0; t < nt; t += 2) {
            const bool last = (t == nt - 2);
            const char* a1 = cA + (size_t)(t + 1) * kstep;
            const char* a2 = last ? nA : cA + (size_t)(t + 2) * kstep; const char* b2 = last ? nB : cB + (size_t)(t + 2) * kstep;
            const char* a3 = a2 + kstep; const char* b3 = b2 + kstep;
            PG8_LDB(B0, 0, 0); PG8_LDB(B1, 0, 1); PG8_SCHED; PG8_LDA(At, 0, 0); PG8_STAGE(PG8_SA(1, 1), a1 + hstepA, voffA);
            PG8_WAIT_V(8); PG8_WAIT_L(0); PG8_BAR; PG8_MMA(0, 0, At, B0); PG8_MMA(0, 1, At, B1); PG8_BAR; PG8_SCHED;
            PG8_LDA(At, 0, 1); PG8_STAGE(PG8_SB(0, 0), b2, voffB); PG8_STAGE(PG8_SB(0, 1), b2 + hstepB, voffB); PG8_STAGE(PG8_SA(0, 0), a2, voffA);
            PG8_WAIT_V(8); PG8_WAIT_L(0); PG8_BAR; PG8_MMA(1, 0, At, B0); PG8_MMA(1, 1, At, B1); PG8_BAR; PG8_SCHED;
            PG8_LDB(B0, 1, 0); PG8_LDB(B1, 1, 1); PG8_SCHED; PG8_LDA(At, 1, 0); PG8_STAGE(PG8_SA(0, 1), a2 + hstepA, voffA);
            PG8_WAIT_V(8); PG8_WAIT_L(0); PG8_BAR; PG8_MMA(0, 0, At, B0); PG8_MMA(0, 1, At, B1); PG8_BAR; PG8_SCHED;
            PG8_LDA(At, 1, 1); PG8_STAGE(PG8_SB(1, 0), b3, voffB); PG8_STAGE(PG8_SB(1, 1), b3 + hstepB, voffB); PG8_STAGE(PG8_SA(1, 0), a3, voffA);
            PG8_WAIT_V(8); PG8_WAIT_L(0); PG8_BAR; PG8_MMA(1, 0, At, B0); PG8_MMA(1, 1, At, B1); PG8_BAR; PG8_SCHED;
        }
        if (wr == 0) PG8_BAR;
        E(acc, cur, ui, wr, wc, fr, fq, lds);
        if (!has_next) break;
#pragma unroll
        for (int a = 0; a < 2; ++a)
#pragma unroll
            for (int b = 0; b < 2; ++b)
#pragma unroll
                for (int m = 0; m < 4; ++m)
#pragma unroll
                    for (int n = 0; n < 2; ++n) acc[a][b][m][n] = (f32x4){0.f, 0.f, 0.f, 0.f};
        cur = nxt; cA = nA; cB = nB; ++ui;
        if (wr == 1) PG8_BAR;
    }
    PG8_WAIT_V(0);
    PG8_BAR;
#undef PG8_SA
#undef PG8_SB
#undef PG8_STAGE
#undef PG8_LDA
#undef PG8_LDB
#undef PG8_MMA
#undef PG8_WAIT_V
#undef PG8_WAIT_L
#undef PG8_BAR
#undef PG8_SCHED
}

__device__ __forceinline__ float silu_mul(float g, float u) {
    const float e = __builtin_amdgcn_exp2f(g * -1.4426950408889634f);
    return g * u * __builtin_amdgcn_rcpf(1.0f + e);
}
__device__ __forceinline__ f32x4 swiglu4(const f32x4 g, const f32x4 u, float c1, float k) {
    const f32x4 t = g * c1;
    const f32x4 e = {__builtin_amdgcn_exp2f(t[0]), __builtin_amdgcn_exp2f(t[1]), __builtin_amdgcn_exp2f(t[2]), __builtin_amdgcn_exp2f(t[3])};
    const f32x4 kv = {k, k, k, k};
    const f32x4 d = __builtin_elementwise_fma(e, kv, kv);
    const f32x4 r = {__builtin_amdgcn_rcpf(d[0]), __builtin_amdgcn_rcpf(d[1]), __builtin_amdgcn_rcpf(d[2]), __builtin_amdgcn_rcpf(d[3])};
    return (g * u) * r;
}
struct EpiSwiGLU {
    static constexpr bool PERM = true;
    bf16_t* H; unsigned char* H8; float desc;
    __device__ __forceinline__ void operator()(const f32x4 (&acc)[2][2][4][2], const Unit& u, int ui, int wr, int wc, int fr, int fq, LAS unsigned char* lds) const {
        const LAS float* tab = (const LAS float*)(lds + RSTD_OFF) + ui * 256;
        int fr_ = fr; asm volatile("" : "+v"(fr_));
        const int rl0 = wr * 64 + fr_, col0 = u.pn * 128 + wc * 32 + 8 * fq;
#pragma unroll
        for (int ai = 0; ai < 2; ++ai)
#pragma unroll
            for (int m = 0; m < 4; ++m) {
                const int rl = ai * HALF + rl0 + m * 16; const float rs = tab[rl] * desc;
                const float c1 = rs * -1.4426950408889634f, kk = __builtin_amdgcn_rcpf((rs * rs) * (H8 ? SH8 : 1.0f));
                const f32x4 h0 = swiglu4(acc[ai][0][m][0], acc[ai][1][m][0], c1, kk), h1 = swiglu4(acc[ai][0][m][1], acc[ai][1][m][1], c1, kk);
                if (H8) {
                    u32x2 w8; w8.x = pk4_fp8(h0[0], h0[1], h0[2], h0[3]); w8.y = pk4_fp8(h1[0], h1[1], h1[2], h1[3]);
                    *(u32x2*)(H8 + (size_t)(u.pm * BM + rl) * DFF8 + col0) = w8;
                } else {
                    u32x4 w;
                    w.x = cvt_pk_bf16(h0[0], h0[1]); w.y = cvt_pk_bf16(h0[2], h0[3]); w.z = cvt_pk_bf16(h1[0], h1[1]); w.w = cvt_pk_bf16(h1[2], h1[3]);
                    *(u32x4*)(H + (size_t)(u.pm * BM + rl) * DFF + col0) = w;
                }
            }
    }
};
__device__ __forceinline__ f32x4 bf4_lo(unsigned a, unsigned b) { return (f32x4){__builtin_bit_cast(float, a << 16), __builtin_bit_cast(float, a & 0xffff0000u), __builtin_bit_cast(float, b << 16), __builtin_bit_cast(float, b & 0xffff0000u)}; }
struct EpiRes {
    static constexpr bool PERM = true;
    const bf16_t* baseb; const float* basef; bf16_t* xb; float* outf; float* ssq; const float* cscale; float alpha; unsigned char* xb8;
    __device__ __forceinline__ void operator()(const f32x4 (&acc)[2][2][4][2], const Unit& u, int ui, int wr, int wc, int fr, int fq, LAS unsigned char* lds) const {
        const int ln_ = lane_now(), fr_ = ln_ & 15, fq_ = ln_ >> 4;
        const int rl0 = wr * 64 + fr_, col0 = u.pn * BM + wc * 32 + 8 * fq_;
        f32x4 cs[2][2];
        const float al = __builtin_bit_cast(float, opaque_s(__builtin_bit_cast(int, alpha)));
#pragma unroll
        for (int bj = 0; bj < 2; ++bj)
#pragma unroll
            for (int n = 0; n < 2; ++n) { cs[bj][n] = cscale ? *(const f32x4*)(cscale + col0 + bj * HALF + n * 4) * al : (f32x4){al, al, al, al}; }
#pragma unroll
        for (int ai = 0; ai < 2; ++ai)
#pragma unroll
            for (int m = 0; m < 4; ++m) {
                const int row = u.pm * BM + ai * HALF + rl0 + m * 16; const size_t off = (size_t)row * DM + col0; float ss = 0.f;
#pragma unroll
                for (int bj = 0; bj < 2; ++bj) {
                    f32x4 b0, b1;
                    if (basef) { b0 = *(const f32x4*)(basef + off + bj * HALF); b1 = *(const f32x4*)(basef + off + bj * HALF + 4); }
                    else { const u32x4 w = *(const u32x4*)(baseb + off + bj * HALF); b0 = bf4_lo(w.x, w.y); b1 = bf4_lo(w.z, w.w); }
                    const f32x4 o0 = b0 + acc[ai][bj][m][0] * cs[bj][0], o1 = b1 + acc[ai][bj][m][1] * cs[bj][1];
                    if (outf) { *(f32x4*)(outf + off + bj * HALF) = o0; *(f32x4*)(outf + off + bj * HALF + 4) = o1; }
                    u32x4 r; r.x = cvt_pk_bf16(o0[0], o0[1]); r.y = cvt_pk_bf16(o0[2], o0[3]); r.z = cvt_pk_bf16(o1[0], o1[1]); r.w = cvt_pk_bf16(o1[2], o1[3]);
                    *(u32x4*)(xb + off + bj * HALF) = r;
                    if (xb8) { u32x2 r8; r8.x = pk4_fp8(o0[0] * SX8, o0[1] * SX8, o0[2] * SX8, o0[3] * SX8); r8.y = pk4_fp8(o1[0] * SX8, o1[1] * SX8, o1[2] * SX8, o1[3] * SX8); *(u32x2*)(xb8 + off + bj * HALF) = r8; }
                    const f32x4 v0 = bf4_lo(r.x, r.y), v1 = bf4_lo(r.z, r.w);
                    ss += ((v0[0] * v0[0] + v0[1] * v0[1]) + (v0[2] * v0[2] + v0[3] * v0[3])) + ((v1[0] * v1[0] + v1[1] * v1[1]) + (v1[2] * v1[2] + v1[3] * v1[3]));
                }
                ss = xor16_add(ss); ss = xor32_add(ss, ln_);
                if (fq_ == 0) ssq[(size_t)row * 32 + u.pn * 4 + wc] = ss;
                asm volatile("" ::: "memory");
            }
    }
};
struct EpiHead {
    static constexpr bool PERM = true;
    bf16_t* dst0; bf16_t* dst1; const float* gain; int nnorm; float desc;
    __device__ __forceinline__ void operator()(const f32x4 (&acc)[2][2][4][2], const Unit& u, int ui, int wr, int wc, int fr, int fq, LAS unsigned char* lds) const {
        const LAS float* tab = (const LAS float*)(lds + RSTD_OFF) + ui * 256;
        LAS float* HP = (LAS float*)(lds + HP_OFF);
        const int ln_ = lane_now(), fr_ = ln_ & 15, fq_ = ln_ >> 4;
        const int rl0 = wr * 64 + fr_, d0 = wc * 32 + 8 * fq_;
        const bool norm = u.pn < nnorm; const int pnl = norm ? u.pn : u.pn - nnorm; bf16_t* dst = norm ? dst0 : dst1;
        if (norm) {
#pragma unroll
            for (int ai = 0; ai < 2; ++ai)
#pragma unroll
                for (int m = 0; m < 4; ++m) {
                    const int rl = ai * HALF + rl0 + m * 16; const float rs = tab[rl] * desc;
#pragma unroll
                    for (int bj = 0; bj < 2; ++bj) {
                        const f32x4 a = acc[ai][bj][m][0] * rs, b = acc[ai][bj][m][1] * rs;
                        float s = ((a[0] * a[0] + a[1] * a[1]) + (a[2] * a[2] + a[3] * a[3])) + ((b[0] * b[0] + b[1] * b[1]) + (b[2] * b[2] + b[3] * b[3]));
                        s = xor16_add(s); s = xor32_add(s, fq_ * 16 + fr_);
                        if (fq_ == 0) HP[(rl * 2 + bj) * 4 + wc] = s;
                    }
                }
            asm volatile("s_waitcnt lgkmcnt(0)" ::: "memory"); __builtin_amdgcn_s_barrier(); asm volatile("" ::: "memory");
        }
        f32x4 gv0 = {1.f, 1.f, 1.f, 1.f}, gv1 = {1.f, 1.f, 1.f, 1.f};
        if (norm) { gv0 = *(const f32x4*)(gain + d0); gv1 = *(const f32x4*)(gain + d0 + 4); }
#pragma unroll
        for (int ai = 0; ai < 2; ++ai)
#pragma unroll
            for (int m = 0; m < 4; ++m) {
                const int rl = ai * HALF + rl0 + m * 16; const float rs = tab[rl] * desc;
#pragma unroll
                for (int bj = 0; bj < 2; ++bj) {
                    float sc = rs;
                    if (norm) { const f32x4 p = *(const LAS f32x4*)(HP + (rl * 2 + bj) * 4); sc = rs * __builtin_amdgcn_rsqf(((p[0] + p[1]) + (p[2] + p[3])) * (1.0f / 128.0f) + EPS); }
                    const f32x4 a = acc[ai][bj][m][0] * sc * gv0, b = acc[ai][bj][m][1] * sc * gv1;
                    u32x4 w; w.x = cvt_pk_bf16(a[0], a[1]); w.y = cvt_pk_bf16(a[2], a[3]); w.z = cvt_pk_bf16(b[0], b[1]); w.w = cvt_pk_bf16(b[2], b[3]);
                    *(u32x4*)(dst + ((size_t)(2 * pnl + bj) * SEQ + (size_t)(u.pm * BM + rl)) * HD + d0) = w;
                }
            }
    }
};
}

namespace att {
constexpr int NW = 8, QBLK = 32, KVBLK = 64, QB = NW * QBLK, D = 128;
constexpr int SHM_V = KVBLK * D * 2, SHM_K = KVBLK * D * 2;
constexpr int WS_OFF = 2 * SHM_V + 2 * SHM_K, ETAB_OFF = WS_OFF + NW * 64 * 4, ATT_LDS = ETAB_OFF + 256 * 4;
static_assert(ATT_LDS <= RING_BYTES, "attention LDS inside the ring region");
constexpr float SCALE = 0.08838834764831845f, THR = 8.f;
#define KSWZ(row, colB) ((row) * 256 + ((colB) ^ (((row) & 7) << 4)))
#define SBAR() __builtin_amdgcn_sched_barrier(0)
__device__ __forceinline__ int v_st(int k, int c) { const int kk = (k & ~0xC) | ((k & 4) << 1) | ((k & 8) >> 1); return ((kk >> 3) * 4 + (c >> 5)) * 512 + ((kk & 7) * 32 + (c & 31)) * 2; }
__device__ __forceinline__ int v_rd_base(int lane) { return ((lane & 3) << 3) | (((lane >> 2) & 3) << 6) | (((lane >> 4) & 1) << 5) | (((lane >> 5) & 1) << 8); }
constexpr int v_rd_off(int d0, int ks, int half) { return d0 * 512 + ks * 4096 + half * 2048; }
__device__ __forceinline__ int crow(int r, int hi) { return (r & 3) + 8 * (r >> 2) + 4 * hi; }
__device__ __forceinline__ unsigned cvtpk(float lo, float hi) { unsigned r; asm volatile("v_cvt_pk_bf16_f32 %0, %1, %2" : "=v"(r) : "v"(lo), "v"(hi)); return r; }
__device__ __forceinline__ bf16x8 load8(const bf16_t* p) { return *reinterpret_cast<const bf16x8*>(p); }

__device__ __forceinline__ void partialSM(f32x16& p0, f32x16& p1, float& m_reg, float& mn, float& alpha) {
    float pmax = p0[0]; for (int r = 1; r < 16; ++r) pmax = fmaxf(pmax, p0[r]); for (int r = 0; r < 16; ++r) pmax = fmaxf(pmax, p1[r]);
    { auto rr = __builtin_amdgcn_permlane32_swap(__float_as_uint(pmax), __float_as_uint(pmax), false, false);
      pmax = fmaxf(__uint_as_float(rr[0]), __uint_as_float(rr[1])); }
    constexpr float C2 = 1.4426950408889634f * SCALE;
    if (__builtin_expect(__all((pmax - m_reg) * SCALE <= THR), 1)) { mn = m_reg; alpha = 1.f; }
    else { mn = fmaxf(m_reg, pmax); alpha = __builtin_amdgcn_exp2f((m_reg - mn) * C2); m_reg = mn; }
    const float mnL = -mn * C2;
    for (int r = 0; r < 16; ++r) p0[r] = fmaf(p0[r], C2, mnL); for (int r = 0; r < 16; ++r) p1[r] = fmaf(p1[r], C2, mnL);
    for (int r = 0; r < 16; ++r) p0[r] = __builtin_amdgcn_exp2f(p0[r]);
}
__device__ __forceinline__ void finishSM(f32x16& p0, f32x16& p1, float alpha, float& l_reg, bf16x8& pa0, bf16x8& pa1, bf16x8& pa2, bf16x8& pa3) {
    for (int r = 0; r < 16; ++r) p1[r] = __builtin_amdgcn_exp2f(p1[r]);
    float ps = 0; for (int r = 0; r < 16; ++r) ps += p0[r]; for (int r = 0; r < 16; ++r) ps += p1[r];
    { auto rr = __builtin_amdgcn_permlane32_swap(__float_as_uint(ps), __float_as_uint(ps), false, false);
      ps = __uint_as_float(rr[0]) + __uint_as_float(rr[1]); }
    l_reg = l_reg * alpha + ps;
#define PK4(P, B_, OUT) do { unsigned a0 = cvtpk(P[B_+0], P[B_+1]), a1 = cvtpk(P[B_+2], P[B_+3]);                          \
        unsigned b0 = cvtpk(P[B_+4], P[B_+5]), b1 = cvtpk(P[B_+6], P[B_+7]);                                             \
        auto r0 = __builtin_amdgcn_permlane32_swap(a0, b0, false, false); auto r1 = __builtin_amdgcn_permlane32_swap(a1, b1, false, false); \
        u32x4 w = {r0[0], r1[0], r0[1], r1[1]}; OUT = *reinterpret_cast<bf16x8*>(&w); } while (0)
    PK4(p0, 0, pa0); PK4(p0, 8, pa1); PK4(p1, 0, pa2); PK4(p1, 8, pa3);
#undef PK4
}
template <int KB>
__device__ __forceinline__ void qkt(f32x16& p0, f32x16& p1, const char* K_lds, int r32, int hi, const bf16x8* qr, bool act, int delta, const float* etab, int wodd, float c191) {
    if (!act) { const float NEG = -__builtin_inff();
#pragma unroll
        for (int r = 0; r < 16; ++r) { p0[r] = NEG; p1[r] = NEG; } return; }
    if (delta >= 3) {
#pragma unroll
        for (int r = 0; r < 16; ++r) { p0[r] = c191; p1[r] = c191; }
    } else {
        const float* e = etab + (wodd * 32 + r32 + 4 - 4 * hi) + 64 * delta;
#pragma unroll
        for (int r = 0; r < 16; ++r) { const int c = (r & 3) + 8 * (r >> 2); p0[r] = e[59 - c]; p1[r] = e[27 - c]; }
    }
    const char* kb[4];
#pragma unroll
    for (int dd = 0; dd < 4; ++dd) kb[dd] = K_lds + KB * SHM_K + KSWZ(r32, (dd * 16 + hi * 8) * 2);
#pragma unroll
    for (int d0 = 0; d0 < 8; ++d0) { const char* a = kb[d0 & 3] + (d0 >> 2) * 128;
        bf16x8 b0 = *reinterpret_cast<const bf16x8*>(a);
        bf16x8 b1 = *reinterpret_cast<const bf16x8*>(a + 32 * 256);
        p0 = __builtin_amdgcn_mfma_f32_32x32x16_bf16(b0, qr[d0], p0, 0, 0, 0);
        p1 = __builtin_amdgcn_mfma_f32_32x32x16_bf16(b1, qr[d0], p1, 0, 0, 0); }
}
template <int VB>
__device__ __forceinline__ void pv_tile(f32x16* o, int vb0, bf16x8 pa0, bf16x8 pa1, bf16x8 pa2, bf16x8 pa3, bool act) {
    if (!act) return;
#define TRRD(dst, off) asm volatile("ds_read_b64_tr_b16 %0, %1 offset:%2" : "=&v"(dst) : "v"(vb0), "i"(off) : "memory")
#define PV_D0(d0) do { s16x4 l0, l1, l2, l3, h0, h1, h2, h3; constexpr int b_ = VB * SHM_V + v_rd_off(d0, 0, 0); \
        TRRD(l0, b_); TRRD(h0, b_ + 2048); TRRD(l1, b_ + 4096); TRRD(h1, b_ + 6144); TRRD(l2, b_ + 8192); TRRD(h2, b_ + 10240); TRRD(l3, b_ + 12288); TRRD(h3, b_ + 14336); \
        asm volatile("s_waitcnt lgkmcnt(0)" ::: "memory"); SBAR();   \
        o[d0] = __builtin_amdgcn_mfma_f32_32x32x16_bf16(pa0, (bf16x8){l0[0], l0[1], l0[2], l0[3], h0[0], h0[1], h0[2], h0[3]}, o[d0], 0, 0, 0);   \
        o[d0] = __builtin_amdgcn_mfma_f32_32x32x16_bf16(pa1, (bf16x8){l1[0], l1[1], l1[2], l1[3], h1[0], h1[1], h1[2], h1[3]}, o[d0], 0, 0, 0);   \
        o[d0] = __builtin_amdgcn_mfma_f32_32x32x16_bf16(pa2, (bf16x8){l2[0], l2[1], l2[2], l2[3], h2[0], h2[1], h2[2], h2[3]}, o[d0], 0, 0, 0);   \
        o[d0] = __builtin_amdgcn_mfma_f32_32x32x16_bf16(pa3, (bf16x8){l3[0], l3[1], l3[2], l3[3], h3[0], h3[1], h3[2], h3[3]}, o[d0], 0, 0, 0); } while (0)
    PV_D0(0); PV_D0(1); PV_D0(2); PV_D0(3);
#undef PV_D0
#undef TRRD
}
struct BlockRef { const bf16_t* Q; const bf16_t* K; const bf16_t* V; bf16_t* O; const float* rel; int P0; };
struct Seam { bf16x8 qr[8]; bf16x8 st_v0, st_v1, st_k0, st_k1; };
__device__ __forceinline__ int jlo_of(int P0) { const int c = P0 / KVBLK - 8; return c > 0 ? c : 0; }
#define ROW(p, k0, rr) ((p) + (size_t)((k0) + (rr)) * D + sc)
#define VMW() asm volatile("s_waitcnt vmcnt(0)" ::: "memory")
#define VMWN(n) asm volatile("s_waitcnt vmcnt(%0)" :: "i"(n) : "memory")
#define SLOAD_H(Kp, Vp, k0) do { S.st_v0 = load8(ROW(Vp, k0, sr)); S.st_v1 = load8(ROW(Vp, k0, 32 + sr));              \
                         S.st_k0 = load8(ROW(Kp, k0, sr)); S.st_k1 = load8(ROW(Kp, k0, 32 + sr)); } while (0)
#define SWRITE_HK(bf) do { *(bf16x8*)(K_lds + (bf) * SHM_K + kws) = S.st_k0; *(bf16x8*)(K_lds + (bf) * SHM_K + kws + 32 * 256) = S.st_k1; } while (0)
#define SWRITE_HV(bf) do { *(bf16x8*)(V_lds + (bf) * SHM_V + vst0) = S.st_v0; *(bf16x8*)(V_lds + (bf) * SHM_V + vst1) = S.st_v1; } while (0)
#define SWRITE_H(bf) do { SWRITE_HV(bf); SWRITE_HK(bf); } while (0)
__device__ __forceinline__ void etab_write(char* lds, const float* rel, int tid) {
    if (tid < 256) { const int i = tid < NREL - 1 ? tid : NREL - 1; ((float*)(lds + ETAB_OFF))[tid] = rel[i] * (1.0f / SCALE); }
}
__device__ __forceinline__ void attn_prime(const BlockRef& cur, char* lds, Seam& S, int wid) {
    const int lane = lane_now(), tid = wid * 64 + lane, r32 = lane & 31, hi = lane >> 5;
    const int sr = tid >> 4, sc = (tid & 15) * 8, kws = KSWZ(sr, sc * 2); char* K_lds = lds + 2 * SHM_V;
    const int kb0 = jlo_of(cur.P0) * KVBLK;
    for (int d0 = 0; d0 < 8; ++d0) S.qr[d0] = load8(cur.Q + (size_t)(wid * QBLK + r32) * D + d0 * 16 + hi * 8);
    SLOAD_H(cur.K, cur.V, kb0); VMW(); SWRITE_HK(0);
    etab_write(lds, cur.rel, tid);
    __syncthreads();
}
__device__ __forceinline__ void attn_block(const BlockRef& cur, const BlockRef& nxt, char* lds, Seam& S, int wid) {
    const int lane = lane_now(), tid = wid * 64 + lane, r32 = lane & 31, hi = lane >> 5;
    const int j_lo = jlo_of(cur.P0), j_hi = cur.P0 / KVBLK + QB / KVBLK;
    const int NT = j_hi - j_lo;
    const int kbn = jlo_of(nxt.P0) * KVBLK;
    const int cw = cur.P0 / KVBLK + (wid >> 1);
    char* V_lds = lds; char* K_lds = lds + 2 * SHM_V;
    float* ws = (float*)(lds + WS_OFF) + wid * 64; float* li_l = ws, * al_l = ws + 32;
    const float* etab = (const float*)(lds + ETAB_OFF); const int wodd = wid & 1;
    const float c191 = __builtin_bit_cast(float, __builtin_amdgcn_readfirstlane(__builtin_bit_cast(int, etab[255])));
    float m_reg = -1e30f, l_reg = 0; f32x16 o[4] = {};
    const int sr = tid >> 4, sc = (tid & 15) * 8, vst0 = v_st(sr, sc), vst1 = v_st(32 + sr, sc), kws = KSWZ(sr, sc * 2);
    const int vb0 = (int)(uintptr_t)V_lds + v_rd_base(lane);
    const bf16_t* Kh = cur.K; const bf16_t* Vh = cur.V;
#define RESC(a) do { if (__any((a) < 1.f)) { if (hi == 0) al_l[r32] = (a); asm volatile("s_waitcnt lgkmcnt(0)" ::: "memory");              \
                     for (int d_ = 0; d_ < 4; ++d_) for (int r = 0; r < 16; ++r) o[d_][r] *= al_l[crow(r, hi)]; } } while (0)
#define KBASE(t) ((j_lo + (t)) * KVBLK)
#define DLT(t) (cw - (j_lo + (t)))
#define ACT(t) (DLT(t) >= 0 && DLT(t) <= 8)
    constexpr int NQL = 8;
#define SEAM_K0() do { VMWN(NQL); SWRITE_HK(0); SBAR(); } while (0)
    f32x16 pA0, pA1, pB0, pB1; float mnA, mnB, alA, alB; bf16x8 pa0, pa1, pa2, pa3;
    SWRITE_HV(0); SBAR();
    if (NT > 1) { SLOAD_H(Kh, Vh, KBASE(1)); }
    SBAR(); qkt<0>(pA0, pA1, K_lds, r32, hi, S.qr, ACT(0), DLT(0), etab, wodd, c191);
    partialSM(pA0, pA1, m_reg, mnA, alA);
    if (NT > 1) { VMW(); SWRITE_H(1); }
    __syncthreads();
#define HALF_STEP(PX0, PX1, mnX, alX, PY0, PY1, alY, t, KB, VB, SB) do {                                                      \
        SBAR(); qkt<KB>(PX0, PX1, K_lds, r32, hi, S.qr, ACT(t), DLT(t), etab, wodd, c191);                                             \
        finishSM(PY0, PY1, alY, l_reg, pa0, pa1, pa2, pa3); SBAR();                                                           \
        if ((t) + 1 < NT) { SLOAD_H(Kh, Vh, KBASE((t) + 1)); SBAR(); }                                                         \
        pv_tile<VB>(o, vb0, pa0, pa1, pa2, pa3, ACT((t) - 1)); partialSM(PX0, PX1, m_reg, mnX, alX);                           \
        __syncthreads();                                                                                                      \
        if ((t) + 1 < NT) { VMW(); SWRITE_H(SB); }                                                                            \
        RESC(alX); __syncthreads(); } while (0)
    for (int t = 1; t + 1 < NT; t += 2) {
        HALF_STEP(pB0, pB1, mnB, alB, pA0, pA1, alA, t, 1, 0, 0);
        HALF_STEP(pA0, pA1, mnA, alA, pB0, pB1, alB, t + 1, 0, 1, 1);
    }
    const bool even = (NT & 1) == 0;
    if (even) { SBAR(); qkt<1>(pB0, pB1, K_lds, r32, hi, S.qr, ACT(NT - 1), DLT(NT - 1), etab, wodd, c191); SBAR(); }
    SLOAD_H(nxt.K, nxt.V, kbn); SBAR();
#pragma unroll
    for (int d0 = 0; d0 < 8; ++d0) S.qr[d0] = load8(nxt.Q + (size_t)(wid * QBLK + r32) * D + d0 * 16 + hi * 8);
    SBAR();
    finishSM(pA0, pA1, alA, l_reg, pa0, pa1, pa2, pa3); SBAR();
    pv_tile<0>(o, vb0, pa0, pa1, pa2, pa3, ACT(even ? NT - 2 : NT - 1));
    if (even) { partialSM(pB0, pB1, m_reg, mnB, alB); __syncthreads(); RESC(alB);
        finishSM(pB0, pB1, alB, l_reg, pa0, pa1, pa2, pa3); SBAR(); pv_tile<1>(o, vb0, pa0, pa1, pa2, pa3, ACT(NT - 1)); }
    SBAR(); SEAM_K0();
    if (nxt.rel != cur.rel) etab_write(lds, nxt.rel, tid);
    if (hi == 0) li_l[r32] = l_reg; asm volatile("s_waitcnt lgkmcnt(0)" ::: "memory");
    float rli[16];
#pragma unroll
    for (int r = 0; r < 16; ++r) rli[r] = __builtin_amdgcn_rcpf(li_l[crow(r, hi)]);
    if constexpr (FP8_O != 0) {
        unsigned char* Ow8 = (unsigned char*)cur.O + (size_t)(wid * QBLK) * DM;
#pragma unroll
        for (int r = 0; r < 16; ++r) { const int orow = crow(r, hi);
#pragma unroll
            for (int d0 = 0; d0 < 4; ++d0) { const float v = o[d0][r] * (rli[r] * SO8);
                const float v1 = __builtin_bit_cast(float, __builtin_amdgcn_mov_dpp(__builtin_bit_cast(int, v), 0x39, 0xF, 0xF, true));
                const float v2 = __builtin_bit_cast(float, __builtin_amdgcn_mov_dpp(__builtin_bit_cast(int, v), 0x4E, 0xF, 0xF, true));
                const float v3 = __builtin_bit_cast(float, __builtin_amdgcn_mov_dpp(__builtin_bit_cast(int, v), 0x93, 0xF, 0xF, true));
                if ((r32 & 3) == 0) *(unsigned*)(Ow8 + (size_t)orow * DM + d0 * 32 + r32) = pk4_fp8(v, v1, v2, v3); } }
    } else {
    bf16_t* Ow = cur.O + (size_t)(wid * QBLK) * DM;
#pragma unroll
    for (int r = 0; r < 16; ++r) { const int orow = crow(r, hi);
#pragma unroll
        for (int d0 = 0; d0 < 4; ++d0) { const float v = o[d0][r] * rli[r];
            const float vn = xor1_get(v);
            if ((r32 & 1) == 0) *(unsigned*)(Ow + (size_t)orow * DM + d0 * 32 + r32) = cvtpk(v, vn); } }
    }
    __syncthreads();
#undef RESC
#undef KBASE
#undef DLT
#undef ACT
#undef SEAM_K0
#undef HALF_STEP
}
#undef ROW
#undef VMW
#undef VMWN
#undef SLOAD_H
#undef SWRITE_HK
#undef SWRITE_HV
#undef SWRITE_H
}

#define XB_TMO      128
#define XB_XCNT(j)  (256  + 64 * (j))
#define XB_XSUB(j)  (1280 + 64 * (j))
#define XB_XGEN(j)  (2304 + 64 * (j))
#define XB_TOP      3328
#define XB_TOPGEN   3392
#define XCD_BAR_WORDS 3456
#define XB_SPIN_CAP (1u << 18)
__device__ __forceinline__ unsigned xb_ld(unsigned* p)              { return __hip_atomic_load(p, __ATOMIC_RELAXED, __HIP_MEMORY_SCOPE_AGENT); }
__device__ __forceinline__ unsigned xb_add(unsigned* p, unsigned v) { return __hip_atomic_fetch_add(p, v, __ATOMIC_RELAXED, __HIP_MEMORY_SCOPE_AGENT); }
__device__ __forceinline__ unsigned xb_xcc_id() { return (unsigned)__builtin_amdgcn_s_getreg((3 << 11) | 20) & 0xFu; }
#define XB_SPIN(cond, bar) do { unsigned _sp = 0; while (cond) { __builtin_amdgcn_s_sleep(1); \
    if ((++_sp & 255u) == 0u) { if (xb_ld(&(bar)[XB_TMO])) break; if (_sp > XB_SPIN_CAP) { atomicAdd(&(bar)[XB_TMO], 1u); break; } } } } while (0)
struct XcdBarrier { unsigned* bar; unsigned x; volatile LAS unsigned* st; };
__device__ __forceinline__ XcdBarrier xcd_barrier_post(unsigned* bar, volatile LAS unsigned* st, int tid0) {
    XcdBarrier b; b.bar = bar; b.x = xb_xcc_id(); b.st = st;
    if (tid0 == 0) (void)xb_add(&bar[XB_XCNT(b.x)], 1u);
    return b;
}
__device__ __forceinline__ void xcd_barrier_complete(unsigned* bar, unsigned x, unsigned& nloc, unsigned& nx) {
    const unsigned G = gridDim.x * gridDim.y * gridDim.z;
    unsigned sum, cnt, mine, sp = 0u;
    for (;;) {
        sum = 0u; cnt = 0u; mine = 0u;
#pragma unroll
        for (unsigned j = 0; j < 16; ++j) { const unsigned c = xb_ld(&bar[XB_XCNT(j)]); sum += c; cnt += (c > 0u) ? 1u : 0u; mine = (j == x) ? c : mine; }
        if (sum == G) break;
        __builtin_amdgcn_s_sleep(1);
        if ((++sp & 255u) == 0u) { if (xb_ld(&bar[XB_TMO])) break; if (sp > XB_SPIN_CAP) { atomicAdd(&bar[XB_TMO], 1u); break; } }
    }
    nloc = mine > 0u ? mine : 1u; nx = cnt > 0u ? cnt : 1u;
}
__device__ __forceinline__ void xcd_barrier(const XcdBarrier& b, int wave) {
    asm volatile("s_waitcnt vmcnt(0)" ::: "memory");
    __syncthreads();
    if (wave == 0 && lane_now() == 0) {
        unsigned* bar = b.bar;
        __builtin_amdgcn_s_waitcnt(0);
        unsigned nloc = b.st[0], nx = b.st[1];
        if (nloc == 0u) { xcd_barrier_complete(bar, b.x, nloc, nx); b.st[0] = nloc; b.st[1] = nx; }
        const unsigned old = xb_add(&bar[XB_XSUB(b.x)], 1u);
        const unsigned gen = old / nloc;
        if (old + 1u == (gen + 1u) * nloc) {
            __builtin_amdgcn_fence(__ATOMIC_RELEASE, "agent");
            asm volatile("s_waitcnt vmcnt(0)" ::: "memory");
            const unsigned og = xb_add(&bar[XB_TOP], 1u);
            const unsigned tg = og / nx;
            if (og + 1u == (tg + 1u) * nx) xb_add(&bar[XB_TOPGEN], 1u);
            else XB_SPIN(xb_ld(&bar[XB_TOPGEN]) == tg, bar);
            __builtin_amdgcn_fence(__ATOMIC_ACQUIRE, "agent");
            xb_add(&bar[XB_XGEN(b.x)], 1u);
            asm volatile("s_waitcnt vmcnt(0)" ::: "memory");
        } else {
            XB_SPIN(xb_ld(&bar[XB_XGEN(b.x)]) == gen, bar);
            __builtin_amdgcn_fence(__ATOMIC_ACQUIRE, "agent");
            asm volatile("s_waitcnt vmcnt(0)" ::: "memory");
        }
    }
    __syncthreads();
}

struct Frame {
    LAS unsigned char* lds;
    volatile LAS unsigned* MISC;
    gu32* ctl;
    int wave;
    int vcu, G;
};
struct Args { const float* in[20]; float* out; unsigned char* ws; int ph_lo, ph_hi; };
__device__ __forceinline__ const void* ldptr(LAS unsigned char* lds, int i) {
    volatile LAS unsigned* p = (volatile LAS unsigned*)(lds + LDSCTL_OFF) + 2 * i;
    const unsigned lo = __builtin_amdgcn_readfirstlane(p[0]), hi = __builtin_amdgcn_readfirstlane(p[1]);
    const GAS void* q = (const GAS void*)(((unsigned long long)hi << 32) | lo);
    return (const void*)q;
}
#define IN_PTR(i) ((const float*)ldptr(F.lds, (i)))
#define OUT_PTR() ((float*)ldptr(F.lds, 20))
#define WS_PTR() ((unsigned char*)ldptr(F.lds, 21))

struct TItem { const float* src; const float* gain; bf16_t* dst; int ldw, ldt; unsigned char* dst8; float sc8; };
constexpr int I_GU = (DM / 64) * (DFF / 32);
constexpr int I_D = (DFF / 64) * (DM / 32);
constexpr int I_FFN = 2 * I_GU + I_D;
constexpr int I_P = (512 / 64) * (512 / 32);
constexpr int I_S = (DM / 64) * (DM / 32);
constexpr int N_SMALL = 8 * I_P + 6 * I_S;
__device__ __forceinline__ TItem dec_ffn(Frame& F, int set, int r) {
    TItem t; const int l = set >> 1, f = set & 1; unsigned char* ws = WS_PTR();
    if (r < 2 * I_GU) { const int up = r >= I_GU, item = r - up * I_GU, nnb = DFF / 32, kb = item / nnb, nb = item - kb * nnb, n0 = nb * 32, k0 = kb * 64;
        t.src = IN_PTR((f ? 7 : 2) + up) + (size_t)l * DM * DFF + (size_t)k0 * DFF + n0; t.gain = IN_PTR(f ? 6 : 1) + (size_t)l * DM + k0;
        t.dst = (bf16_t*)(ws + WS_WGU + (size_t)set * SZ_WGU) + (size_t)(256 * (n0 >> 7) + (n0 & 127) + up * 128) * DM + k0; t.ldw = DFF; t.ldt = DM; t.dst8 = nullptr; t.sc8 = 1.f;
        if (use8(set)) { t.dst8 = (ws + WS_WGU + (size_t)set * SZ_WGU) + (size_t)(256 * (n0 >> 7) + (n0 & 127) + up * 128) * DM + k0; t.sc8 = SWGU8; } }
    else { const int item = r - 2 * I_GU, nnb = DM / 32, kb = item / nnb, nb = item - kb * nnb, n0 = nb * 32, k0 = kb * 64;
        t.src = IN_PTR(f ? 9 : 4) + (size_t)l * DFF * DM + (size_t)k0 * DM + n0; t.gain = nullptr;
        t.dst = (bf16_t*)(ws + WS_WD + (size_t)set * SZ_WD) + (size_t)n0 * DFF + k0; t.ldw = DM; t.ldt = DFF; t.dst8 = nullptr; t.sc8 = 1.f;
        if (use8d(set)) { t.dst8 = (ws + WS_WD + (size_t)set * SZ_WD) + (size_t)n0 * DFF8 + k0; t.ldt = DFF8; t.sc8 = SWD8; } }
    return t;
}
__device__ __forceinline__ TItem dec_small(Frame& F, int r) {
    TItem t; unsigned char* ws = WS_PTR();
    if (r < 8 * I_P) { const int q = r / I_P, item = r - q * I_P, l = q >> 2, g = q & 3, kb = item >> 4, nb = item & 15, n0 = nb * 32, k0 = kb * 64;
        t.src = IN_PTR(10) + (size_t)q * 512 * 512 + (size_t)k0 * 512 + n0; t.gain = IN_PTR(5) + (size_t)l * DM + g * 512 + k0;
        t.dst = (bf16_t*)(ws + WS_WPOOL + (size_t)l * SZ_WPOOL) + (size_t)g * 512 * 512 + (size_t)n0 * 512 + k0; t.ldw = 512; t.ldt = 512; t.dst8 = nullptr; t.sc8 = 1.f; }
    else { const int rr = r - 8 * I_P, q = rr / I_S, item = rr - q * I_S, kb = item >> 6, nb = item & 63, n0 = nb * 32, k0 = kb * 64; const float* W; const float* gn; bf16_t* WT;
        if (q == 0) { W = IN_PTR(13); gn = IN_PTR(12); WT = (bf16_t*)(ws + WS_WKV); }
        else if (q == 1) { W = IN_PTR(14); gn = IN_PTR(12); WT = (bf16_t*)(ws + WS_WKV) + (size_t)DM * DM; }
        else if (q < 4) { W = IN_PTR(16) + (size_t)(q - 2) * DM * DM; gn = IN_PTR(5) + (size_t)(NPOOL + q - 2) * DM; WT = (bf16_t*)(ws + WS_WQ) + (size_t)(q - 2) * DM * DM; }
        else { W = IN_PTR(19) + (size_t)(q - 4) * DM * DM; gn = nullptr; WT = (bf16_t*)(ws + WS_WO) + (size_t)(q - 4) * DM * DM; }
        t.src = W + (size_t)k0 * DM + n0; t.gain = gn ? gn + k0 : nullptr; t.dst = WT + (size_t)n0 * DM + k0; t.ldw = DM; t.ldt = DM; t.dst8 = nullptr; t.sc8 = 1.f;
        if (FP8_O && q >= 4) { t.dst8 = (unsigned char*)WT + (size_t)n0 * DM + k0; t.sc8 = SWGU8; }
        if (FP8_QKV && q < 4) { t.dst8 = (q == 1 ? ws + WS_WKV + (size_t)DM * DM : (unsigned char*)WT) + (size_t)n0 * DM + k0; t.sc8 = SWGU8; } }
    return t;
}
template <bool GAIN>
__device__ __forceinline__ void titem_load(const TItem& t, float (&v)[32], f32x4& g0, f32x4& g1, int lane) {
    if constexpr (GAIN) { g0 = *(const f32x4*)(t.gain + 8 * (lane & 7)); g1 = *(const f32x4*)(t.gain + 8 * (lane & 7) + 4); }
    const float* p = t.src + (size_t)(lane >> 5) * t.ldw + (lane & 31);
#pragma unroll
    for (int i = 0; i < 32; ++i) v[i] = __builtin_nontemporal_load(p + (size_t)(2 * i) * t.ldw);
}
template <bool GAIN>
__device__ __forceinline__ void titem_store(const TItem& t, const float (&v)[32], const f32x4& g0, const f32x4& g1, LAS float* scr, int lane) {
    const int c = lane & 7;
#pragma unroll
    for (int i = 0; i < 32; ++i) scr[(2 * i + (lane >> 5)) * 33 + (lane & 31)] = v[i];
    LDS_WAIT(); asm volatile("" ::: "memory");
#pragma unroll
    for (int j = 0; j < 4; ++j) { const int n = (lane >> 3) + 8 * j; const LAS float* s = scr + (8 * c) * 33 + n;
        float e[8];
#pragma unroll
        for (int q = 0; q < 8; ++q) e[q] = s[q * 33];
        if constexpr (GAIN) { e[0] *= g0[0]; e[1] *= g0[1]; e[2] *= g0[2]; e[3] *= g0[3]; e[4] *= g1[0]; e[5] *= g1[1]; e[6] *= g1[2]; e[7] *= g1[3]; }
        if ((FP8_SETS != 0 || FP8_QKV || FP8_O) && t.dst8) { u32x2 o8; o8.x = pk4_fp8(e[0] * t.sc8, e[1] * t.sc8, e[2] * t.sc8, e[3] * t.sc8); o8.y = pk4_fp8(e[4] * t.sc8, e[5] * t.sc8, e[6] * t.sc8, e[7] * t.sc8);
            *(GAS u32x2*)(t.dst8 + (size_t)n * t.ldt + 8 * c) = o8; }
        else { u32x4 o; o.x = cvt_pk_bf16(e[0], e[1]); o.y = cvt_pk_bf16(e[2], e[3]); o.z = cvt_pk_bf16(e[4], e[5]); o.w = cvt_pk_bf16(e[6], e[7]);
            *(GAS u32x4*)(t.dst + (size_t)n * t.ldt + 8 * c) = o; } }
    LDS_WAIT(); asm volatile("" ::: "memory");
}
template <bool SMALL, bool GAIN>
__device__ __forceinline__ void convert_items(Frame& F, int set, int first, int end, int stride) {
    LAS float* scr = (LAS float*)(F.lds + RING_OFF + F.wave * 16384);
    const int lane = lane_now();
    int it = first; if (it >= end) return;
    const float z_ = __builtin_bit_cast(float, opaque_s(0));
    float va[32], vb[32]; f32x4 ga0 = {z_, z_, z_, z_}, ga1 = ga0, gb0 = ga0, gb1 = ga0;
    TItem ta = SMALL ? dec_small(F, it) : dec_ffn(F, set, it);
    titem_load<GAIN>(ta, va, ga0, ga1, lane);
    for (;;) {
        const int nxt = it + stride; const bool more = nxt < end;
        const TItem tb = SMALL ? dec_small(F, more ? nxt : it) : dec_ffn(F, set, more ? nxt : it);
        titem_load<GAIN>(tb, vb, gb0, gb1, lane);
        titem_store<GAIN>(ta, va, ga0, ga1, scr, lane);
        if (!more) break;
        ta = tb; ga0 = gb0; ga1 = gb1;
#pragma unroll
        for (int i = 0; i < 32; ++i) va[i] = vb[i];
        it = nxt;
    }
}
constexpr int N_SMALL_G = 8 * I_P + 4 * I_S;
__device__ __forceinline__ void convert_ffn_set(Frame& F, int set, int worker, int nworkers) {
    convert_items<false, true>(F, set, worker, 2 * I_GU, nworkers);
    convert_items<false, false>(F, set, 2 * I_GU + worker, I_FFN, nworkers);
    if (use8d(set)) {
        unsigned char* wd8 = WS_PTR() + WS_WD + (size_t)set * SZ_WD; const int lane = lane_now(); const unsigned z0 = (unsigned)opaque_s(0);
        for (int r = worker; r < DM; r += nworkers) if (lane < (DFF8 - DFF) / 16) *(GAS u32x4*)(wd8 + (size_t)r * DFF8 + DFF + lane * 16) = (u32x4){z0, z0, z0, z0};
    }
}
__device__ __forceinline__ void p0_prologue(Frame& F) {
    const int lane = lane_now();
    const int gw = F.vcu * NWAVES + F.wave, NGW = F.G * NWAVES;
    unsigned char* ws = WS_PTR();
    convert_ffn_set(F, 0, gw, NGW);
    convert_items<true, true>(F, 0, gw, N_SMALL_G, NGW);
    convert_items<true, false>(F, 0, N_SMALL_G + gw, N_SMALL, NGW);
    const float* x = IN_PTR(0); bf16_t* XB = (bf16_t*)(ws + WS_XB); float* SSQ = (float*)(ws + WS_SSQ);
    for (int m = gw; m < SEQ; m += NGW) {
        const GAS f32x4* xr = (const GAS f32x4*)(x + (size_t)m * DM) + lane;
        GAS u32x2* o8 = (GAS u32x2*)(XB + (size_t)m * DM) + lane;
        float s = 0.f;
#pragma unroll
        for (int j = 0; j < 8; ++j) { const f32x4 v = xr[64 * j]; s += (v[0] * v[0] + v[1] * v[1]) + (v[2] * v[2] + v[3] * v[3]);
            u32x2 w; w.x = pk2(v[0], v[1]); w.y = pk2(v[2], v[3]); o8[64 * j] = w; }
        s = wave_sum(s, lane);
        if (lane < 32) SSQ[(size_t)m * 32 + lane] = lane == 0 ? s : 0.f;
        if ((FP8_SETS | FP8_D_SETS) != 0 && lane < (DFF8 - DFF) / 16) *(GAS u32x4*)(ws + WS_H8 + (size_t)m * DFF8 + DFF + lane * 16) = (u32x4){0u, 0u, 0u, 0u};
    }
}
__device__ __forceinline__ void tail_convert(Frame& F, const pg8::StaticOrder& S, int next_set) {
    if (next_set >= 2 * DEPTH) return;
    const int rounds = (S.nwg + S.G - 1) / S.G, nfull = S.nwg - (rounds - 1) * S.G;
    int worker, nworkers;
    if (nfull >= S.G) { worker = S.c * NWAVES + F.wave; nworkers = S.G * NWAVES; }
    else { if (S.c < nfull) return; worker = (S.c - nfull) * NWAVES + F.wave; nworkers = (S.G - nfull) * NWAVES; }
    convert_ffn_set(F, next_set, worker, nworkers);
}
__device__ __forceinline__ void prep_rstd(Frame& F, const pg8::StaticOrder& S, const float* ssq) {
    LAS float* tab = (LAS float*)(F.lds + RSTD_OFF);
    const int tid_ = F.wave * 64 + lane_now();
    const int row = tid_ >> 1, half = tid_ & 1;
    pg8::Unit u;
    int pm_prev = -1; float v_prev = 0.f;
#pragma unroll 1
    for (int i = 0; i < 8 && S.next(i, u); ++i) {
        if (u.pm != pm_prev) {
            const f32x4* p = (const f32x4*)(ssq + (size_t)(u.pm * 256 + row) * 32 + half * 16);
            const f32x4 a = p[0], b = p[1], c = p[2], d = p[3];
            float s = ((a[0] + a[1]) + (a[2] + a[3])) + ((b[0] + b[1]) + (b[2] + b[3])) + ((c[0] + c[1]) + (c[2] + c[3])) + ((d[0] + d[1]) + (d[2] + d[3]));
            s += xor1_get(s);
            v_prev = __builtin_amdgcn_rsqf(s * (1.0f / DM) + EPS); pm_prev = u.pm;
        }
        if (half == 0) tab[i * 256 + row] = v_prev;
    }
    LDS_WAIT(); __syncthreads();
}
__device__ __forceinline__ float half_sum(float v) {
    v += __builtin_bit_cast(float, __builtin_amdgcn_ds_swizzle(__builtin_bit_cast(int, v), 0x041F));
    v += __builtin_bit_cast(float, __builtin_amdgcn_ds_swizzle(__builtin_bit_cast(int, v), 0x081F));
    v += __builtin_bit_cast(float, __builtin_amdgcn_ds_swizzle(__builtin_bit_cast(int, v), 0x101F));
    v += __builtin_bit_cast(float, __builtin_amdgcn_ds_swizzle(__builtin_bit_cast(int, v), 0x201F));
    return xor16_add(v);
}
template <int W>
__device__ __forceinline__ void pool_diff_block(Frame& F, const bf16_t* x, const float* ssq, bf16_t* diff, int t0, int tid_) {
    LAS float* rt = (LAS float*)(F.lds + RING_OFF);
    const int c4 = tid_ * 4, rr = tid_ >> 5, part = tid_ & 31;
    float pv[3];
#pragma unroll
    for (int j = 0; j < 3; ++j) { const int r = t0 - 16 + rr + 16 * j; pv[j] = ssq[(size_t)(r < 0 ? 0 : r) * 32 + part]; }
    u32x2 xr[31 + W];
#pragma unroll
    for (int i = 0; i < 31 + W; ++i) { const int sr = t0 - W + 1 + i; xr[i] = *(const u32x2*)(x + (size_t)(sr < 0 ? 0 : sr) * DM + c4); }
#pragma unroll
    for (int j = 0; j < 3; ++j) { const int r = t0 - 16 + rr + 16 * j; const float sm = half_sum(pv[j]);
        if (part == 0) rt[rr + 16 * j] = r >= 0 ? __builtin_amdgcn_rsqf(sm * (1.0f / DM) + EPS) : 0.f; }
    LDS_WAIT(); __syncthreads();
    const float z_ = __builtin_bit_cast(float, opaque_s(0));
    f32x4 sum = {z_, z_, z_, z_};
#pragma unroll
    for (int i = 0; i < W - 1; ++i) sum += pg8::bf4_lo(xr[i].x, xr[i].y) * rt[17 - W + i];
    const bool head = t0 == 0;
#pragma unroll
    for (int t = 0; t < 32; ++t) {
        const f32x4 a = pg8::bf4_lo(xr[W - 1 + t].x, xr[W - 1 + t].y) * rt[16 + t];
        sum += a;
        const float inv = __builtin_bit_cast(float, opaque_s(__builtin_bit_cast(int, (t + 1 < W && head) ? 1.0f / (float)(t + 1) : 1.0f / (float)W)));
        const f32x4 o = sum * inv - a;
        u32x2 pk; pk.x = pk2(o[0], o[1]); pk.y = pk2(o[2], o[3]);
        *(u32x2*)(diff + (size_t)(t0 + t) * DM + c4) = pk;
        sum -= pg8::bf4_lo(xr[t].x, xr[t].y) * rt[17 - W + t];
    }
    __syncthreads();
}
__device__ __forceinline__ void pool_diff_phase(Frame& F, const bf16_t* x, const float* ssq, bf16_t* diff) {
    const int lane = lane_now(), tid_ = F.wave * 64 + lane;
    const int g = F.wave >> 1;
    const int vcu_ = opaque_s(F.vcu), G_ = opaque_s(F.G);
    for (int blk = vcu_; blk < SEQ / 32; blk += G_) {
        const int t0 = blk * 32;
        if (g == 0) pool_diff_block<2>(F, x, ssq, diff, t0, tid_);
        else if (g == 1) pool_diff_block<4>(F, x, ssq, diff, t0, tid_);
        else if (g == 2) pool_diff_block<8>(F, x, ssq, diff, t0, tid_);
        else pool_diff_block<16>(F, x, ssq, diff, t0, tid_);
    }
}
__device__ __forceinline__ att::BlockRef attn_ref(int l, const bf16_t* QH, const bf16_t* KH, const bf16_t* VH, bf16_t* AO, const float* rel) {
    att::BlockRef r; const int h = l >> 5, qb = l & 31;
    r.Q = QH + ((size_t)h * SEQ + (size_t)qb * att::QB) * HD; r.K = KH + (size_t)h * SEQ * HD; r.V = VH + (size_t)h * SEQ * HD;
    r.O = FP8_O ? (bf16_t*)((unsigned char*)AO + (size_t)qb * att::QB * DM + h * HD) : AO + (size_t)qb * att::QB * DM + h * HD; r.rel = rel + h * NREL; r.P0 = qb * att::QB; return r;
}
__device__ __forceinline__ void attn_phase(Frame& F, char* lds, const bf16_t* QH, const bf16_t* KH, const bf16_t* VH, bf16_t* AO, const float* rel) {
    const int total = NH * (SEQ / att::QB);
    const int G_ = opaque_s(F.G);
    int L = opaque_s(F.vcu); if (L >= total) return;
    att::BlockRef cur = attn_ref(L, QH, KH, VH, AO, rel);
    att::Seam S;
    att::attn_prime(cur, lds, S, F.wave);
    for (;;) {
        const bool more = L + G_ < total;
        const att::BlockRef nxt = more ? attn_ref(L + G_, QH, KH, VH, AO, rel) : cur;
        att::attn_block(cur, nxt, lds, S, F.wave);
        if (!more) break;
        cur = nxt; L += G_;
    }
}

__global__ void __launch_bounds__(NWAVES * 64, 2) fwd_kernel(Args args) {
    extern __shared__ __attribute__((aligned(16))) unsigned char lds[];
    Frame F;
    F.lds = (LAS unsigned char*)lds;
    F.MISC = (volatile LAS unsigned*)(F.lds + MISC_OFF);
    const int tid0 = threadIdx.x; F.wave = __builtin_amdgcn_readfirstlane(tid0 >> 6);
    F.G = gridDim.x; { const int bx = blockIdx.x; F.vcu = (F.G % 8 == 0) ? (bx % 8) * (F.G / 8) + bx / 8 : bx; }
    if (tid0 < 32) ((LAS unsigned*)(F.lds + MISC_OFF))[tid0] = 0u;
    if (tid0 >= 64 && tid0 < 64 + 44) {
        const __attribute__((address_space(4))) unsigned* ka = (const __attribute__((address_space(4))) unsigned*)__builtin_amdgcn_kernarg_segment_ptr();
        ((LAS unsigned*)(F.lds + LDSCTL_OFF))[tid0 - 64] = ka[tid0 - 64]; }
    __syncthreads();
    F.ctl = (gu32*)(WS_PTR() + WS_CTL);
#if MK_PER_PHASE
#define GRID_BAR() do { } while (0)
#else
    XcdBarrier bar = xcd_barrier_post((unsigned*)(F.ctl + CW_BAR), F.MISC + 8, tid0);
#define GRID_BAR() xcd_barrier(bar, F.wave)
#endif
    const int lo = args.ph_lo, hi = args.ph_hi;
    int pi = 0;
#define PHASE_BEGIN if (pi >= lo && pi < hi) {
#define PHASE_END   if (pi + 1 < hi) GRID_BAR(); } ++pi;
#define WSP(off) (WS_PTR() + (off))

    PHASE_BEGIN if (PH_ON(0)) DUP_LOOP(0) { p0_prologue(F); DUP_BAR(0) } PHASE_END

#define LAYER_BODY(K8, KD8, F0, F1, WITH_KV) \
        for (int f = F0; f < F1; ++f) { \
            PHASE_BEGIN if (PH_ON(1)) DUP_LOOP(1) { \
                pg8::StaticOrder S; S.init(SEQ, NGU, opaque_s(F.G), opaque_s((int)blockIdx.x)); \
                prep_rstd(F, S, (const float*)WSP(WS_SSQ)); \
                if constexpr (K8) { \
                    pg8::Gemm g{(const bf16_t*)WSP(WS_XB8), (const bf16_t*)WSP(WS_WGU + (size_t)(l * 2 + f) * SZ_WGU), DM / 2, DM / 2, DM / 2}; \
                    pg8::EpiSwiGLU E{nullptr, (unsigned char*)WSP(WS_H8), 1.0f / (SX8 * SWGU8)}; \
                    pg8::gemm_phase<pg8::EpiSwiGLU, pg8::PlainTiles, true>(F.lds + RING_OFF, F.wave, g, S, pg8::PlainTiles{}, E); \
                } else { \
                    pg8::Gemm g{(const bf16_t*)WSP(WS_XB), (const bf16_t*)WSP(WS_WGU + (size_t)(l * 2 + f) * SZ_WGU), DM, DM, DM}; \
                    pg8::EpiSwiGLU E{KD8 ? nullptr : (bf16_t*)WSP(WS_HB), KD8 ? (unsigned char*)WSP(WS_H8) : nullptr, 1.0f}; \
                    pg8::gemm_phase(F.lds + RING_OFF, F.wave, g, S, pg8::PlainTiles{}, E); \
                } \
                tail_convert(F, S, l * 2 + f + 1); \
                DUP_BAR(1) \
            } PHASE_END \
            PHASE_BEGIN if (PH_ON(2)) DUP3_LOOP(2) { \
                pg8::StaticOrder S; S.init(SEQ, DM, opaque_s(F.G), opaque_s((int)blockIdx.x)); \
                const bool first = (l == 0 && f == 0 && rep_ == 0), lastp = (l == DEPTH - 1 && f == 1); \
                bf16_t* XB = (bf16_t*)WSP(WS_XB); \
                unsigned char* nx8 = ((f == 1 && l + 1 < DEPTH && use8((l + 1) * 2)) || (FP8_QKV && ((l == NPOOL - 1 && f == 1) || (l >= NPOOL && f == 0)))) ? (unsigned char*)WSP(WS_XB8) : nullptr; \
                if constexpr (K8 || KD8) { \
                    pg8::Gemm g{(const bf16_t*)WSP(WS_H8), (const bf16_t*)WSP(WS_WD + (size_t)(l * 2 + f) * SZ_WD), DFF8 / 2, DFF8 / 2, DFF8 / 2}; \
                    pg8::EpiRes E{first ? nullptr : (const bf16_t*)XB, first ? IN_PTR(0) : nullptr, XB, lastp ? OUT_PTR() : nullptr, (float*)WSP(WS_SSQ), nullptr, 0.5f * DUP3_SIGN / (SH8 * SWD8), nx8}; \
                    pg8::gemm_phase<pg8::EpiRes, pg8::PlainTiles, true>(F.lds + RING_OFF, F.wave, g, S, pg8::PlainTiles{}, E); \
                } else { \
                    pg8::Gemm g{(const bf16_t*)WSP(WS_HB), (const bf16_t*)WSP(WS_WD + (size_t)(l * 2 + f) * SZ_WD), DFF, DFF, DFF}; \
                    pg8::EpiRes E{first ? nullptr : (const bf16_t*)XB, first ? IN_PTR(0) : nullptr, XB, lastp ? OUT_PTR() : nullptr, (float*)WSP(WS_SSQ), nullptr, 0.5f * DUP3_SIGN, nx8}; \
                    pg8::gemm_phase(F.lds + RING_OFF, F.wave, g, S, pg8::PlainTiles{}, E); \
                } \
                DUP3_BAR(2) \
            } PHASE_END \
            if (f == 0) { \
                if (l < NPOOL) { \
                    PHASE_BEGIN if (PH_ON(3)) DUP_LOOP(3) { pool_diff_phase(F, (const bf16_t*)WSP(WS_XB), (const float*)WSP(WS_SSQ), (bf16_t*)WSP(WS_T1)); DUP_BAR(3) } PHASE_END \
                    PHASE_BEGIN if (PH_ON(4)) DUP3_LOOP(4) { \
                        pg8::StaticOrder S; S.init(SEQ, DM, opaque_s(F.G), opaque_s((int)blockIdx.x)); \
                        pg8::Gemm g{(const bf16_t*)WSP(WS_T1), (const bf16_t*)WSP(WS_WPOOL + (size_t)l * SZ_WPOOL), DM, 512, 512}; \
                        bf16_t* XB = (bf16_t*)WSP(WS_XB); \
                        pg8::EpiRes E{XB, nullptr, XB, nullptr, (float*)WSP(WS_SSQ), IN_PTR(11) + (size_t)l * DM, DUP3_SIGN, use8(l * 2 + 1) ? (unsigned char*)WSP(WS_XB8) : nullptr}; \
                        pg8::gemm_phase(F.lds + RING_OFF, F.wave, g, S, pg8::PoolTiles{}, E); \
                        DUP3_BAR(4) \
                    } PHASE_END \
                } else { \
                    const int b = l - NPOOL; \
                    PHASE_BEGIN if (PH_ON(5)) DUP_LOOP(5) { \
                        pg8::StaticOrder S; S.init(SEQ, DM, opaque_s(F.G), opaque_s((int)blockIdx.x)); \
                        prep_rstd(F, S, (const float*)WSP(WS_SSQ)); \
                        bf16_t* QH = (bf16_t*)WSP(WS_QH); \
                        if constexpr (FP8_QKV != 0) { \
                            pg8::Gemm g{(const bf16_t*)WSP(WS_XB8), (const bf16_t*)WSP(WS_WQ) + (size_t)b * DM * DM, DM / 2, DM / 2, DM / 2}; \
                            pg8::EpiHead E{QH, QH, IN_PTR(17) + (size_t)b * HD, 8, 1.0f / (SX8 * SWGU8)}; \
                            pg8::gemm_phase<pg8::EpiHead, pg8::PlainTiles, true>(F.lds + RING_OFF, F.wave, g, S, pg8::PlainTiles{}, E); \
                        } else { \
                            pg8::Gemm g{(const bf16_t*)WSP(WS_XB), (const bf16_t*)WSP(WS_WQ) + (size_t)b * DM * DM, DM, DM, DM}; \
                            pg8::EpiHead E{QH, QH, IN_PTR(17) + (size_t)b * HD, 8, 1.0f}; \
                            pg8::gemm_phase(F.lds + RING_OFF, F.wave, g, S, pg8::PlainTiles{}, E); \
                        } \
                        DUP_BAR(5) \
                    } PHASE_END \
                    PHASE_BEGIN if (PH_ON(6)) DUP_LOOP(6) { attn_phase(F, (char*)lds + RING_OFF, (const bf16_t*)WSP(WS_QH), (const bf16_t*)WSP(WS_KH), (const bf16_t*)WSP(WS_VH), (bf16_t*)WSP(WS_T1), IN_PTR(18) + (size_t)b * NH * NREL); DUP_BAR(6) } PHASE_END \
                    PHASE_BEGIN if (PH_ON(7)) DUP3_LOOP(7) { \
                        pg8::StaticOrder S; S.init(SEQ, DM, opaque_s(F.G), opaque_s((int)blockIdx.x)); \
                        bf16_t* XB = (bf16_t*)WSP(WS_XB); \
                        if constexpr (FP8_O != 0) { \
                            pg8::Gemm g{(const bf16_t*)WSP(WS_T1), (const bf16_t*)WSP(WS_WO) + (size_t)b * DM * DM, DM / 2, DM / 2, DM / 2}; \
                            pg8::EpiRes E{XB, nullptr, XB, nullptr, (float*)WSP(WS_SSQ), nullptr, DUP3_SIGN / (SO8 * SWGU8), use8(l * 2 + 1) ? (unsigned char*)WSP(WS_XB8) : nullptr}; \
                            pg8::gemm_phase<pg8::EpiRes, pg8::PlainTiles, true>(F.lds + RING_OFF, F.wave, g, S, pg8::PlainTiles{}, E); \
                        } else { \
                            pg8::Gemm g{(const bf16_t*)WSP(WS_T1), (const bf16_t*)WSP(WS_WO) + (size_t)b * DM * DM, DM, DM, DM}; \
                            pg8::EpiRes E{XB, nullptr, XB, nullptr, (float*)WSP(WS_SSQ), nullptr, DUP3_SIGN, use8(l * 2 + 1) ? (unsigned char*)WSP(WS_XB8) : nullptr}; \
                            pg8::gemm_phase(F.lds + RING_OFF, F.wave, g, S, pg8::PlainTiles{}, E); \
                        } \
                        DUP3_BAR(7) \
                    } PHASE_END \
                } \
            } \
        } \
        if (WITH_KV && l == NPOOL - 1) { \
            PHASE_BEGIN if (PH_ON(8)) DUP_LOOP(8) { \
                pg8::StaticOrder S; S.init(SEQ, 2 * DM, opaque_s(F.G), opaque_s((int)blockIdx.x)); \
                prep_rstd(F, S, (const float*)WSP(WS_SSQ)); \
                if constexpr (FP8_QKV != 0) { \
                    pg8::Gemm g{(const bf16_t*)WSP(WS_XB8), (const bf16_t*)WSP(WS_WKV), DM / 2, DM / 2, DM / 2}; \
                    pg8::EpiHead E{(bf16_t*)WSP(WS_KH), (bf16_t*)WSP(WS_VH), IN_PTR(15), 8, 1.0f / (SX8 * SWGU8)}; \
                    pg8::gemm_phase<pg8::EpiHead, pg8::PlainTiles, true>(F.lds + RING_OFF, F.wave, g, S, pg8::PlainTiles{}, E); \
                } else { \
                    pg8::Gemm g{(const bf16_t*)WSP(WS_XB), (const bf16_t*)WSP(WS_WKV), DM, DM, DM}; \
                    pg8::EpiHead E{(bf16_t*)WSP(WS_KH), (bf16_t*)WSP(WS_VH), IN_PTR(15), 8, 1.0f}; \
                    pg8::gemm_phase(F.lds + RING_OFF, F.wave, g, S, pg8::PlainTiles{}, E); \
                } \
                DUP_BAR(8) \
            } PHASE_END \
        }
#if FP8_D_SETS
    static_assert(FP8_FIRST_LAYER == DEPTH, "FP8-down of the last half-step: the layers' FFNs are otherwise bf16");
    for (int l = 0; l < DEPTH; ++l) {
        LAYER_BODY(false, false, 0, (l == DEPTH - 1 ? 1 : 2), true)
    }
    {   const int l = opaque_s(DEPTH - 1);
        LAYER_BODY(false, true, 1, 2, false)
    }
#else
    for (int l = 0; l < FP8_FIRST_LAYER; ++l) {
        LAYER_BODY(false, false, 0, 2, true)
    }
    for (int l = FP8_FIRST_LAYER; l < DEPTH; ++l) {
        LAYER_BODY(true, false, 0, 2, true)
    }
#endif
#undef LAYER_BODY
#undef PHASE_BEGIN
#undef PHASE_END
}
constexpr int N_PHASES = 1 + 2 * 6 + 1 + 2 * 7;


#ifndef MK_DEBUG
#define MK_DEBUG 0
#endif
#if MK_DEBUG
constexpr size_t WS_XOLD = WS_END, WS_RES = WS_END + (size_t)SEQ * DM * 4;
struct ChkArgs { const float* in[20]; float* out; unsigned char* ws; int phase, kind, l, f; };
__device__ __forceinline__ float bf2f(bf16_t b) { return __uint_as_float(((unsigned)b) << 16); }
__device__ __forceinline__ float bfr(float x) { return __uint_as_float(f2bf(x) << 16); }
__device__ __forceinline__ unsigned hash32(unsigned x) { x ^= x >> 16; x *= 0x7feb352du; x ^= x >> 15; x *= 0x846ca68bu; x ^= x >> 16; return x; }
__device__ __forceinline__ float wsum(float v) { for (int o = 32; o >= 1; o >>= 1) v += __shfl_xor(v, o); return v; }
__device__ __forceinline__ float row_rstd_b(const bf16_t* XBp, int row, int lane) { float s = 0.f; for (int k = lane; k < DM; k += 64) { const float v = bf2f(XBp[(size_t)row * DM + k]); s += v * v; } s = wsum(s); return 1.0f / sqrtf(s / DM + EPS); }
__device__ __forceinline__ float row_rstd(const float* X, int row, int lane) { float s = 0.f; for (int k = lane; k < DM; k += 64) { const float v = X[(size_t)row * DM + k]; s += v * v; } s = wsum(s); return 1.0f / sqrtf(s / DM + EPS); }
__device__ __forceinline__ void rec(unsigned* res, int phase, float got, float ref, float floor_) { float e = fabsf(got - ref) / (fabsf(ref) + floor_); if (!(e == e)) e = 1e30f; atomicMax(res + phase, __float_as_uint(e)); }
__device__ void chk_ffn_set(const ChkArgs& a, unsigned* res, int slot, int set, unsigned t) {
    unsigned char* ws = a.ws; const int ll = set >> 1, ff = set & 1;
    { const int up = t & 1; const int n = hash32(t + 1) % DFF, k = hash32(t + 2) % DM;
      const float w = a.in[(ff ? 7 : 2) + up][(size_t)ll * DM * DFF + (size_t)k * DFF + n] * a.in[ff ? 6 : 1][ll * DM + k];
      const bf16_t g = ((const bf16_t*)(ws + WS_WGU + (size_t)set * SZ_WGU))[(size_t)(256 * (n >> 7) + (n & 127) + up * 128) * DM + k]; rec(res, slot, bf2f(g), bfr(w), 1e-3f); }
    { const int n = hash32(t + 3) % DM, k = hash32(t + 4) % DFF;
      const float w = a.in[ff ? 9 : 4][(size_t)ll * DFF * DM + (size_t)k * DM + n];
      const bf16_t g = ((const bf16_t*)(ws + WS_WD + (size_t)set * SZ_WD))[(size_t)n * DFF + k]; rec(res, slot, bf2f(g), bfr(w), 1e-3f); }
}
__global__ void chk_kernel(ChkArgs a) {
    const int lane = threadIdx.x & 63, gw = blockIdx.x * (blockDim.x >> 6) + (threadIdx.x >> 6);
    unsigned char* ws = a.ws; unsigned* res = (unsigned*)(ws + WS_RES);
    const bf16_t* XOLD = (const bf16_t*)(ws + WS_XOLD);
    const bf16_t* XB = (const bf16_t*)(ws + WS_XB); const bf16_t* HB = (const bf16_t*)(ws + WS_HB); const bf16_t* T1 = (const bf16_t*)(ws + WS_T1);
    const float* SSQ = (const float*)(ws + WS_SSQ);
    const unsigned h0 = hash32(gw * 7919u + a.phase * 104729u + 17u);
    const int l = a.l, f = a.f;
    if (a.kind == 0) {
        const unsigned t = hash32(h0 + lane * 31u);
        chk_ffn_set(a, res, 28, 0, t); chk_ffn_set(a, res, 29, 0, hash32(t + 99));
        { const int q = t % 8, ll = q >> 2, gg = q & 3; const int d = hash32(t + 5) % 512, c = hash32(t + 6) % 512;
          const float w = a.in[10][(size_t)q * 512 * 512 + (size_t)c * 512 + d] * a.in[5][ll * DM + gg * 512 + c];
          const bf16_t g = ((const bf16_t*)(ws + WS_WPOOL + (size_t)ll * SZ_WPOOL))[(size_t)gg * 512 * 512 + (size_t)d * 512 + c]; rec(res, 30, bf2f(g), bfr(w), 1e-3f); }
        { const int q = t % 6; const int n = hash32(t + 7) % DM, k = hash32(t + 8) % DM; float w; bf16_t g;
          if (q == 0) { w = a.in[13][(size_t)k * DM + n] * a.in[12][k]; g = ((const bf16_t*)(ws + WS_WKV))[(size_t)n * DM + k]; }
          else if (q == 1) { w = a.in[14][(size_t)k * DM + n] * a.in[12][k]; g = ((const bf16_t*)(ws + WS_WKV))[(size_t)(DM + n) * DM + k]; }
          else if (q < 4) { w = a.in[16][(size_t)(q - 2) * DM * DM + (size_t)k * DM + n] * a.in[5][(NPOOL + q - 2) * DM + k]; g = ((const bf16_t*)(ws + WS_WQ))[(size_t)(q - 2) * DM * DM + (size_t)n * DM + k]; }
          else { w = a.in[19][(size_t)(q - 4) * DM * DM + (size_t)k * DM + n]; g = ((const bf16_t*)(ws + WS_WO))[(size_t)(q - 4) * DM * DM + (size_t)n * DM + k]; }
          rec(res, 31, bf2f(g), bfr(w), 1e-3f); }
        { const int row = h0 % SEQ; float s = 0.f, sq = 0.f; for (int k = lane; k < DM; k += 64) { const float v = a.in[0][(size_t)row * DM + k]; sq += v * v; rec(res, 32, bf2f(XB[(size_t)row * DM + k]), bfr(v), 1e-3f); }
          sq = wsum(sq); s = lane < 32 ? SSQ[(size_t)row * 32 + lane] : 0.f; s = wsum(s); if (lane == 0) rec(res, 33, s, sq, 1e-3f); }
        return;
    }
    const bool firstD = (l == 0 && f == 0);
    if (a.kind == 1) {
        const int row = h0 % SEQ, col = hash32(h0 + 1) % DFF; const float rs = firstD ? row_rstd(a.in[0], row, lane) : row_rstd_b(XB, row, lane);
        const bf16_t* W = (const bf16_t*)(ws + WS_WGU + (size_t)(l * 2 + f) * SZ_WGU); const size_t rg = (size_t)(256 * (col >> 7) + (col & 127)) * DM, ru = rg + (size_t)128 * DM;
        float g = 0.f, u = 0.f; for (int k = lane; k < DM; k += 64) { const float xv = bf2f(XB[(size_t)row * DM + k]); g += xv * bf2f(W[rg + k]); u += xv * bf2f(W[ru + k]); }
        g = wsum(g) * rs; u = wsum(u) * rs; const float hh = g / (1.f + expf(-g)) * u;
        if (lane == 0) rec(res, a.phase, bf2f(HB[(size_t)row * DFF + col]), hh, 0.05f);
        if (l * 2 + f + 1 < 2 * DEPTH) chk_ffn_set(a, res, a.phase, l * 2 + f + 1, hash32(h0 + lane * 31u));
        return;
    }
    if (a.kind == 2 || a.kind == 7 || a.kind == 4) {
        const int row = h0 % SEQ, col = hash32(h0 + 1) % DM; float s = 0.f; float mul;
        if (a.kind == 2) { const bf16_t* W = (const bf16_t*)(ws + WS_WD + (size_t)(l * 2 + f) * SZ_WD); for (int k = lane; k < DFF; k += 64) s += bf2f(HB[(size_t)row * DFF + k]) * bf2f(W[(size_t)col * DFF + k]); mul = 0.5f; }
        else if (a.kind == 7) { const bf16_t* W = (const bf16_t*)(ws + WS_WO) + (size_t)(l - NPOOL) * DM * DM; for (int k = lane; k < DM; k += 64) s += bf2f(T1[(size_t)row * DM + k]) * bf2f(W[(size_t)col * DM + k]); mul = 1.0f; }
        else { const int gg = col >> 9, d = col & 511; const bf16_t* W = (const bf16_t*)(ws + WS_WPOOL + (size_t)l * SZ_WPOOL) + (size_t)gg * 512 * 512; for (int c = lane; c < 512; c += 64) s += bf2f(T1[(size_t)row * DM + gg * 512 + c]) * bf2f(W[(size_t)d * 512 + c]); mul = a.in[11][l * DM + col]; }
        s = wsum(s); const float bv = (a.kind == 2 && firstD) ? a.in[0][(size_t)row * DM + col] : bf2f(XOLD[(size_t)row * DM + col]); const float ref = bv + mul * s;
        if (lane == 0) { rec(res, a.phase, bf2f(XB[(size_t)row * DM + col]), bfr(ref), 0.05f); if (a.phase == N_PHASES - 1) rec(res, a.phase, a.out[(size_t)row * DM + col], ref, 0.05f); }
        float sq = 0.f; for (int k = lane; k < DM; k += 64) { const float v = bf2f(XB[(size_t)row * DM + k]); sq += v * v; } sq = wsum(sq);
        float sp = lane < 32 ? SSQ[(size_t)row * 32 + lane] : 0.f; sp = wsum(sp); if (lane == 0) rec(res, a.phase, sp, sq, 1e-3f);
        return;
    }
    if (a.kind == 3) {
        const int t = (gw & 1) ? (h0 % 40) : (h0 % SEQ), c = hash32(h0 + 1) % DM, w = 2 << (c >> 9); float sum = 0.f, self = 0.f;
        for (int s = t - w + 1; s <= t; ++s) if (s >= 0) { const float rs = row_rstd_b(XB, s, lane); const float z = bf2f(XB[(size_t)s * DM + c]) * rs; sum += z; if (s == t) self = z; }
        const int cnt = (t + 1 < w) ? t + 1 : w; if (lane == 0) rec(res, a.phase, bf2f(T1[(size_t)t * DM + c]), sum / cnt - self, 0.02f);
        return;
    }
    if (a.kind == 5 || a.kind == 8) {
        const int row = h0 % SEQ, hh = hash32(h0 + 1) % NH, which = (a.kind == 8) ? (int)(hash32(h0 + 2) & 1) : 0;
        const float rs = row_rstd_b(XB, row, lane);
        const bf16_t* W = (a.kind == 5) ? (const bf16_t*)(ws + WS_WQ) + (size_t)(l - NPOOL) * DM * DM : (const bf16_t*)(ws + WS_WKV) + (size_t)which * DM * DM;
        const float* gain = (a.kind == 5) ? a.in[17] + (l - NPOOL) * HD : a.in[15];
        const bf16_t* O = (const bf16_t*)(ws + (a.kind == 5 ? WS_QH : (which ? WS_VH : WS_KH)));
        float v0 = 0.f, v1 = 0.f;
        for (int k = 0; k < DM; ++k) { const float xv = bf2f(XB[(size_t)row * DM + k]); v0 += xv * bf2f(W[(size_t)(hh * HD + lane) * DM + k]); v1 += xv * bf2f(W[(size_t)(hh * HD + lane + 64) * DM + k]); }
        v0 *= rs; v1 *= rs;
        if (!(a.kind == 8 && which == 1)) { const float ss = wsum(v0 * v0 + v1 * v1); const float rn = 1.0f / sqrtf(ss / HD + EPS); v0 *= rn * gain[lane]; v1 *= rn * gain[lane + 64]; }
        rec(res, a.phase, bf2f(O[((size_t)hh * SEQ + row) * HD + lane]), v0, 0.05f); rec(res, a.phase, bf2f(O[((size_t)hh * SEQ + row) * HD + lane + 64]), v1, 0.05f);
        return;
    }
    if (a.kind == 6) {
        const int row = (gw & 1) ? (h0 % 700) : (h0 % SEQ), hh = hash32(h0 + 1) % NH, c = row >> 6, k0 = (c - 8) * 64 > 0 ? (c - 8) * 64 : 0, k1 = (c + 1) * 64;
        const bf16_t* Q = (const bf16_t*)(ws + WS_QH) + ((size_t)hh * SEQ + row) * HD; const bf16_t* K = (const bf16_t*)(ws + WS_KH) + (size_t)hh * SEQ * HD; const bf16_t* V = (const bf16_t*)(ws + WS_VH) + (size_t)hh * SEQ * HD;
        const float* rel = a.in[18] + ((size_t)(l - NPOOL) * NH + hh) * NREL;
        float sc[9]; float mx = -1e30f;
        for (int j = 0; j < 9; ++j) { const int k = k0 + lane + 64 * j; sc[j] = -1e30f; if (k < k1) { float d = 0.f; for (int e = 0; e < HD; ++e) d += bf2f(Q[e]) * bf2f(K[(size_t)k * HD + e]);
            int r = row - k; r = r < -63 ? -63 : (r > 128 ? 128 : r); sc[j] = d * 0.08838834764831845f + rel[r + 63]; mx = fmaxf(mx, sc[j]); } }
        for (int o = 32; o >= 1; o >>= 1) mx = fmaxf(mx, __shfl_xor(mx, o));
        float den = 0.f; for (int j = 0; j < 9; ++j) { sc[j] = (sc[j] > -1e29f) ? expf(sc[j] - mx) : 0.f; den += sc[j]; } den = wsum(den);
        float o0 = 0.f, o1 = 0.f;
        for (int j = 0; j < 9; ++j) for (int src = 0; src < 64; ++src) { const float p = __shfl(sc[j], src); const int k = k0 + src + 64 * j; if (k < k1) { o0 += p * bf2f(V[(size_t)k * HD + lane]); o1 += p * bf2f(V[(size_t)k * HD + lane + 64]); } }
        rec(res, a.phase, bf2f(T1[(size_t)row * DM + hh * HD + lane]), o0 / den, 0.05f); rec(res, a.phase, bf2f(T1[(size_t)row * DM + hh * HD + lane + 64]), o1 / den, 0.05f);
        return;
    }
}
__global__ void chk_final(unsigned char* ws, float* out, int nph) {
    const unsigned* res = (const unsigned*)(ws + WS_RES);
    if (threadIdx.x == 0 && blockIdx.x == 0) { for (int p = 28; p < 34; ++p) { const float e = __uint_as_float(res[p]); if (e > 0.06f) { out[0] = (float)(p + 1) * 1e6f; return; } }
        for (int p = 0; p < nph; ++p) { const float e = __uint_as_float(res[p]); const float tol = 0.06f; if (e > tol) { out[0] = (float)(p + 1) * 1e6f; break; } } }
}
#endif

extern "C" void kernel_launch(void* const* d_in, const int* in_sizes, int n_in, void* d_out, int out_size, void* d_ws, size_t ws_size, hipStream_t stream) {
    static int grid = 0;
    if (grid == 0) {
        if (n_in != 20 || in_sizes[0] != SEQ * DM || out_size != SEQ * DM || ws_size < WS_END + (DUPMASK ? 100 * MiB : 0)) {
            fprintf(stderr, "kernel_launch: unexpected shapes (n_in %d, in0 %d, out %d, ws %zu < %zu); nothing launched\n", n_in, n_in > 0 ? in_sizes[0] : -1, out_size, ws_size, (size_t)WS_END); grid = -1; return; }
        int dev = 0, cus = 0, per_cu = 0;
        if (hipGetDevice(&dev) != hipSuccess || hipDeviceGetAttribute(&cus, hipDeviceAttributeMultiprocessorCount, dev) != hipSuccess) { fprintf(stderr, "kernel_launch: device query failed\n"); grid = -1; return; }
        if (hipFuncSetAttribute((const void*)fwd_kernel, hipFuncAttributeMaxDynamicSharedMemorySize, LDS_BYTES) != hipSuccess) { fprintf(stderr, "kernel_launch: hipFuncSetAttribute failed\n"); grid = -1; return; }
        if (hipOccupancyMaxActiveBlocksPerMultiprocessor(&per_cu, (const void*)fwd_kernel, NWAVES * 64, LDS_BYTES) != hipSuccess || per_cu < 1)
            fprintf(stderr, "kernel_launch: note: occupancy query reports %d workgroups per CU\n", per_cu);
        (void)hipGetLastError();
        grid = cus;
    }
    if (grid < 0) return;
    if (hipMemsetAsync((char*)d_ws + WS_CTL, 0, CTL_ZERO_BYTES, stream) != hipSuccess) { fprintf(stderr, "kernel_launch: memset failed\n"); return; }
    Args a{};
    for (int i = 0; i < 20; ++i) a.in[i] = (const float*)d_in[i];
    a.out = (float*)d_out; a.ws = (unsigned char*)d_ws;
#if MK_DEBUG
    {
        int kinds[N_PHASES], ls[N_PHASES], fs[N_PHASES], n = 0;
        kinds[n] = 0; ls[n] = 0; fs[n] = 0; ++n;
        for (int l = 0; l < DEPTH; ++l) { for (int f = 0; f < 2; ++f) { kinds[n] = 1; ls[n] = l; fs[n] = f; ++n; kinds[n] = 2; ls[n] = l; fs[n] = f; ++n;
            if (f == 0) { if (l < NPOOL) { kinds[n] = 3; ls[n] = l; fs[n] = f; ++n; kinds[n] = 4; ls[n] = l; fs[n] = f; ++n; } else { kinds[n] = 5; ls[n] = l; fs[n] = f; ++n; kinds[n] = 6; ls[n] = l; fs[n] = f; ++n; kinds[n] = 7; ls[n] = l; fs[n] = f; ++n; } } }
            if (l == NPOOL - 1) { kinds[n] = 8; ls[n] = l; fs[n] = 1; ++n; } }
        if (ws_size < WS_RES + 4096) { fprintf(stderr, "debug build: workspace too small\n"); return; }
        hipMemsetAsync((char*)d_ws + WS_RES, 0, 4096, stream);
        for (int p = 0; p < N_PHASES; ++p) {
            if ((kinds[p] == 2 || kinds[p] == 4 || kinds[p] == 7) && !(kinds[p] == 2 && ls[p] == 0 && fs[p] == 0)) hipMemcpyAsync((char*)d_ws + WS_XOLD, (char*)d_ws + WS_XB, (size_t)SEQ * DM * 2, hipMemcpyDeviceToDevice, stream);
            a.ph_lo = p; a.ph_hi = p + 1; hipLaunchKernelGGL(fwd_kernel, dim3(grid), dim3(NWAVES * 64), LDS_BYTES, stream, a);
            ChkArgs c{}; for (int i = 0; i < 20; ++i) c.in[i] = (const float*)d_in[i]; c.out = (float*)d_out; c.ws = (unsigned char*)d_ws; c.phase = p; c.kind = kinds[p]; c.l = ls[p]; c.f = fs[p];
            hipLaunchKernelGGL(chk_kernel, dim3(256), dim3(256), 0, stream, c);
        }
        hipLaunchKernelGGL(chk_final, dim3(1), dim3(64), 0, stream, (unsigned char*)d_ws, (float*)d_out, (int)N_PHASES);
    }
#elif MK_PER_PHASE
    for (int p = 0; p < N_PHASES; ++p) { a.ph_lo = p; a.ph_hi = p + 1; hipLaunchKernelGGL(fwd_kernel, dim3(grid), dim3(NWAVES * 64), LDS_BYTES, stream, a); }
#else
    a.ph_lo = 0; a.ph_hi = N_PHASES;
    hipLaunchKernelGGL(fwd_kernel, dim3(grid), dim3(NWAVES * 64), LDS_BYTES, stream, a);
#endif
    const hipError_t le = hipPeekAtLastError();
    if (le != hipSuccess) fprintf(stderr, "kernel_launch: launch failed: %s\n", hipGetErrorName(le));
}
```

```cpp
#include <hip/hip_runtime.h>
#include <hip/hip_bf16.h>
#include <cstdio>
#include <cstdint>

#ifndef MK_DEBUG
#define MK_DEBUG 0
#endif
#ifndef MK_PER_PHASE
#define MK_PER_PHASE MK_DEBUG
#endif

#ifndef PHMASK
#define PHMASK 0x3ff
#endif
#define PH_ON(k) (((PHMASK) >> (k)) & 1)
#ifndef MK_CLK
#define MK_CLK 0
#endif
#ifndef DUPMASK
#define DUPMASK 0
#endif
#define DUP_ON(k) (((DUPMASK) >> (k)) & 1)
#define DUP_LOOP(k) for (int rep_ = 0; rep_ < (DUP_ON(k) ? 2 : 1); ++rep_)
#define DUP3_LOOP(k) for (int rep_ = 0; rep_ < (DUP_ON(k) ? 3 : 1); ++rep_)
#define DUP3_BAR(k) if (DUP_ON(k) && rep_ < 2) GRID_BAR();
#define DUP3_SIGN (rep_ == 1 ? -1.0f : 1.0f)
#define DUP_BAR(k) if (DUP_ON(k) && rep_ == 0) GRID_BAR();
#define GAS __attribute__((address_space(1)))
#define LAS __attribute__((address_space(3)))
typedef unsigned short bf16_t;
typedef short bf16x8 __attribute__((ext_vector_type(8)));
typedef short s16x4 __attribute__((ext_vector_type(4)));
typedef float f32x4 __attribute__((ext_vector_type(4)));
typedef float f32x16 __attribute__((ext_vector_type(16)));
typedef unsigned u32x4 __attribute__((ext_vector_type(4)));
typedef unsigned u32x2 __attribute__((ext_vector_type(2)));
typedef GAS unsigned gu32;

constexpr int SEQ = 8192, DM = 2048, DFF = 5504, NH = 16, HD = 128, DEPTH = 4, NPOOL = 2, NATT = 2;
constexpr int NGU = 2 * DFF;
constexpr int NREL = 192;
#ifndef FP8_SETS
#define FP8_SETS 0x00
#endif
#ifndef FP8_O
#define FP8_O 1
#endif
#ifndef FP8_QKV
#define FP8_QKV 1
#endif
#ifndef FP8_D_SETS
#define FP8_D_SETS 0x80
#endif
#ifndef FP8_FIRST_LAYER
#define FP8_FIRST_LAYER 4
#endif
__host__ __device__ constexpr bool use8(int set) { return ((FP8_SETS >> set) & 1) != 0; }
__host__ __device__ constexpr bool use8d(int set) { return (((FP8_SETS | FP8_D_SETS) >> set) & 1) != 0; }
static_assert((FP8_D_SETS & ~0x80) == 0, "only the last half-step's down GEMM has an FP8-down code path");
static_assert(FP8_SETS == ((0xff << (2 * FP8_FIRST_LAYER)) & 0xff), "FP8_SETS = the sets of layers >= FP8_FIRST_LAYER");
constexpr int DFF8 = 5632;
constexpr float SO8 = 64.0f;
constexpr float SX8 = 0.25f, SWGU8 = 32.0f, SH8 = 8.0f, SWD8 = 64.0f;
constexpr float EPS = 1e-6f;
constexpr int NWAVES = 8;

constexpr size_t MiB = 1u << 20;
constexpr size_t WS_CTL = 0, CTL_ZERO_BYTES = 1 * MiB;
constexpr size_t WS_SSQ = 1 * MiB;
constexpr size_t WS_WGU = 2 * MiB;
constexpr size_t SZ_WGU = (size_t)NGU * DM * 2;
constexpr size_t WS_WD = WS_WGU + 8 * SZ_WGU;
constexpr size_t SZ_WD = (size_t)DM * DFF * 2;
constexpr size_t WS_WPOOL = WS_WD + 8 * SZ_WD;
constexpr size_t SZ_WPOOL = (size_t)4 * 512 * 512 * 2;
constexpr size_t WS_WKV = WS_WPOOL + 2 * SZ_WPOOL;
constexpr size_t WS_WQ = WS_WKV + (size_t)2 * DM * DM * 2;
constexpr size_t WS_WO = WS_WQ + (size_t)2 * DM * DM * 2;
constexpr size_t SZ_ACT = (size_t)SEQ * DM * 2;
constexpr size_t WS_XB = WS_WO + (size_t)2 * DM * DM * 2;
constexpr size_t WS_HB = WS_XB + SZ_ACT;
constexpr size_t WS_T1 = WS_HB + (size_t)SEQ * DFF * 2;
constexpr size_t WS_QH = WS_T1 + SZ_ACT;
constexpr size_t WS_KH = WS_QH + SZ_ACT;
constexpr size_t WS_VH = WS_KH + SZ_ACT;
constexpr size_t WS_XB8 = WS_VH + SZ_ACT;
constexpr size_t WS_H8 = WS_XB8 + (size_t)SEQ * DM;
constexpr size_t WS_END = WS_H8 + (size_t)SEQ * DFF8;
static_assert(SZ_WGU % 16 == 0 && SZ_WD % 16 == 0 && WS_XB % 256 == 0 && WS_HB % 256 == 0, "alignment");
constexpr int CW_TMO = 0, CW_CODE = 1;
constexpr int CW_BAR = 4096;

constexpr int RING_OFF = 0, RING_BYTES = 131072;
constexpr int LDSCTL_OFF = RING_BYTES, MISC_OFF = LDSCTL_OFF + 320;
constexpr int RSTD_OFF = 131584;
constexpr int HP_OFF = RSTD_OFF + 8192;
constexpr int LDS_BYTES = 155648;
static_assert(HP_OFF + 8192 <= LDS_BYTES && MISC_OFF + 128 <= RSTD_OFF, "LDS map");

#define RLX_AGENT __ATOMIC_RELAXED, __HIP_MEMORY_SCOPE_AGENT
#define LDS_WAIT() asm volatile("s_waitcnt lgkmcnt(0)" ::: "memory")
#define VM_WAIT() asm volatile("s_waitcnt vmcnt(0)" ::: "memory")
__device__ __forceinline__ unsigned f2bf(float f) { unsigned u = __builtin_bit_cast(unsigned, f); return (u + 0x7fffu + ((u >> 16) & 1u)) >> 16; }
__device__ __forceinline__ unsigned pk2(float lo, float hi) { return f2bf(lo) | (f2bf(hi) << 16); }
__device__ __forceinline__ unsigned cvt_pk_bf16(float lo, float hi) { unsigned r; asm volatile("v_cvt_pk_bf16_f32 %0, %1, %2" : "=v"(r) : "v"(lo), "v"(hi)); return r; }
__device__ __forceinline__ int lane_now() { int l; asm volatile("v_mbcnt_lo_u32_b32 %0, -1, 0\n\tv_mbcnt_hi_u32_b32 %0, -1, %0" : "=v"(l)); return l; }
__device__ __forceinline__ unsigned pk4_fp8(float a, float b, float c, float d) {
    a = __builtin_amdgcn_fmed3f(a, -448.f, 448.f); b = __builtin_amdgcn_fmed3f(b, -448.f, 448.f); c = __builtin_amdgcn_fmed3f(c, -448.f, 448.f); d = __builtin_amdgcn_fmed3f(d, -448.f, 448.f);
    int r = 0; r = __builtin_amdgcn_cvt_pk_fp8_f32(a, b, r, false); r = __builtin_amdgcn_cvt_pk_fp8_f32(c, d, r, true); return (unsigned)r; }
__device__ __forceinline__ int opaque_s(int x) { asm volatile("" : "+s"(x)); return x; }
__device__ __forceinline__ float xor16_add(float v) { return v + __builtin_bit_cast(float, __builtin_amdgcn_ds_swizzle(__builtin_bit_cast(int, v), 0x401F)); }
__device__ __forceinline__ float xor32_add(float v, int lane) { return v + __builtin_bit_cast(float, __builtin_amdgcn_ds_bpermute((lane ^ 32) << 2, __builtin_bit_cast(int, v))); }
__device__ __forceinline__ float xor1_get(float v) { return __builtin_bit_cast(float, __builtin_amdgcn_mov_dpp(__builtin_bit_cast(int, v), 0xB1, 0xF, 0xF, true)); }
__device__ __forceinline__ float wave_sum(float v, int lane) {
    v += __builtin_bit_cast(float, __builtin_amdgcn_ds_swizzle(__builtin_bit_cast(int, v), 0x041F));
    v += __builtin_bit_cast(float, __builtin_amdgcn_ds_swizzle(__builtin_bit_cast(int, v), 0x081F));
    v += __builtin_bit_cast(float, __builtin_amdgcn_ds_swizzle(__builtin_bit_cast(int, v), 0x101F));
    v += __builtin_bit_cast(float, __builtin_amdgcn_ds_swizzle(__builtin_bit_cast(int, v), 0x201F));
    v = xor16_add(v);
    return xor32_add(v, lane);
}

#ifndef PG8_ASM_DMA
#define PG8_ASM_DMA 1
#endif
namespace pg8 {
constexpr int BM = 256, BK = 64, HALF = 128, HTB = HALF * BK * 2, STAGE_BYTES = 8 * HTB, NXCD = 8, WGM = 4;
__host__ __device__ __forceinline__ int lds_byte(int r, int c) { const int st = (r >> 4) * 2 + (c >> 5), rr = r & 15, cc = c & 31, ob = rr * 64 + cc * 2; return st * 1024 + (ob ^ (((ob >> 9) & 1) << 5)); }
__host__ __device__ __forceinline__ void stage_rc(int b, int& R, int& C) { const int st = b / 1024, sb = b % 1024, swz = sb ^ (((sb >> 9) & 1) << 5); R = (st >> 1) * 16 + swz / 64; C = (st & 1) * 32 + (swz % 64) / 2; }
__host__ __device__ __forceinline__ int perm32(int rho) { const int n = rho >> 4, i = rho & 15; return 8 * (i >> 2) + 4 * n + (i & 3); }

struct Unit { int pm, pn; };
struct Gemm { const bf16_t* A; const bf16_t* Bt; int lda, ldb, K; };

struct StaticOrder {
    int nM, nN, nwg, G, c;
    __host__ __device__ void init(int M, int N, int G_, int c_) { nM = M / BM; nN = N / BM; nwg = nM * nN; G = G_; c = c_; }
    __host__ __device__ bool next(int i, Unit& u) const {
        const long L = (long)i * G + c; if (L >= nwg) return false;
        int wgid = (int)L; { const int q = nwg / NXCD, r = nwg % NXCD, xcd = wgid % NXCD, off = wgid / NXCD; wgid = (xcd < r ? xcd * (q + 1) : r * (q + 1) + (xcd - r) * q) + off; }
        const int nig = WGM * nN, gid = wgid / nig, fm = gid * WGM, gsz = (nM - fm) < WGM ? (nM - fm) : WGM;
        u.pm = fm + ((wgid % nig) % gsz); u.pn = (wgid % nig) / gsz; return true;
    }
};
struct PlainTiles {
    __device__ __forceinline__ size_t a_off(const Unit& u, int lda) const { return (size_t)u.pm * BM * lda; }
    __device__ __forceinline__ size_t b_off(const Unit& u, int ldb) const { return (size_t)u.pn * BM * ldb; }
};
struct PoolTiles {
    __device__ __forceinline__ size_t a_off(const Unit& u, int lda) const { return (size_t)u.pm * BM * lda + (size_t)(u.pn >> 1) * 512; }
    __device__ __forceinline__ size_t b_off(const Unit& u, int ldb) const { return (size_t)(u.pn >> 1) * 512 * 512 + (size_t)(u.pn & 1) * BM * ldb; }
};

typedef int i32x4v __attribute__((ext_vector_type(4)));
typedef int i32x8v __attribute__((ext_vector_type(8)));
__device__ __forceinline__ i32x8v cat8(bf16x8 a, bf16x8 b) { const i32x4v x = __builtin_bit_cast(i32x4v, a), y = __builtin_bit_cast(i32x4v, b); return __builtin_shufflevector(x, y, 0, 1, 2, 3, 4, 5, 6, 7); }
template <class Epi, class Tiles, bool F8 = false>
__device__ __forceinline__ void gemm_phase(LAS unsigned char* lds, int wave_id, const Gemm g, const StaticOrder& S, const Tiles& T, const Epi& E) {
    const int lane = lane_now(), wid = opaque_s(wave_id), tid = wid * 64 + lane, wr = wid >> 2, wc = wid & 3, fr = lane & 15, fq = lane >> 4;
    const int K = g.K, nt = K / BK;
    unsigned voffA[2], voffB[2];
#pragma unroll
    for (int i = 0; i < 2; ++i) { int R, C; stage_rc(tid * 16 + i * 8192, R, C); const int Rb = Epi::PERM ? ((R & ~31) + perm32(R & 31)) : R;
        voffA[i] = (unsigned)(R * g.lda + C) * 2u; voffB[i] = (unsigned)(Rb * g.ldb + C) * 2u; }
    const size_t kstep = (size_t)(BK * 2);
    const size_t hstepA = (size_t)HALF * g.lda * 2, hstepB = (size_t)HALF * g.ldb * 2;
    const unsigned ldsw = (unsigned)wid * 1024u;
    const unsigned lds_base32 = (unsigned)(size_t)lds;
    const int aoff = lds_byte(wr * 64 + fr, fq * 8), boff = lds_byte(wc * 32 + fr, fq * 8);
#define PG8_SA(b, h) (((b) * 2 + (h)) * HTB)
#define PG8_SB(b, h) ((4 + (b) * 2 + (h)) * HTB)
#define PG8_STAGE(bufoff, gbase, voff) do { if constexpr (F8 || PG8_ASM_DMA) { _Pragma("unroll") for (int _i = 0; _i < 2; ++_i) { unsigned _keep; \
        asm volatile("s_mov_b32 %0, m0\n\ts_mov_b32 m0, %3\n\ts_nop 0\n\tglobal_load_lds_dwordx4 %1, %2\n\ts_mov_b32 m0, %0" : "=&s"(_keep) : "v"((voff)[_i]), "s"((const char*)(gbase)), "s"(lds_base32 + (unsigned)(bufoff) + ldsw + (unsigned)(_i * 8192)) : "memory"); } } \
    else { _Pragma("unroll") for (int _i = 0; _i < 2; ++_i) \
        __builtin_amdgcn_global_load_lds((const unsigned*)((const char*)(gbase) + (voff)[_i]), (LAS unsigned*)(lds + (bufoff) + ldsw + _i * 8192), 16, 0, 0); } } while (0)
#define PG8_LDA(dst, b, h) do { if constexpr (F8) { _Pragma("unroll") for (int m = 0; m < 4; ++m) dst##_8[m] = cat8(*(const LAS bf16x8*)(lds + PG8_SA(b, h) + aoff + m * 2048), *(const LAS bf16x8*)(lds + PG8_SA(b, h) + aoff + m * 2048 + 1024)); } \
        else { _Pragma("unroll") for (int m = 0; m < 4; ++m) _Pragma("unroll") for (int k = 0; k < 2; ++k) dst[m][k] = *(const LAS bf16x8*)(lds + PG8_SA(b, h) + aoff + m * 2048 + k * 1024); } } while (0)
#define PG8_LDB(dst, b, h) do { if constexpr (F8) { _Pragma("unroll") for (int n = 0; n < 2; ++n) dst##_8[n] = cat8(*(const LAS bf16x8*)(lds + PG8_SB(b, h) + boff + n * 2048), *(const LAS bf16x8*)(lds + PG8_SB(b, h) + boff + n * 2048 + 1024)); } \
        else { _Pragma("unroll") for (int n = 0; n < 2; ++n) _Pragma("unroll") for (int k = 0; k < 2; ++k) dst[n][k] = *(const LAS bf16x8*)(lds + PG8_SB(b, h) + boff + n * 2048 + k * 1024); } } while (0)
#define PG8_MMA(ai, bj, At, Bt) do { __builtin_amdgcn_s_setprio(1); if constexpr (F8) { _Pragma("unroll") for (int m = 0; m < 4; ++m) _Pragma("unroll") for (int n = 0; n < 2; ++n) \
        acc[ai][bj][m][n] = __builtin_amdgcn_mfma_scale_f32_16x16x128_f8f6f4(Bt##_8[n], At##_8[m], acc[ai][bj][m][n], 0, 0, 0, 0x7F7F7F7F, 0, 0x7F7F7F7F); } \
        else { _Pragma("unroll") for (int m = 0; m < 4; ++m) _Pragma("unroll") for (int n = 0; n < 2; ++n) _Pragma("unroll") for (int k = 0; k < 2; ++k) \
        acc[ai][bj][m][n] = __builtin_amdgcn_mfma_f32_16x16x32_bf16(Bt[n][k], At[m][k], acc[ai][bj][m][n], 0, 0, 0); } __builtin_amdgcn_s_setprio(0); } while (0)
#define PG8_WAIT_V(n) asm volatile("s_waitcnt vmcnt(" #n ")" ::: "memory")
#define PG8_WAIT_L(n) asm volatile("s_waitcnt lgkmcnt(" #n ")" ::: "memory")
#define PG8_BAR __builtin_amdgcn_s_barrier()
#define PG8_SCHED __builtin_amdgcn_sched_barrier(0)
    Unit cur, nxt; int ui = 0;
    if (!S.next(0, cur)) return;
    f32x4 acc[2][2][4][2];
#pragma unroll
    for (int a = 0; a < 2; ++a)
#pragma unroll
        for (int b = 0; b < 2; ++b)
#pragma unroll
            for (int m = 0; m < 4; ++m)
#pragma unroll
                for (int n = 0; n < 2; ++n) acc[a][b][m][n] = (f32x4){0.f, 0.f, 0.f, 0.f};
    bf16x8 At[4][2], B0[2][2], B1[2][2];
    i32x8v At_8[4], B0_8[2], B1_8[2];
    const char* cA = (const char*)(g.A + T.a_off(cur, g.lda)); const char* cB = (const char*)(g.Bt + T.b_off(cur, g.ldb));
    PG8_STAGE(PG8_SB(0, 0), cB, voffB); PG8_STAGE(PG8_SB(0, 1), cB + hstepB, voffB); PG8_STAGE(PG8_SA(0, 0), cA, voffA); PG8_STAGE(PG8_SA(0, 1), cA + hstepA, voffA);
    if (wr == 1) PG8_BAR;
    PG8_WAIT_V(2); PG8_BAR;
    PG8_STAGE(PG8_SB(1, 0), cB + kstep, voffB); PG8_STAGE(PG8_SA(1, 0), cA + kstep, voffA); PG8_STAGE(PG8_SB(1, 1), cB + hstepB + kstep, voffB);
    PG8_WAIT_V(6); PG8_BAR;
    for (;;) {
        const bool has_next = S.next(ui + 1, nxt);
        const char* nA = has_next ? (const char*)(g.A + T.a_off(nxt, g.lda)) : cA; const char* nB = has_next ? (const char*)(g.Bt + T.b_off(nxt, g.ldb)) : cB;
        for (int t = 0; t < nt; t += 2) {
            const bool last = (t == nt - 2);
            const char* a1 = cA + (size_t)(t + 1) * kstep;
            const char* a2 = last ? nA : cA + (size_t)(t + 2) * kstep; const char* b2 = last ? nB : cB + (size_t)(t + 2) * kstep;
            const char* a3 = a2 + kstep; const char* b3 = b2 + kstep;
            PG8_LDB(B0, 0, 0); PG8_LDB(B1, 0, 1); PG8_SCHED; PG8_LDA(At, 0, 0); PG8_STAGE(PG8_SA(1, 1), a1 + hstepA, voffA);
            PG8_WAIT_V(8); PG8_WAIT_L(0); PG8_BAR; PG8_MMA(0, 0, At, B0); PG8_MMA(0, 1, At, B1); PG8_BAR; PG8_SCHED;
            PG8_LDA(At, 0, 1); PG8_STAGE(PG8_SB(0, 0), b2, voffB); PG8_STAGE(PG8_SB(0, 1), b2 + hstepB, voffB); PG8_STAGE(PG8_SA(0, 0), a2, voffA);
            PG8_WAIT_V(8); PG8_WAIT_L(0); PG8_BAR; PG8_MMA(1, 0, At, B0); PG8_MMA(1, 1, At, B1); PG8_BAR; PG8_SCHED;
            PG8_LDB(B0, 1, 0); PG8_LDB(B1, 1, 1); PG8_SCHED; PG8_LDA(At, 1, 0); PG8_STAGE(PG8_SA(0, 1), a2 + hstepA, voffA);
            PG8_WAIT_V(8); PG8_WAIT_L(0); PG8_BAR; PG8_MMA(0, 0, At, B0); PG8_MMA(0, 1, At, B1); PG8_BAR; PG8_SCHED;
            PG8_LDA(At, 1, 1); PG8_STAGE(PG8_SB(1, 0), b3, voffB); PG8_STAGE(PG8_SB(1, 1), b3 + hstepB, voffB); PG8_STAGE(PG8_SA(1, 0), a3, voffA);
            PG8_WAIT_V(8); PG8_WAIT_L(0); PG8_BAR; PG8_MMA(1, 0, At, B0); PG8_MMA(1, 1, At, B1); PG8_BAR; PG8_SCHED;
        }
        if (wr == 0) PG8_BAR;
        E(acc, cur, ui, wr, wc, fr, fq, lds);
        if (!has_next) break;
#pragma unroll
        for (int a = 0; a < 2; ++a)
#pragma unroll
            for (int b = 0; b < 2; ++b)
#pragma unroll
                for (int m = 0; m < 4; ++m)
#pragma unroll
                    for (int n = 0; n < 2; ++n) acc[a][b][m][n] = (f32x4){0.f, 0.f, 0.f, 0.f};
        cur = nxt; cA = nA; cB = nB; ++ui;
        if (wr == 1) PG8_BAR;
    }
    PG8_WAIT_V(0);
    PG8_BAR;
#undef PG8_SA
#undef PG8_SB
#undef PG8_STAGE
#undef PG8_LDA
#undef PG8_LDB
#undef PG8_MMA
#undef PG8_WAIT_V
#undef PG8_WAIT_L
#undef PG8_BAR
#undef PG8_SCHED
}

__device__ __forceinline__ float silu_mul(float g, float u) {
    const float e = __builtin_amdgcn_exp2f(g * -1.4426950408889634f);
    return g * u * __builtin_amdgcn_rcpf(1.0f + e);
}
__device__ __forceinline__ f32x4 swiglu4(const f32x4 g, const f32x4 u, float c1, float k) {
    const f32x4 t = g * c1;
    const f32x4 e = {__builtin_amdgcn_exp2f(t[0]), __builtin_amdgcn_exp2f(t[1]), __builtin_amdgcn_exp2f(t[2]), __builtin_amdgcn_exp2f(t[3])};
    const f32x4 kv = {k, k, k, k};
    const f32x4 d = __builtin_elementwise_fma(e, kv, kv);
    const f32x4 r = {__builtin_amdgcn_rcpf(d[0]), __builtin_amdgcn_rcpf(d[1]), __builtin_amdgcn_rcpf(d[2]), __builtin_amdgcn_rcpf(d[3])};
    return (g * u) * r;
}
struct EpiSwiGLU {
    static constexpr bool PERM = true;
    bf16_t* H; unsigned char* H8; float desc;
    __device__ __forceinline__ void operator()(const f32x4 (&acc)[2][2][4][2], const Unit& u, int ui, int wr, int wc, int fr, int fq, LAS unsigned char* lds) const {
        const LAS float* tab = (const LAS float*)(lds + RSTD_OFF) + ui * 256;
        int fr_ = fr; asm volatile("" : "+v"(fr_));
        const int rl0 = wr * 64 + fr_, col0 = u.pn * 128 + wc * 32 + 8 * fq;
#pragma unroll
        for (int ai = 0; ai < 2; ++ai)
#pragma unroll
            for (int m = 0; m < 4; ++m) {
                const int rl = ai * HALF + rl0 + m * 16; const float rs = tab[rl] * desc;
                const float c1 = rs * -1.4426950408889634f, kk = __builtin_amdgcn_rcpf((rs * rs) * (H8 ? SH8 : 1.0f));
                const f32x4 h0 = swiglu4(acc[ai][0][m][0], acc[ai][1][m][0], c1, kk), h1 = swiglu4(acc[ai][0][m][1], acc[ai][1][m][1], c1, kk);
                if (H8) {
                    u32x2 w8; w8.x = pk4_fp8(h0[0], h0[1], h0[2], h0[3]); w8.y = pk4_fp8(h1[0], h1[1], h1[2], h1[3]);
                    *(u32x2*)(H8 + (size_t)(u.pm * BM + rl) * DFF8 + col0) = w8;
                } else {
                    u32x4 w;
                    w.x = cvt_pk_bf16(h0[0], h0[1]); w.y = cvt_pk_bf16(h0[2], h0[3]); w.z = cvt_pk_bf16(h1[0], h1[1]); w.w = cvt_pk_bf16(h1[2], h1[3]);
                    *(u32x4*)(H + (size_t)(u.pm * BM + rl) * DFF + col0) = w;
                }
            }
    }
};
__device__ __forceinline__ f32x4 bf4_lo(unsigned a, unsigned b) { return (f32x4){__builtin_bit_cast(float, a << 16), __builtin_bit_cast(float, a & 0xffff0000u), __builtin_bit_cast(float, b << 16), __builtin_bit_cast(float, b & 0xffff0000u)}; }
struct EpiRes {
    static constexpr bool PERM = true;
    const bf16_t* baseb; const float* basef; bf16_t* xb; float* outf; float* ssq; const float* cscale; float alpha; unsigned char* xb8;
    __device__ __forceinline__ void operator()(const f32x4 (&acc)[2][2][4][2], const Unit& u, int ui, int wr, int wc, int fr, int fq, LAS unsigned char* lds) const {
        const int ln_ = lane_now(), fr_ = ln_ & 15, fq_ = ln_ >> 4;
        const int rl0 = wr * 64 + fr_, col0 = u.pn * BM + wc * 32 + 8 * fq_;
        f32x4 cs[2][2];
        const float al = __builtin_bit_cast(float, opaque_s(__builtin_bit_cast(int, alpha)));
#pragma unroll
        for (int bj = 0; bj < 2; ++bj)
#pragma unroll
            for (int n = 0; n < 2; ++n) { cs[bj][n] = cscale ? *(const f32x4*)(cscale + col0 + bj * HALF + n * 4) * al : (f32x4){al, al, al, al}; }
#pragma unroll
        for (int ai = 0; ai < 2; ++ai)
#pragma unroll
            for (int m = 0; m < 4; ++m) {
                const int row = u.pm * BM + ai * HALF + rl0 + m * 16; const size_t off = (size_t)row * DM + col0; float ss = 0.f;
#pragma unroll
                for (int bj = 0; bj < 2; ++bj) {
                    f32x4 b0, b1;
                    if (basef) { b0 = *(const f32x4*)(basef + off + bj * HALF); b1 = *(const f32x4*)(basef + off + bj * HALF + 4); }
                    else { const u32x4 w = *(const u32x4*)(baseb + off + bj * HALF); b0 = bf4_lo(w.x, w.y); b1 = bf4_lo(w.z, w.w); }
                    const f32x4 o0 = b0 + acc[ai][bj][m][0] * cs[bj][0], o1 = b1 + acc[ai][bj][m][1] * cs[bj][1];
                    if (outf) { *(f32x4*)(outf + off + bj * HALF) = o0; *(f32x4*)(outf + off + bj * HALF + 4) = o1; }
                    u32x4 r; r.x = cvt_pk_bf16(o0[0], o0[1]); r.y = cvt_pk_bf16(o0[2], o0[3]); r.z = cvt_pk_bf16(o1[0], o1[1]); r.w = cvt_pk_bf16(o1[2], o1[3]);
                    *(u32x4*)(xb + off + bj * HALF) = r;
                    if (xb8) { u32x2 r8; r8.x = pk4_fp8(o0[0] * SX8, o0[1] * SX8, o0[2] * SX8, o0[3] * SX8); r8.y = pk4_fp8(o1[0] * SX8, o1[1] * SX8, o1[2] * SX8, o1[3] * SX8); *(u32x2*)(xb8 + off + bj * HALF) = r8; }
                    const f32x4 v0 = bf4_lo(r.x, r.y), v1 = bf4_lo(r.z, r.w);
                    ss += ((v0[0] * v0[0] + v0[1] * v0[1]) + (v0[2] * v0[2] + v0[3] * v0[3])) + ((v1[0] * v1[0] + v1[1] * v1[1]) + (v1[2] * v1[2] + v1[3] * v1[3]));
                }
                ss = xor16_add(ss); ss = xor32_add(ss, ln_);
                if (fq_ == 0) ssq[(size_t)row * 32 + u.pn * 4 + wc] = ss;
                asm volatile("" ::: "memory");
            }
    }
};
struct EpiHead {
    static constexpr bool PERM = true;
    bf16_t* dst0; bf16_t* dst1; const float* gain; int nnorm; float desc;
    __device__ __forceinline__ void operator()(const f32x4 (&acc)[2][2][4][2], const Unit& u, int ui, int wr, int wc, int fr, int fq, LAS unsigned char* lds) const {
        const LAS float* tab = (const LAS float*)(lds + RSTD_OFF) + ui * 256;
        LAS float* HP = (LAS float*)(lds + HP_OFF);
        const int ln_ = lane_now(), fr_ = ln_ & 15, fq_ = ln_ >> 4;
        const int rl0 = wr * 64 + fr_, d0 = wc * 32 + 8 * fq_;
        const bool norm = u.pn < nnorm; const int pnl = norm ? u.pn : u.pn - nnorm; bf16_t* dst = norm ? dst0 : dst1;
        if (norm) {
#pragma unroll
            for (int ai = 0; ai < 2; ++ai)
#pragma unroll
                for (int m = 0; m < 4; ++m) {
                    const int rl = ai * HALF + rl0 + m * 16; const float rs = tab[rl] * desc;
#pragma unroll
                    for (int bj = 0; bj < 2; ++bj) {
                        const f32x4 a = acc[ai][bj][m][0] * rs, b = acc[ai][bj][m][1] * rs;
                        float s = ((a[0] * a[0] + a[1] * a[1]) + (a[2] * a[2] + a[3] * a[3])) + ((b[0] * b[0] + b[1] * b[1]) + (b[2] * b[2] + b[3] * b[3]));
                        s = xor16_add(s); s = xor32_add(s, fq_ * 16 + fr_);
                        if (fq_ == 0) HP[(rl * 2 + bj) * 4 + wc] = s;
                    }
                }
            asm volatile("s_waitcnt lgkmcnt(0)" ::: "memory"); __builtin_amdgcn_s_barrier(); asm volatile("" ::: "memory");
        }
        f32x4 gv0 = {1.f, 1.f, 1.f, 1.f}, gv1 = {1.f, 1.f, 1.f, 1.f};
        if (norm) { gv0 = *(const f32x4*)(gain + d0); gv1 = *(const f32x4*)(gain + d0 + 4); }
#pragma unroll
        for (int ai = 0; ai < 2; ++ai)
#pragma unroll
            for (int m = 0; m < 4; ++m) {
                const int rl = ai * HALF + rl0 + m * 16; const float rs = tab[rl] * desc;
#pragma unroll
                for (int bj = 0; bj < 2; ++bj) {
                    float sc = rs;
                    if (norm) { const f32x4 p = *(const LAS f32x4*)(HP + (rl * 2 + bj) * 4); sc = rs * __builtin_amdgcn_rsqf(((p[0] + p[1]) + (p[2] + p[3])) * (1.0f / 128.0f) + EPS); }
                    const f32x4 a = acc[ai][bj][m][0] * sc * gv0, b = acc[ai][bj][m][1] * sc * gv1;
                    u32x4 w; w.x = cvt_pk_bf16(a[0], a[1]); w.y = cvt_pk_bf16(a[2], a[3]); w.z = cvt_pk_bf16(b[0], b[1]); w.w = cvt_pk_bf16(b[2], b[3]);
                    *(u32x4*)(dst + ((size_t)(2 * pnl + bj) * SEQ + (size_t)(u.pm * BM + rl)) * HD + d0) = w;
                }
            }
    }
};
}

namespace att {
constexpr int NW = 8, QBLK = 32, KVBLK = 64, QB = NW * QBLK, D = 128;
constexpr int SHM_V = KVBLK * D * 2, SHM_K = KVBLK * D * 2;
constexpr int WS_OFF = 2 * SHM_V + 2 * SHM_K, ETAB_OFF = WS_OFF + NW * 64 * 4, ATT_LDS = ETAB_OFF + 256 * 4;
static_assert(ATT_LDS <= RING_BYTES, "attention LDS inside the ring region");
constexpr float SCALE = 0.08838834764831845f, THR = 8.f;
#define KSWZ(row, colB) ((row) * 256 + ((colB) ^ (((row) & 7) << 4)))
#define SBAR() __builtin_amdgcn_sched_barrier(0)
__device__ __forceinline__ int v_st(int k, int c) { const int kk = (k & ~0xC) | ((k & 4) << 1) | ((k & 8) >> 1); return ((kk >> 3) * 4 + (c >> 5)) * 512 + ((kk & 7) * 32 + (c & 31)) * 2; }
__device__ __forceinline__ int v_rd_base(int lane) { return ((lane & 3) << 3) | (((lane >> 2) & 3) << 6) | (((lane >> 4) & 1) << 5) | (((lane >> 5) & 1) << 8); }
constexpr int v_rd_off(int d0, int ks, int half) { return d0 * 512 + ks * 4096 + half * 2048; }
__device__ __forceinline__ int crow(int r, int hi) { return (r & 3) + 8 * (r >> 2) + 4 * hi; }
__device__ __forceinline__ unsigned cvtpk(float lo, float hi) { unsigned r; asm volatile("v_cvt_pk_bf16_f32 %0, %1, %2" : "=v"(r) : "v"(lo), "v"(hi)); return r; }
__device__ __forceinline__ bf16x8 load8(const bf16_t* p) { return *reinterpret_cast<const bf16x8*>(p); }

__device__ __forceinline__ void partialSM(f32x16& p0, f32x16& p1, float& m_reg, float& mn, float& alpha) {
    float pmax = p0[0]; for (int r = 1; r < 16; ++r) pmax = fmaxf(pmax, p0[r]); for (int r = 0; r < 16; ++r) pmax = fmaxf(pmax, p1[r]);
    { auto rr = __builtin_amdgcn_permlane32_swap(__float_as_uint(pmax), __float_as_uint(pmax), false, false);
      pmax = fmaxf(__uint_as_float(rr[0]), __uint_as_float(rr[1])); }
    constexpr float C2 = 1.4426950408889634f * SCALE;
    if (__builtin_expect(__all((pmax - m_reg) * SCALE <= THR), 1)) { mn = m_reg; alpha = 1.f; }
    else { mn = fmaxf(m_reg, pmax); alpha = __builtin_amdgcn_exp2f((m_reg - mn) * C2); m_reg = mn; }
    const float mnL = -mn * C2;
    for (int r = 0; r < 16; ++r) p0[r] = fmaf(p0[r], C2, mnL); for (int r = 0; r < 16; ++r) p1[r] = fmaf(p1[r], C2, mnL);
    for (int r = 0; r < 16; ++r) p0[r] = __builtin_amdgcn_exp2f(p0[r]);
}
__device__ __forceinline__ void finishSM(f32x16& p0, f32x16& p1, float alpha, float& l_reg, bf16x8& pa0, bf16x8& pa1, bf16x8& pa2, bf16x8& pa3) {
    for (int r = 0; r < 16; ++r) p1[r] = __builtin_amdgcn_exp2f(p1[r]);
    float ps = 0; for (int r = 0; r < 16; ++r) ps += p0[r]; for (int r = 0; r < 16; ++r) ps += p1[r];
    { auto rr = __builtin_amdgcn_permlane32_swap(__float_as_uint(ps), __float_as_uint(ps), false, false);
      ps = __uint_as_float(rr[0]) + __uint_as_float(rr[1]); }
    l_reg = l_reg * alpha + ps;
#define PK4(P, B_, OUT) do { unsigned a0 = cvtpk(P[B_+0], P[B_+1]), a1 = cvtpk(P[B_+2], P[B_+3]);                          \
        unsigned b0 = cvtpk(P[B_+4], P[B_+5]), b1 = cvtpk(P[B_+6], P[B_+7]);                                             \
        auto r0 = __builtin_amdgcn_permlane32_swap(a0, b0, false, false); auto r1 = __builtin_amdgcn_permlane32_swap(a1, b1, false, false); \
        u32x4 w = {r0[0], r1[0], r0[1], r1[1]}; OUT = *reinterpret_cast<bf16x8*>(&w); } while (0)
    PK4(p0, 0, pa0); PK4(p0, 8, pa1); PK4(p1, 0, pa2); PK4(p1, 8, pa3);
#undef PK4
}
template <int KB>
__device__ __forceinline__ void qkt(f32x16& p0, f32x16& p1, const char* K_lds, int r32, int hi, const bf16x8* qr, bool act, int delta, const float* etab, int wodd, float c191) {
    if (!act) { const float NEG = -__builtin_inff();
#pragma unroll
        for (int r = 0; r < 16; ++r) { p0[r] = NEG; p1[r] = NEG; } return; }
    if (delta >= 3) {
#pragma unroll
        for (int r = 0; r < 16; ++r) { p0[r] = c191; p1[r] = c191; }
    } else {
        const float* e = etab + (wodd * 32 + r32 + 4 - 4 * hi) + 64 * delta;
#pragma unroll
        for (int r = 0; r < 16; ++r) { const int c = (r & 3) + 8 * (r >> 2); p0[r] = e[59 - c]; p1[r] = e[27 - c]; }
    }
    const char* kb[4];
#pragma unroll
    for (int dd = 0; dd < 4; ++dd) kb[dd] = K_lds + KB * SHM_K + KSWZ(r32, (dd * 16 + hi * 8) * 2);
#pragma unroll
    for (int d0 = 0; d0 < 8; ++d0) { const char* a = kb[d0 & 3] + (d0 >> 2) * 128;
        bf16x8 b0 = *reinterpret_cast<const bf16x8*>(a);
        bf16x8 b1 = *reinterpret_cast<const bf16x8*>(a + 32 * 256);
        p0 = __builtin_amdgcn_mfma_f32_32x32x16_bf16(b0, qr[d0], p0, 0, 0, 0);
        p1 = __builtin_amdgcn_mfma_f32_32x32x16_bf16(b1, qr[d0], p1, 0, 0, 0); }
}
template <int VB>
__device__ __forceinline__ void pv_tile(f32x16* o, int vb0, bf16x8 pa0, bf16x8 pa1, bf16x8 pa2, bf16x8 pa3, bool act) {
    if (!act) return;
#define TRRD(dst, off) asm volatile("ds_read_b64_tr_b16 %0, %1 offset:%2" : "=&v"(dst) : "v"(vb0), "i"(off) : "memory")
#define PV_D0(d0) do { s16x4 l0, l1, l2, l3, h0, h1, h2, h3; constexpr int b_ = VB * SHM_V + v_rd_off(d0, 0, 0); \
        TRRD(l0, b_); TRRD(h0, b_ + 2048); TRRD(l1, b_ + 4096); TRRD(h1, b_ + 6144); TRRD(l2, b_ + 8192); TRRD(h2, b_ + 10240); TRRD(l3, b_ + 12288); TRRD(h3, b_ + 14336); \
        asm volatile("s_waitcnt lgkmcnt(0)" ::: "memory"); SBAR();   \
        o[d0] = __builtin_amdgcn_mfma_f32_32x32x16_bf16(pa0, (bf16x8){l0[0], l0[1], l0[2], l0[3], h0[0], h0[1], h0[2], h0[3]}, o[d0], 0, 0, 0);   \
        o[d0] = __builtin_amdgcn_mfma_f32_32x32x16_bf16(pa1, (bf16x8){l1[0], l1[1], l1[2], l1[3], h1[0], h1[1], h1[2], h1[3]}, o[d0], 0, 0, 0);   \
        o[d0] = __builtin_amdgcn_mfma_f32_32x32x16_bf16(pa2, (bf16x8){l2[0], l2[1], l2[2], l2[3], h2[0], h2[1], h2[2], h2[3]}, o[d0], 0, 0, 0);   \
        o[d0] = __builtin_amdgcn_mfma_f32_32x32x16_bf16(pa3, (bf16x8){l3[0], l3[1], l3[2], l3[3], h3[0], h3[1], h3[2], h3[3]}, o[d0], 0, 0, 0); } while (0)
    PV_D0(0); PV_D0(1); PV_D0(2); PV_D0(3);
#undef PV_D0
#undef TRRD
}
struct BlockRef { const bf16_t* Q; const bf16_t* K; const bf16_t* V; bf16_t* O; const float* rel; int P0; };
struct Seam { bf16x8 qr[8]; bf16x8 st_v0, st_v1, st_k0, st_k1; };
__device__ __forceinline__ int jlo_of(int P0) { const int c = P0 / KVBLK - 8; return c > 0 ? c : 0; }
#define ROW(p, k0, rr) ((p) + (size_t)((k0) + (rr)) * D + sc)
#define VMW() asm volatile("s_waitcnt vmcnt(0)" ::: "memory")
#define VMWN(n) asm volatile("s_waitcnt vmcnt(%0)" :: "i"(n) : "memory")
#define SLOAD_H(Kp, Vp, k0) do { S.st_v0 = load8(ROW(Vp, k0, sr)); S.st_v1 = load8(ROW(Vp, k0, 32 + sr));              \
                         S.st_k0 = load8(ROW(Kp, k0, sr)); S.st_k1 = load8(ROW(Kp, k0, 32 + sr)); } while (0)
#define SWRITE_HK(bf) do { *(bf16x8*)(K_lds + (bf) * SHM_K + kws) = S.st_k0; *(bf16x8*)(K_lds + (bf) * SHM_K + kws + 32 * 256) = S.st_k1; } while (0)
#define SWRITE_HV(bf) do { *(bf16x8*)(V_lds + (bf) * SHM_V + vst0) = S.st_v0; *(bf16x8*)(V_lds + (bf) * SHM_V + vst1) = S.st_v1; } while (0)
#define SWRITE_H(bf) do { SWRITE_HV(bf); SWRITE_HK(bf); } while (0)
__device__ __forceinline__ void etab_write(char* lds, const float* rel, int tid) {
    if (tid < 256) { const int i = tid < NREL - 1 ? tid : NREL - 1; ((float*)(lds + ETAB_OFF))[tid] = rel[i] * (1.0f / SCALE); }
}
__device__ __forceinline__ void attn_prime(const BlockRef& cur, char* lds, Seam& S, int wid) {
    const int lane = lane_now(), tid = wid * 64 + lane, r32 = lane & 31, hi = lane >> 5;
    const int sr = tid >> 4, sc = (tid & 15) * 8, kws = KSWZ(sr, sc * 2); char* K_lds = lds + 2 * SHM_V;
    const int kb0 = jlo_of(cur.P0) * KVBLK;
    for (int d0 = 0; d0 < 8; ++d0) S.qr[d0] = load8(cur.Q + (size_t)(wid * QBLK + r32) * D + d0 * 16 + hi * 8);
    SLOAD_H(cur.K, cur.V, kb0); VMW(); SWRITE_HK(0);
    etab_write(lds, cur.rel, tid);
    __syncthreads();
}
__device__ __forceinline__ void attn_block(const BlockRef& cur, const BlockRef& nxt, char* lds, Seam& S, int wid) {
    const int lane = lane_now(), tid = wid * 64 + lane, r32 = lane & 31, hi = lane >> 5;
    const int j_lo = jlo_of(cur.P0), j_hi = cur.P0 / KVBLK + QB / KVBLK;
    const int NT = j_hi - j_lo;
    const int kbn = jlo_of(nxt.P0) * KVBLK;
    const int cw = cur.P0 / KVBLK + (wid >> 1);
    char* V_lds = lds; char* K_lds = lds + 2 * SHM_V;
    float* ws = (float*)(lds + WS_OFF) + wid * 64; float* li_l = ws, * al_l = ws + 32;
    const float* etab = (const float*)(lds + ETAB_OFF); const int wodd = wid & 1;
    const float c191 = __builtin_bit_cast(float, __builtin_amdgcn_readfirstlane(__builtin_bit_cast(int, etab[255])));
    float m_reg = -1e30f, l_reg = 0; f32x16 o[4] = {};
    const int sr = tid >> 4, sc = (tid & 15) * 8, vst0 = v_st(sr, sc), vst1 = v_st(32 + sr, sc), kws = KSWZ(sr, sc * 2);
    const int vb0 = (int)(uintptr_t)V_lds + v_rd_base(lane);
    const bf16_t* Kh = cur.K; const bf16_t* Vh = cur.V;
#define RESC(a) do { if (__any((a) < 1.f)) { if (hi == 0) al_l[r32] = (a); asm volatile("s_waitcnt lgkmcnt(0)" ::: "memory");              \
                     for (int d_ = 0; d_ < 4; ++d_) for (int r = 0; r < 16; ++r) o[d_][r] *= al_l[crow(r, hi)]; } } while (0)
#define KBASE(t) ((j_lo + (t)) * KVBLK)
#define DLT(t) (cw - (j_lo + (t)))
#define ACT(t) (DLT(t) >= 0 && DLT(t) <= 8)
    constexpr int NQL = 8;
#define SEAM_K0() do { VMWN(NQL); SWRITE_HK(0); SBAR(); } while (0)
    f32x16 pA0, pA1, pB0, pB1; float mnA, mnB, alA, alB; bf16x8 pa0, pa1, pa2, pa3;
    SWRITE_HV(0); SBAR();
    if (NT > 1) { SLOAD_H(Kh, Vh, KBASE(1)); }
    SBAR(); qkt<0>(pA0, pA1, K_lds, r32, hi, S.qr, ACT(0), DLT(0), etab, wodd, c191);
    partialSM(pA0, pA1, m_reg, mnA, alA);
    if (NT > 1) { VMW(); SWRITE_H(1); }
    __syncthreads();
#define HALF_STEP(PX0, PX1, mnX, alX, PY0, PY1, alY, t, KB, VB, SB) do {                                                      \
        SBAR(); qkt<KB>(PX0, PX1, K_lds, r32, hi, S.qr, ACT(t), DLT(t), etab, wodd, c191);                                             \
        finishSM(PY0, PY1, alY, l_reg, pa0, pa1, pa2, pa3); SBAR();                                                           \
        if ((t) + 1 < NT) { SLOAD_H(Kh, Vh, KBASE((t) + 1)); SBAR(); }                                                         \
        pv_tile<VB>(o, vb0, pa0, pa1, pa2, pa3, ACT((t) - 1)); partialSM(PX0, PX1, m_reg, mnX, alX);                           \
        __syncthreads();                                                                                                      \
        if ((t) + 1 < NT) { VMW(); SWRITE_H(SB); }                                                                            \
        RESC(alX); __syncthreads(); } while (0)
    for (int t = 1; t + 1 < NT; t += 2) {
        HALF_STEP(pB0, pB1, mnB, alB, pA0, pA1, alA, t, 1, 0, 0);
        HALF_STEP(pA0, pA1, mnA, alA, pB0, pB1, alB, t + 1, 0, 1, 1);
    }
    const bool even = (NT & 1) == 0;
    if (even) { SBAR(); qkt<1>(pB0, pB1, K_lds, r32, hi, S.qr, ACT(NT - 1), DLT(NT - 1), etab, wodd, c191); SBAR(); }
    SLOAD_H(nxt.K, nxt.V, kbn); SBAR();
#pragma unroll
    for (int d0 = 0; d0 < 8; ++d0) S.qr[d0] = load8(nxt.Q + (size_t)(wid * QBLK + r32) * D + d0 * 16 + hi * 8);
    SBAR();
    finishSM(pA0, pA1, alA, l_reg, pa0, pa1, pa2, pa3); SBAR();
    pv_tile<0>(o, vb0, pa0, pa1, pa2, pa3, ACT(even ? NT - 2 : NT - 1));
    if (even) { partialSM(pB0, pB1, m_reg, mnB, alB); __syncthreads(); RESC(alB);
        finishSM(pB0, pB1, alB, l_reg, pa0, pa1, pa2, pa3); SBAR(); pv_tile<1>(o, vb0, pa0, pa1, pa2, pa3, ACT(NT - 1)); }
    SBAR(); SEAM_K0();
    if (nxt.rel != cur.rel) etab_write(lds, nxt.rel, tid);
    if (hi == 0) li_l[r32] = l_reg; asm volatile("s_waitcnt lgkmcnt(0)" ::: "memory");
    float rli[16];
#pragma unroll
    for (int r = 0; r < 16; ++r) rli[r] = __builtin_amdgcn_rcpf(li_l[crow(r, hi)]);
    if constexpr (FP8_O != 0) {
        unsigned char* Ow8 = (unsigned char*)cur.O + (size_t)(wid * QBLK) * DM;
#pragma unroll
        for (int r = 0; r < 16; ++r) { const int orow = crow(r, hi);
#pragma unroll
            for (int d0 = 0; d0 < 4; ++d0) { const float v = o[d0][r] * (rli[r] * SO8);
                const float v1 = __builtin_bit_cast(float, __builtin_amdgcn_mov_dpp(__builtin_bit_cast(int, v), 0x39, 0xF, 0xF, true));
                const float v2 = __builtin_bit_cast(float, __builtin_amdgcn_mov_dpp(__builtin_bit_cast(int, v), 0x4E, 0xF, 0xF, true));
                const float v3 = __builtin_bit_cast(float, __builtin_amdgcn_mov_dpp(__builtin_bit_cast(int, v), 0x93, 0xF, 0xF, true));
                if ((r32 & 3) == 0) *(unsigned*)(Ow8 + (size_t)orow * DM + d0 * 32 + r32) = pk4_fp8(v, v1, v2, v3); } }
    } else {
    bf16_t* Ow = cur.O + (size_t)(wid * QBLK) * DM;
#pragma unroll
    for (int r = 0; r < 16; ++r) { const int orow = crow(r, hi);
#pragma unroll
        for (int d0 = 0; d0 < 4; ++d0) { const float v = o[d0][r] * rli[r];
            const float vn = xor1_get(v);
            if ((r32 & 1) == 0) *(unsigned*)(Ow + (size_t)orow * DM + d0 * 32 + r32) = cvtpk(v, vn); } }
    }
    __syncthreads();
#undef RESC
#undef KBASE
#undef DLT
#undef ACT
#undef SEAM_K0
#undef HALF_STEP
}
#undef ROW
#undef VMW
#undef VMWN
#undef SLOAD_H
#undef SWRITE_HK
#undef SWRITE_HV
#undef SWRITE_H
}

#define XB_TMO      128
#define XB_XCNT(j)  (256  + 64 * (j))
#define XB_XSUB(j)  (1280 + 64 * (j))
#define XB_XGEN(j)  (2304 + 64 * (j))
#define XB_TOP      3328
#define XB_TOPGEN   3392
#define XCD_BAR_WORDS 3456
#define XB_SPIN_CAP (1u << 18)
__device__ __forceinline__ unsigned xb_ld(unsigned* p)              { return __hip_atomic_load(p, __ATOMIC_RELAXED, __HIP_MEMORY_SCOPE_AGENT); }
__device__ __forceinline__ unsigned xb_add(unsigned* p, unsigned v) { return __hip_atomic_fetch_add(p, v, __ATOMIC_RELAXED, __HIP_MEMORY_SCOPE_AGENT); }
__device__ __forceinline__ unsigned xb_xcc_id() { return (unsigned)__builtin_amdgcn_s_getreg((3 << 11) | 20) & 0xFu; }
#define XB_SPIN(cond, bar) do { unsigned _sp = 0; while (cond) { __builtin_amdgcn_s_sleep(1); \
    if ((++_sp & 255u) == 0u) { if (xb_ld(&(bar)[XB_TMO])) break; if (_sp > XB_SPIN_CAP) { atomicAdd(&(bar)[XB_TMO], 1u); break; } } } } while (0)
struct XcdBarrier { unsigned* bar; unsigned x; volatile LAS unsigned* st; };
__device__ __forceinline__ XcdBarrier xcd_barrier_post(unsigned* bar, volatile LAS unsigned* st, int tid0) {
    XcdBarrier b; b.bar = bar; b.x = xb_xcc_id(); b.st = st;
    if (tid0 == 0) (void)xb_add(&bar[XB_XCNT(b.x)], 1u);
    return b;
}
__device__ __forceinline__ void xcd_barrier_complete(unsigned* bar, unsigned x, unsigned& nloc, unsigned& nx) {
    const unsigned G = gridDim.x * gridDim.y * gridDim.z;
    unsigned sum, cnt, mine, sp = 0u;
    for (;;) {
        sum = 0u; cnt = 0u; mine = 0u;
#pragma unroll
        for (unsigned j = 0; j < 16; ++j) { const unsigned c = xb_ld(&bar[XB_XCNT(j)]); sum += c; cnt += (c > 0u) ? 1u : 0u; mine = (j == x) ? c : mine; }
        if (sum == G) break;
        __builtin_amdgcn_s_sleep(1);
        if ((++sp & 255u) == 0u) { if (xb_ld(&bar[XB_TMO])) break; if (sp > XB_SPIN_CAP) { atomicAdd(&bar[XB_TMO], 1u); break; } }
    }
    nloc = mine > 0u ? mine : 1u; nx = cnt > 0u ? cnt : 1u;
}
__device__ __forceinline__ void xcd_barrier(const XcdBarrier& b, int wave) {
    asm volatile("s_waitcnt vmcnt(0)" ::: "memory");
    __syncthreads();
    if (wave == 0 && lane_now() == 0) {
        unsigned* bar = b.bar;
        __builtin_amdgcn_s_waitcnt(0);
        unsigned nloc = b.st[0], nx = b.st[1];
        if (nloc == 0u) { xcd_barrier_complete(bar, b.x, nloc, nx); b.st[0] = nloc; b.st[1] = nx; }
        const unsigned old = xb_add(&bar[XB_XSUB(b.x)], 1u);
        const unsigned gen = old / nloc;
        if (old + 1u == (gen + 1u) * nloc) {
            __builtin_amdgcn_fence(__ATOMIC_RELEASE, "agent");
            asm volatile("s_waitcnt vmcnt(0)" ::: "memory");
            const unsigned og = xb_add(&bar[XB_TOP], 1u);
            const unsigned tg = og / nx;
            if (og + 1u == (tg + 1u) * nx) xb_add(&bar[XB_TOPGEN], 1u);
            else XB_SPIN(xb_ld(&bar[XB_TOPGEN]) == tg, bar);
            __builtin_amdgcn_fence(__ATOMIC_ACQUIRE, "agent");
            xb_add(&bar[XB_XGEN(b.x)], 1u);
            asm volatile("s_waitcnt vmcnt(0)" ::: "memory");
        } else {
            XB_SPIN(xb_ld(&bar[XB_XGEN(b.x)]) == gen, bar);
            __builtin_amdgcn_fence(__ATOMIC_ACQUIRE, "agent");
            asm volatile("s_waitcnt vmcnt(0)" ::: "memory");
        }
    }
    __syncthreads();
}

struct Frame {
    LAS unsigned char* lds;
    volatile LAS unsigned* MISC;
    gu32* ctl;
    int wave;
    int vcu, G;
};
struct Args { const float* in[20]; float* out; unsigned char* ws; int ph_lo, ph_hi; };
__device__ __forceinline__ const void* ldptr(LAS unsigned char* lds, int i) {
    volatile LAS unsigned* p = (volatile LAS unsigned*)(lds + LDSCTL_OFF) + 2 * i;
    const unsigned lo = __builtin_amdgcn_readfirstlane(p[0]), hi = __builtin_amdgcn_readfirstlane(p[1]);
    const GAS void* q = (const GAS void*)(((unsigned long long)hi << 32) | lo);
    return (const void*)q;
}
#define IN_PTR(i) ((const float*)ldptr(F.lds, (i)))
#define OUT_PTR() ((float*)ldptr(F.lds, 20))
#define WS_PTR() ((unsigned char*)ldptr(F.lds, 21))

struct TItem { const float* src; const float* gain; bf16_t* dst; int ldw, ldt; unsigned char* dst8; float sc8; };
constexpr int I_GU = (DM / 64) * (DFF / 32);
constexpr int I_D = (DFF / 64) * (DM / 32);
constexpr int I_FFN = 2 * I_GU + I_D;
constexpr int I_P = (512 / 64) * (512 / 32);
constexpr int I_S = (DM / 64) * (DM / 32);
constexpr int N_SMALL = 8 * I_P + 6 * I_S;
__device__ __forceinline__ TItem dec_ffn(Frame& F, int set, int r) {
    TItem t; const int l = set >> 1, f = set & 1; unsigned char* ws = WS_PTR();
    if (r < 2 * I_GU) { const int up = r >= I_GU, item = r - up * I_GU, nnb = DFF / 32, kb = item / nnb, nb = item - kb * nnb, n0 = nb * 32, k0 = kb * 64;
        t.src = IN_PTR((f ? 7 : 2) + up) + (size_t)l * DM * DFF + (size_t)k0 * DFF + n0; t.gain = IN_PTR(f ? 6 : 1) + (size_t)l * DM + k0;
        t.dst = (bf16_t*)(ws + WS_WGU + (size_t)set * SZ_WGU) + (size_t)(256 * (n0 >> 7) + (n0 & 127) + up * 128) * DM + k0; t.ldw = DFF; t.ldt = DM; t.dst8 = nullptr; t.sc8 = 1.f;
        if (use8(set)) { t.dst8 = (ws + WS_WGU + (size_t)set * SZ_WGU) + (size_t)(256 * (n0 >> 7) + (n0 & 127) + up * 128) * DM + k0; t.sc8 = SWGU8; } }
    else { const int item = r - 2 * I_GU, nnb = DM / 32, kb = item / nnb, nb = item - kb * nnb, n0 = nb * 32, k0 = kb * 64;
        t.src = IN_PTR(f ? 9 : 4) + (size_t)l * DFF * DM + (size_t)k0 * DM + n0; t.gain = nullptr;
        t.dst = (bf16_t*)(ws + WS_WD + (size_t)set * SZ_WD) + (size_t)n0 * DFF + k0; t.ldw = DM; t.ldt = DFF; t.dst8 = nullptr; t.sc8 = 1.f;
        if (use8d(set)) { t.dst8 = (ws + WS_WD + (size_t)set * SZ_WD) + (size_t)n0 * DFF8 + k0; t.ldt = DFF8; t.sc8 = SWD8; } }
    return t;
}
__device__ __forceinline__ TItem dec_small(Frame& F, int r) {
    TItem t; unsigned char* ws = WS_PTR();
    if (r < 8 * I_P) { const int q = r / I_P, item = r - q * I_P, l = q >> 2, g = q & 3, kb = item >> 4, nb = item & 15, n0 = nb * 32, k0 = kb * 64;
        t.src = IN_PTR(10) + (size_t)q * 512 * 512 + (size_t)k0 * 512 + n0; t.gain = IN_PTR(5) + (size_t)l * DM + g * 512 + k0;
        t.dst = (bf16_t*)(ws + WS_WPOOL + (size_t)l * SZ_WPOOL) + (size_t)g * 512 * 512 + (size_t)n0 * 512 + k0; t.ldw = 512; t.ldt = 512; t.dst8 = nullptr; t.sc8 = 1.f; }
    else { const int rr = r - 8 * I_P, q = rr / I_S, item = rr - q * I_S, kb = item >> 6, nb = item & 63, n0 = nb * 32, k0 = kb * 64; const float* W; const float* gn; bf16_t* WT;
        if (q == 0) { W = IN_PTR(13); gn = IN_PTR(12); WT = (bf16_t*)(ws + WS_WKV); }
        else if (q == 1) { W = IN_PTR(14); gn = IN_PTR(12); WT = (bf16_t*)(ws + WS_WKV) + (size_t)DM * DM; }
        else if (q < 4) { W = IN_PTR(16) + (size_t)(q - 2) * DM * DM; gn = IN_PTR(5) + (size_t)(NPOOL + q - 2) * DM; WT = (bf16_t*)(ws + WS_WQ) + (size_t)(q - 2) * DM * DM; }
        else { W = IN_PTR(19) + (size_t)(q - 4) * DM * DM; gn = nullptr; WT = (bf16_t*)(ws + WS_WO) + (size_t)(q - 4) * DM * DM; }
        t.src = W + (size_t)k0 * DM + n0; t.gain = gn ? gn + k0 : nullptr; t.dst = WT + (size_t)n0 * DM + k0; t.ldw = DM; t.ldt = DM; t.dst8 = nullptr; t.sc8 = 1.f;
        if (FP8_O && q >= 4) { t.dst8 = (unsigned char*)WT + (size_t)n0 * DM + k0; t.sc8 = SWGU8; }
        if (FP8_QKV && q < 4) { t.dst8 = (q == 1 ? ws + WS_WKV + (size_t)DM * DM : (unsigned char*)WT) + (size_t)n0 * DM + k0; t.sc8 = SWGU8; } }
    return t;
}
template <bool GAIN>
__device__ __forceinline__ void titem_load(const TItem& t, float (&v)[32], f32x4& g0, f32x4& g1, int lane) {
    if constexpr (GAIN) { g0 = *(const f32x4*)(t.gain + 8 * (lane & 7)); g1 = *(const f32x4*)(t.gain + 8 * (lane & 7) + 4); }
    const float* p = t.src + (size_t)(lane >> 5) * t.ldw + (lane & 31);
#pragma unroll
    for (int i = 0; i < 32; ++i) v[i] = __builtin_nontemporal_load(p + (size_t)(2 * i) * t.ldw);
}
template <bool GAIN>
__device__ __forceinline__ void titem_store(const TItem& t, const float (&v)[32], const f32x4& g0, const f32x4& g1, LAS float* scr, int lane) {
    const int c = lane & 7;
#pragma unroll
    for (int i = 0; i < 32; ++i) scr[(2 * i + (lane >> 5)) * 33 + (lane & 31)] = v[i];
    LDS_WAIT(); asm volatile("" ::: "memory");
#pragma unroll
    for (int j = 0; j < 4; ++j) { const int n = (lane >> 3) + 8 * j; const LAS float* s = scr + (8 * c) * 33 + n;
        float e[8];
#pragma unroll
        for (int q = 0; q < 8; ++q) e[q] = s[q * 33];
        if constexpr (GAIN) { e[0] *= g0[0]; e[1] *= g0[1]; e[2] *= g0[2]; e[3] *= g0[3]; e[4] *= g1[0]; e[5] *= g1[1]; e[6] *= g1[2]; e[7] *= g1[3]; }
        if ((FP8_SETS != 0 || FP8_QKV || FP8_O) && t.dst8) { u32x2 o8; o8.x = pk4_fp8(e[0] * t.sc8, e[1] * t.sc8, e[2] * t.sc8, e[3] * t.sc8); o8.y = pk4_fp8(e[4] * t.sc8, e[5] * t.sc8, e[6] * t.sc8, e[7] * t.sc8);
            *(GAS u32x2*)(t.dst8 + (size_t)n * t.ldt + 8 * c) = o8; }
        else { u32x4 o; o.x = cvt_pk_bf16(e[0], e[1]); o.y = cvt_pk_bf16(e[2], e[3]); o.z = cvt_pk_bf16(e[4], e[5]); o.w = cvt_pk_bf16(e[6], e[7]);
            *(GAS u32x4*)(t.dst + (size_t)n * t.ldt + 8 * c) = o; } }
    LDS_WAIT(); asm volatile("" ::: "memory");
}
template <bool SMALL, bool GAIN>
__device__ __forceinline__ void convert_items(Frame& F, int set, int first, int end, int stride) {
    LAS float* scr = (LAS float*)(F.lds + RING_OFF + F.wave * 16384);
    const int lane = lane_now();
    int it = first; if (it >= end) return;
    const float z_ = __builtin_bit_cast(float, opaque_s(0));
    float va[32], vb[32]; f32x4 ga0 = {z_, z_, z_, z_}, ga1 = ga0, gb0 = ga0, gb1 = ga0;
    TItem ta = SMALL ? dec_small(F, it) : dec_ffn(F, set, it);
    titem_load<GAIN>(ta, va, ga0, ga1, lane);
    for (;;) {
        const int nxt = it + stride; const bool more = nxt < end;
        const TItem tb = SMALL ? dec_small(F, more ? nxt : it) : dec_ffn(F, set, more ? nxt : it);
        titem_load<GAIN>(tb, vb, gb0, gb1, lane);
        titem_store<GAIN>(ta, va, ga0, ga1, scr, lane);
        if (!more) break;
        ta = tb; ga0 = gb0; ga1 = gb1;
#pragma unroll
        for (int i = 0; i < 32; ++i) va[i] = vb[i];
        it = nxt;
    }
}
constexpr int N_SMALL_G = 8 * I_P + 4 * I_S;
__device__ __forceinline__ void convert_ffn_gu(Frame& F, int set, int worker, int nworkers) {
    convert_items<false, true>(F, set, worker, 2 * I_GU, nworkers);
}
__device__ __forceinline__ void convert_ffn_down(Frame& F, int set, int worker, int nworkers) {
    convert_items<false, false>(F, set, 2 * I_GU + worker, I_FFN, nworkers);
    if (use8d(set)) {
        unsigned char* wd8 = WS_PTR() + WS_WD + (size_t)set * SZ_WD; const int lane = lane_now(); const unsigned z0 = (unsigned)opaque_s(0);
        for (int r = worker; r < DM; r += nworkers) if (lane < (DFF8 - DFF) / 16) *(GAS u32x4*)(wd8 + (size_t)r * DFF8 + DFF + lane * 16) = (u32x4){z0, z0, z0, z0};
    }
}
__device__ __forceinline__ void p0_prologue(Frame& F) {
    const int lane = lane_now();
    const int gw = F.vcu * NWAVES + F.wave, NGW = F.G * NWAVES;
    unsigned char* ws = WS_PTR();
    convert_ffn_gu(F, 0, gw, NGW);
    convert_items<true, true>(F, 0, gw, N_SMALL_G, NGW);
    convert_items<true, false>(F, 0, N_SMALL_G + gw, N_SMALL, NGW);
    const float* x = IN_PTR(0); bf16_t* XB = (bf16_t*)(ws + WS_XB); float* SSQ = (float*)(ws + WS_SSQ);
    for (int m = gw; m < SEQ; m += NGW) {
        const GAS f32x4* xr = (const GAS f32x4*)(x + (size_t)m * DM) + lane;
        GAS u32x2* o8 = (GAS u32x2*)(XB + (size_t)m * DM) + lane;
        float s = 0.f;
#pragma unroll
        for (int j = 0; j < 8; ++j) { const f32x4 v = xr[64 * j]; s += (v[0] * v[0] + v[1] * v[1]) + (v[2] * v[2] + v[3] * v[3]);
            u32x2 w; w.x = pk2(v[0], v[1]); w.y = pk2(v[2], v[3]); o8[64 * j] = w; }
        s = wave_sum(s, lane);
        if (lane < 32) SSQ[(size_t)m * 32 + lane] = lane == 0 ? s : 0.f;
        if ((FP8_SETS | FP8_D_SETS) != 0 && lane < (DFF8 - DFF) / 16) *(GAS u32x4*)(ws + WS_H8 + (size_t)m * DFF8 + DFF + lane * 16) = (u32x4){0u, 0u, 0u, 0u};
    }
}
__device__ __forceinline__ void tail_convert(Frame& F, const pg8::StaticOrder& S, int set) {
    const int rounds = (S.nwg + S.G - 1) / S.G, nfull = S.nwg - (rounds - 1) * S.G;
    int worker, nworkers;
    if (nfull >= S.G) { worker = S.c * NWAVES + F.wave; nworkers = S.G * NWAVES; }
    else { if (S.c < nfull) return; worker = (S.c - nfull) * NWAVES + F.wave; nworkers = (S.G - nfull) * NWAVES; }
    if (set + 1 < 2 * DEPTH) convert_ffn_gu(F, set + 1, worker, nworkers);
    convert_ffn_down(F, set, worker, nworkers);
}
__device__ __forceinline__ void prep_rstd(Frame& F, const pg8::StaticOrder& S, const float* ssq) {
    LAS float* tab = (LAS float*)(F.lds + RSTD_OFF);
    const int tid_ = F.wave * 64 + lane_now();
    const int row = tid_ >> 1, half = tid_ & 1;
    pg8::Unit u;
    int pm_prev = -1; float v_prev = 0.f;
#pragma unroll 1
    for (int i = 0; i < 8 && S.next(i, u); ++i) {
        if (u.pm != pm_prev) {
            const f32x4* p = (const f32x4*)(ssq + (size_t)(u.pm * 256 + row) * 32 + half * 16);
            const f32x4 a = p[0], b = p[1], c = p[2], d = p[3];
            float s = ((a[0] + a[1]) + (a[2] + a[3])) + ((b[0] + b[1]) + (b[2] + b[3])) + ((c[0] + c[1]) + (c[2] + c[3])) + ((d[0] + d[1]) + (d[2] + d[3]));
            s += xor1_get(s);
            v_prev = __builtin_amdgcn_rsqf(s * (1.0f / DM) + EPS); pm_prev = u.pm;
        }
        if (half == 0) tab[i * 256 + row] = v_prev;
    }
    LDS_WAIT(); __syncthreads();
}
__device__ __forceinline__ float half_sum(float v) {
    v += __builtin_bit_cast(float, __builtin_amdgcn_ds_swizzle(__builtin_bit_cast(int, v), 0x041F));
    v += __builtin_bit_cast(float, __builtin_amdgcn_ds_swizzle(__builtin_bit_cast(int, v), 0x081F));
    v += __builtin_bit_cast(float, __builtin_amdgcn_ds_swizzle(__builtin_bit_cast(int, v), 0x101F));
    v += __builtin_bit_cast(float, __builtin_amdgcn_ds_swizzle(__builtin_bit_cast(int, v), 0x201F));
    return xor16_add(v);
}
template <int W>
__device__ __forceinline__ void pool_diff_block(Frame& F, const bf16_t* x, const float* ssq, bf16_t* diff, int t0, int tid_) {
    LAS float* rt = (LAS float*)(F.lds + RING_OFF);
    const int c4 = tid_ * 4, rr = tid_ >> 5, part = tid_ & 31;
    float pv[3];
#pragma unroll
    for (int j = 0; j < 3; ++j) { const int r = t0 - 16 + rr + 16 * j; pv[j] = ssq[(size_t)(r < 0 ? 0 : r) * 32 + part]; }
    u32x2 xr[31 + W];
#pragma unroll
    for (int i = 0; i < 31 + W; ++i) { const int sr = t0 - W + 1 + i; xr[i] = *(const u32x2*)(x + (size_t)(sr < 0 ? 0 : sr) * DM + c4); }
#pragma unroll
    for (int j = 0; j < 3; ++j) { const int r = t0 - 16 + rr + 16 * j; const float sm = half_sum(pv[j]);
        if (part == 0) rt[rr + 16 * j] = r >= 0 ? __builtin_amdgcn_rsqf(sm * (1.0f / DM) + EPS) : 0.f; }
    LDS_WAIT(); __syncthreads();
    const float z_ = __builtin_bit_cast(float, opaque_s(0));
    f32x4 sum = {z_, z_, z_, z_};
#pragma unroll
    for (int i = 0; i < W - 1; ++i) sum += pg8::bf4_lo(xr[i].x, xr[i].y) * rt[17 - W + i];
    const bool head = t0 == 0;
#pragma unroll
    for (int t = 0; t < 32; ++t) {
        const f32x4 a = pg8::bf4_lo(xr[W - 1 + t].x, xr[W - 1 + t].y) * rt[16 + t];
        sum += a;
        const float inv = __builtin_bit_cast(float, opaque_s(__builtin_bit_cast(int, (t + 1 < W && head) ? 1.0f / (float)(t + 1) : 1.0f / (float)W)));
        const f32x4 o = sum * inv - a;
        u32x2 pk; pk.x = pk2(o[0], o[1]); pk.y = pk2(o[2], o[3]);
        *(u32x2*)(diff + (size_t)(t0 + t) * DM + c4) = pk;
        sum -= pg8::bf4_lo(xr[t].x, xr[t].y) * rt[17 - W + t];
    }
    __syncthreads();
}
__device__ __forceinline__ void pool_diff_phase(Frame& F, const bf16_t* x, const float* ssq, bf16_t* diff) {
    const int lane = lane_now(), tid_ = F.wave * 64 + lane;
    const int g = F.wave >> 1;
    const int vcu_ = opaque_s(F.vcu), G_ = opaque_s(F.G);
    for (int blk = vcu_; blk < SEQ / 32; blk += G_) {
        const int t0 = blk * 32;
        if (g == 0) pool_diff_block<2>(F, x, ssq, diff, t0, tid_);
        else if (g == 1) pool_diff_block<4>(F, x, ssq, diff, t0, tid_);
        else if (g == 2) pool_diff_block<8>(F, x, ssq, diff, t0, tid_);
        else pool_diff_block<16>(F, x, ssq, diff, t0, tid_);
    }
}
__device__ __forceinline__ att::BlockRef attn_ref(int l, const bf16_t* QH, const bf16_t* KH, const bf16_t* VH, bf16_t* AO, const float* rel) {
    att::BlockRef r; const int h = l >> 5, qb = l & 31;
    r.Q = QH + ((size_t)h * SEQ + (size_t)qb * att::QB) * HD; r.K = KH + (size_t)h * SEQ * HD; r.V = VH + (size_t)h * SEQ * HD;
    r.O = FP8_O ? (bf16_t*)((unsigned char*)AO + (size_t)qb * att::QB * DM + h * HD) : AO + (size_t)qb * att::QB * DM + h * HD; r.rel = rel + h * NREL; r.P0 = qb * att::QB; return r;
}
__device__ __forceinline__ void attn_phase(Frame& F, char* lds, const bf16_t* QH, const bf16_t* KH, const bf16_t* VH, bf16_t* AO, const float* rel) {
    const int total = NH * (SEQ / att::QB);
    const int G_ = opaque_s(F.G);
    int L = opaque_s(F.vcu); if (L >= total) return;
    att::BlockRef cur = attn_ref(L, QH, KH, VH, AO, rel);
    att::Seam S;
    att::attn_prime(cur, lds, S, F.wave);
    for (;;) {
        const bool more = L + G_ < total;
        const att::BlockRef nxt = more ? attn_ref(L + G_, QH, KH, VH, AO, rel) : cur;
        att::attn_block(cur, nxt, lds, S, F.wave);
        if (!more) break;
        cur = nxt; L += G_;
    }
}

__global__ void __launch_bounds__(NWAVES * 64, 2) fwd_kernel(Args args) {
    extern __shared__ __attribute__((aligned(16))) unsigned char lds[];
    Frame F;
    F.lds = (LAS unsigned char*)lds;
    F.MISC = (volatile LAS unsigned*)(F.lds + MISC_OFF);
    const int tid0 = threadIdx.x; F.wave = __builtin_amdgcn_readfirstlane(tid0 >> 6);
    F.G = gridDim.x; { const int bx = blockIdx.x; F.vcu = (F.G % 8 == 0) ? (bx % 8) * (F.G / 8) + bx / 8 : bx; }
    if (tid0 < 32) ((LAS unsigned*)(F.lds + MISC_OFF))[tid0] = 0u;
    if (tid0 >= 64 && tid0 < 64 + 44) {
        const __attribute__((address_space(4))) unsigned* ka = (const __attribute__((address_space(4))) unsigned*)__builtin_amdgcn_kernarg_segment_ptr();
        ((LAS unsigned*)(F.lds + LDSCTL_OFF))[tid0 - 64] = ka[tid0 - 64]; }
    __syncthreads();
    F.ctl = (gu32*)(WS_PTR() + WS_CTL);
#if MK_PER_PHASE
#define GRID_BAR() do { } while (0)
#else
    XcdBarrier bar = xcd_barrier_post((unsigned*)(F.ctl + CW_BAR), F.MISC + 8, tid0);
#define GRID_BAR() xcd_barrier(bar, F.wave)
#endif
    const int lo = args.ph_lo, hi = args.ph_hi;
    int pi = 0;
#define PHASE_BEGIN if (pi >= lo && pi < hi) {
#define PHASE_END   if (pi + 1 < hi) GRID_BAR(); } ++pi;
#define WSP(off) (WS_PTR() + (off))

    PHASE_BEGIN if (PH_ON(0)) DUP_LOOP(0) { p0_prologue(F); DUP_BAR(0) } PHASE_END

#define LAYER_BODY(K8, KD8, F0, F1, WITH_KV) \
        for (int f = F0; f < F1; ++f) { \
            PHASE_BEGIN if (PH_ON(1)) DUP_LOOP(1) { \
                pg8::StaticOrder S; S.init(SEQ, NGU, opaque_s(F.G), opaque_s((int)blockIdx.x)); \
                prep_rstd(F, S, (const float*)WSP(WS_SSQ)); \
                if constexpr (K8) { \
                    pg8::Gemm g{(const bf16_t*)WSP(WS_XB8), (const bf16_t*)WSP(WS_WGU + (size_t)(l * 2 + f) * SZ_WGU), DM / 2, DM / 2, DM / 2}; \
                    pg8::EpiSwiGLU E{nullptr, (unsigned char*)WSP(WS_H8), 1.0f / (SX8 * SWGU8)}; \
                    pg8::gemm_phase<pg8::EpiSwiGLU, pg8::PlainTiles, true>(F.lds + RING_OFF, F.wave, g, S, pg8::PlainTiles{}, E); \
                } else { \
                    pg8::Gemm g{(const bf16_t*)WSP(WS_XB), (const bf16_t*)WSP(WS_WGU + (size_t)(l * 2 + f) * SZ_WGU), DM, DM, DM}; \
                    pg8::EpiSwiGLU E{KD8 ? nullptr : (bf16_t*)WSP(WS_HB), KD8 ? (unsigned char*)WSP(WS_H8) : nullptr, 1.0f}; \
                    pg8::gemm_phase(F.lds + RING_OFF, F.wave, g, S, pg8::PlainTiles{}, E); \
                } \
                tail_convert(F, S, l * 2 + f); \
                DUP_BAR(1) \
            } PHASE_END \
            PHASE_BEGIN if (PH_ON(2)) DUP3_LOOP(2) { \
                pg8::StaticOrder S; S.init(SEQ, DM, opaque_s(F.G), opaque_s((int)blockIdx.x)); \
                const bool first = (l == 0 && f == 0 && rep_ == 0), lastp = (l == DEPTH - 1 && f == 1); \
                bf16_t* XB = (bf16_t*)WSP(WS_XB); \
                unsigned char* nx8 = ((f == 1 && l + 1 < DEPTH && use8((l + 1) * 2)) || (FP8_QKV && ((l == NPOOL - 1 && f == 1) || (l >= NPOOL && f == 0)))) ? (unsigned char*)WSP(WS_XB8) : nullptr; \
                if constexpr (K8 || KD8) { \
                    pg8::Gemm g{(const bf16_t*)WSP(WS_H8), (const bf16_t*)WSP(WS_WD + (size_t)(l * 2 + f) * SZ_WD), DFF8 / 2, DFF8 / 2, DFF8 / 2}; \
                    pg8::EpiRes E{first ? nullptr : (const bf16_t*)XB, first ? IN_PTR(0) : nullptr, XB, lastp ? OUT_PTR() : nullptr, (float*)WSP(WS_SSQ), nullptr, 0.5f * DUP3_SIGN / (SH8 * SWD8), nx8}; \
                    pg8::gemm_phase<pg8::EpiRes, pg8::PlainTiles, true>(F.lds + RING_OFF, F.wave, g, S, pg8::PlainTiles{}, E); \
                } else { \
                    pg8::Gemm g{(const bf16_t*)WSP(WS_HB), (const bf16_t*)WSP(WS_WD + (size_t)(l * 2 + f) * SZ_WD), DFF, DFF, DFF}; \
                    pg8::EpiRes E{first ? nullptr : (const bf16_t*)XB, first ? IN_PTR(0) : nullptr, XB, lastp ? OUT_PTR() : nullptr, (float*)WSP(WS_SSQ), nullptr, 0.5f * DUP3_SIGN, nx8}; \
                    pg8::gemm_phase(F.lds + RING_OFF, F.wave, g, S, pg8::PlainTiles{}, E); \
                } \
                DUP3_BAR(2) \
            } PHASE_END \
            if (f == 0) { \
                if (l < NPOOL) { \
                    PHASE_BEGIN if (PH_ON(3)) DUP_LOOP(3) { pool_diff_phase(F, (const bf16_t*)WSP(WS_XB), (const float*)WSP(WS_SSQ), (bf16_t*)WSP(WS_T1)); DUP_BAR(3) } PHASE_END \
                    PHASE_BEGIN if (PH_ON(4)) DUP3_LOOP(4) { \
                        pg8::StaticOrder S; S.init(SEQ, DM, opaque_s(F.G), opaque_s((int)blockIdx.x)); \
                        pg8::Gemm g{(const bf16_t*)WSP(WS_T1), (const bf16_t*)WSP(WS_WPOOL + (size_t)l * SZ_WPOOL), DM, 512, 512}; \
                        bf16_t* XB = (bf16_t*)WSP(WS_XB); \
                        pg8::EpiRes E{XB, nullptr, XB, nullptr, (float*)WSP(WS_SSQ), IN_PTR(11) + (size_t)l * DM, DUP3_SIGN, use8(l * 2 + 1) ? (unsigned char*)WSP(WS_XB8) : nullptr}; \
                        pg8::gemm_phase(F.lds + RING_OFF, F.wave, g, S, pg8::PoolTiles{}, E); \
                        DUP3_BAR(4) \
                    } PHASE_END \
                } else { \
                    const int b = l - NPOOL; \
                    PHASE_BEGIN if (PH_ON(5)) DUP_LOOP(5) { \
                        pg8::StaticOrder S; S.init(SEQ, DM, opaque_s(F.G), opaque_s((int)blockIdx.x)); \
                        prep_rstd(F, S, (const float*)WSP(WS_SSQ)); \
                        bf16_t* QH = (bf16_t*)WSP(WS_QH); \
                        if constexpr (FP8_QKV != 0) { \
                            pg8::Gemm g{(const bf16_t*)WSP(WS_XB8), (const bf16_t*)WSP(WS_WQ) + (size_t)b * DM * DM, DM / 2, DM / 2, DM / 2}; \
                            pg8::EpiHead E{QH, QH, IN_PTR(17) + (size_t)b * HD, 8, 1.0f / (SX8 * SWGU8)}; \
                            pg8::gemm_phase<pg8::EpiHead, pg8::PlainTiles, true>(F.lds + RING_OFF, F.wave, g, S, pg8::PlainTiles{}, E); \
                        } else { \
                            pg8::Gemm g{(const bf16_t*)WSP(WS_XB), (const bf16_t*)WSP(WS_WQ) + (size_t)b * DM * DM, DM, DM, DM}; \
                            pg8::EpiHead E{QH, QH, IN_PTR(17) + (size_t)b * HD, 8, 1.0f}; \
                            pg8::gemm_phase(F.lds + RING_OFF, F.wave, g, S, pg8::PlainTiles{}, E); \
                        } \
                        DUP_BAR(5) \
                    } PHASE_END \
                    PHASE_BEGIN if (PH_ON(6)) DUP_LOOP(6) { attn_phase(F, (char*)lds + RING_OFF, (const bf16_t*)WSP(WS_QH), (const bf16_t*)WSP(WS_KH), (const bf16_t*)WSP(WS_VH), (bf16_t*)WSP(WS_T1), IN_PTR(18) + (size_t)b * NH * NREL); DUP_BAR(6) } PHASE_END \
                    PHASE_BEGIN if (PH_ON(7)) DUP3_LOOP(7) { \
                        pg8::StaticOrder S; S.init(SEQ, DM, opaque_s(F.G), opaque_s((int)blockIdx.x)); \
                        bf16_t* XB = (bf16_t*)WSP(WS_XB); \
                        if constexpr (FP8_O != 0) { \
                            pg8::Gemm g{(const bf16_t*)WSP(WS_T1), (const bf16_t*)WSP(WS_WO) + (size_t)b * DM * DM, DM / 2, DM / 2, DM / 2}; \
                            pg8::EpiRes E{XB, nullptr, XB, nullptr, (float*)WSP(WS_SSQ), nullptr, DUP3_SIGN / (SO8 * SWGU8), use8(l * 2 + 1) ? (unsigned char*)WSP(WS_XB8) : nullptr}; \
                            pg8::gemm_phase<pg8::EpiRes, pg8::PlainTiles, true>(F.lds + RING_OFF, F.wave, g, S, pg8::PlainTiles{}, E); \
                        } else { \
                            pg8::Gemm g{(const bf16_t*)WSP(WS_T1), (const bf16_t*)WSP(WS_WO) + (size_t)b * DM * DM, DM, DM, DM}; \
                            pg8::EpiRes E{XB, nullptr, XB, nullptr, (float*)WSP(WS_SSQ), nullptr, DUP3_SIGN, use8(l * 2 + 1) ? (unsigned char*)WSP(WS_XB8) : nullptr}; \
                            pg8::gemm_phase(F.lds + RING_OFF, F.wave, g, S, pg8::PlainTiles{}, E); \
                        } \
                        DUP3_BAR(7) \
                    } PHASE_END \
                } \
            } \
        } \
        if (WITH_KV && l == NPOOL - 1) { \
            PHASE_BEGIN if (PH_ON(8)) DUP_LOOP(8) { \
                pg8::StaticOrder S; S.init(SEQ, 2 * DM, opaque_s(F.G), opaque_s((int)blockIdx.x)); \
                prep_rstd(F, S, (const float*)WSP(WS_SSQ)); \
                if constexpr (FP8_QKV != 0) { \
                    pg8::Gemm g{(const bf16_t*)WSP(WS_XB8), (const bf16_t*)WSP(WS_WKV), DM / 2, DM / 2, DM / 2}; \
                    pg8::EpiHead E{(bf16_t*)WSP(WS_KH), (bf16_t*)WSP(WS_VH), IN_PTR(15), 8, 1.0f / (SX8 * SWGU8)}; \
                    pg8::gemm_phase<pg8::EpiHead, pg8::PlainTiles, true>(F.lds + RING_OFF, F.wave, g, S, pg8::PlainTiles{}, E); \
                } else { \
                    pg8::Gemm g{(const bf16_t*)WSP(WS_XB), (const bf16_t*)WSP(WS_WKV), DM, DM, DM}; \
                    pg8::EpiHead E{(bf16_t*)WSP(WS_KH), (bf16_t*)WSP(WS_VH), IN_PTR(15), 8, 1.0f}; \
                    pg8::gemm_phase(F.lds + RING_OFF, F.wave, g, S, pg8::PlainTiles{}, E); \
                } \
                DUP_BAR(8) \
            } PHASE_END \
        }
#if FP8_D_SETS
    static_assert(FP8_FIRST_LAYER == DEPTH, "FP8-down of the last half-step: the layers' FFNs are otherwise bf16");
    for (int l = 0; l < DEPTH; ++l) {
        LAYER_BODY(false, false, 0, (l == DEPTH - 1 ? 1 : 2), true)
    }
    {   const int l = opaque_s(DEPTH - 1);
        LAYER_BODY(false, true, 1, 2, false)
    }
#else
    for (int l = 0; l < FP8_FIRST_LAYER; ++l) {
        LAYER_BODY(false, false, 0, 2, true)
    }
    for (int l = FP8_FIRST_LAYER; l < DEPTH; ++l) {
        LAYER_BODY(true, false, 0, 2, true)
    }
#endif
#undef LAYER_BODY
#undef PHASE_BEGIN
#undef PHASE_END
}
constexpr int N_PHASES = 1 + 2 * 6 + 1 + 2 * 7;


#ifndef MK_DEBUG
#define MK_DEBUG 0
#endif
#if MK_DEBUG
constexpr size_t WS_XOLD = WS_END, WS_RES = WS_END + (size_t)SEQ * DM * 4;
struct ChkArgs { const float* in[20]; float* out; unsigned char* ws; int phase, kind, l, f; };
__device__ __forceinline__ float bf2f(bf16_t b) { return __uint_as_float(((unsigned)b) << 16); }
__device__ __forceinline__ float bfr(float x) { return __uint_as_float(f2bf(x) << 16); }
__device__ __forceinline__ unsigned hash32(unsigned x) { x ^= x >> 16; x *= 0x7feb352du; x ^= x >> 15; x *= 0x846ca68bu; x ^= x >> 16; return x; }
__device__ __forceinline__ float wsum(float v) { for (int o = 32; o >= 1; o >>= 1) v += __shfl_xor(v, o); return v; }
__device__ __forceinline__ float row_rstd_b(const bf16_t* XBp, int row, int lane) { float s = 0.f; for (int k = lane; k < DM; k += 64) { const float v = bf2f(XBp[(size_t)row * DM + k]); s += v * v; } s = wsum(s); return 1.0f / sqrtf(s / DM + EPS); }
__device__ __forceinline__ float row_rstd(const float* X, int row, int lane) { float s = 0.f; for (int k = lane; k < DM; k += 64) { const float v = X[(size_t)row * DM + k]; s += v * v; } s = wsum(s); return 1.0f / sqrtf(s / DM + EPS); }
__device__ __forceinline__ void rec(unsigned* res, int phase, float got, float ref, float floor_) { float e = fabsf(got - ref) / (fabsf(ref) + floor_); if (!(e == e)) e = 1e30f; atomicMax(res + phase, __float_as_uint(e)); }
__device__ void chk_ffn_set(const ChkArgs& a, unsigned* res, int slot, int set, unsigned t) {
    unsigned char* ws = a.ws; const int ll = set >> 1, ff = set & 1;
    { const int up = t & 1; const int n = hash32(t + 1) % DFF, k = hash32(t + 2) % DM;
      const float w = a.in[(ff ? 7 : 2) + up][(size_t)ll * DM * DFF + (size_t)k * DFF + n] * a.in[ff ? 6 : 1][ll * DM + k];
      const bf16_t g = ((const bf16_t*)(ws + WS_WGU + (size_t)set * SZ_WGU))[(size_t)(256 * (n >> 7) + (n & 127) + up * 128) * DM + k]; rec(res, slot, bf2f(g), bfr(w), 1e-3f); }
    { const int n = hash32(t + 3) % DM, k = hash32(t + 4) % DFF;
      const float w = a.in[ff ? 9 : 4][(size_t)ll * DFF * DM + (size_t)k * DM + n];
      const bf16_t g = ((const bf16_t*)(ws + WS_WD + (size_t)set * SZ_WD))[(size_t)n * DFF + k]; rec(res, slot, bf2f(g), bfr(w), 1e-3f); }
}
__global__ void chk_kernel(ChkArgs a) {
    const int lane = threadIdx.x & 63, gw = blockIdx.x * (blockDim.x >> 6) + (threadIdx.x >> 6);
    unsigned char* ws = a.ws; unsigned* res = (unsigned*)(ws + WS_RES);
    const bf16_t* XOLD = (const bf16_t*)(ws + WS_XOLD);
    const bf16_t* XB = (const bf16_t*)(ws + WS_XB); const bf16_t* HB = (const bf16_t*)(ws + WS_HB); const bf16_t* T1 = (const bf16_t*)(ws + WS_T1);
    const float* SSQ = (const float*)(ws + WS_SSQ);
    const unsigned h0 = hash32(gw * 7919u + a.phase * 104729u + 17u);
    const int l = a.l, f = a.f;
    if (a.kind == 0) {
        const unsigned t = hash32(h0 + lane * 31u);
        chk_ffn_set(a, res, 28, 0, t); chk_ffn_set(a, res, 29, 0, hash32(t + 99));
        { const int q = t % 8, ll = q >> 2, gg = q & 3; const int d = hash32(t + 5) % 512, c = hash32(t + 6) % 512;
          const float w = a.in[10][(size_t)q * 512 * 512 + (size_t)c * 512 + d] * a.in[5][ll * DM + gg * 512 + c];
          const bf16_t g = ((const bf16_t*)(ws + WS_WPOOL + (size_t)ll * SZ_WPOOL))[(size_t)gg * 512 * 512 + (size_t)d * 512 + c]; rec(res, 30, bf2f(g), bfr(w), 1e-3f); }
        { const int q = t % 6; const int n = hash32(t + 7) % DM, k = hash32(t + 8) % DM; float w; bf16_t g;
          if (q == 0) { w = a.in[13][(size_t)k * DM + n] * a.in[12][k]; g = ((const bf16_t*)(ws + WS_WKV))[(size_t)n * DM + k]; }
          else if (q == 1) { w = a.in[14][(size_t)k * DM + n] * a.in[12][k]; g = ((const bf16_t*)(ws + WS_WKV))[(size_t)(DM + n) * DM + k]; }
          else if (q < 4) { w = a.in[16][(size_t)(q - 2) * DM * DM + (size_t)k * DM + n] * a.in[5][(NPOOL + q - 2) * DM + k]; g = ((const bf16_t*)(ws + WS_WQ))[(size_t)(q - 2) * DM * DM + (size_t)n * DM + k]; }
          else { w = a.in[19][(size_t)(q - 4) * DM * DM + (size_t)k * DM + n]; g = ((const bf16_t*)(ws + WS_WO))[(size_t)(q - 4) * DM * DM + (size_t)n * DM + k]; }
          rec(res, 31, bf2f(g), bfr(w), 1e-3f); }
        { const int row = h0 % SEQ; float s = 0.f, sq = 0.f; for (int k = lane; k < DM; k += 64) { const float v = a.in[0][(size_t)row * DM + k]; sq += v * v; rec(res, 32, bf2f(XB[(size_t)row * DM + k]), bfr(v), 1e-3f); }
          sq = wsum(sq); s = lane < 32 ? SSQ[(size_t)row * 32 + lane] : 0.f; s = wsum(s); if (lane == 0) rec(res, 33, s, sq, 1e-3f); }
        return;
    }
    const bool firstD = (l == 0 && f == 0);
    if (a.kind == 1) {
        const int row = h0 % SEQ, col = hash32(h0 + 1) % DFF; const float rs = firstD ? row_rstd(a.in[0], row, lane) : row_rstd_b(XB, row, lane);
        const bf16_t* W = (const bf16_t*)(ws + WS_WGU + (size_t)(l * 2 + f) * SZ_WGU); const size_t rg = (size_t)(256 * (col >> 7) + (col & 127)) * DM, ru = rg + (size_t)128 * DM;
        float g = 0.f, u = 0.f; for (int k = lane; k < DM; k += 64) { const float xv = bf2f(XB[(size_t)row * DM + k]); g += xv * bf2f(W[rg + k]); u += xv * bf2f(W[ru + k]); }
        g = wsum(g) * rs; u = wsum(u) * rs; const float hh = g / (1.f + expf(-g)) * u;
        if (lane == 0) rec(res, a.phase, bf2f(HB[(size_t)row * DFF + col]), hh, 0.05f);
        if (l * 2 + f + 1 < 2 * DEPTH) chk_ffn_set(a, res, a.phase, l * 2 + f + 1, hash32(h0 + lane * 31u));
        return;
    }
    if (a.kind == 2 || a.kind == 7 || a.kind == 4) {
        const int row = h0 % SEQ, col = hash32(h0 + 1) % DM; float s = 0.f; float mul;
        if (a.kind == 2) { const bf16_t* W = (const bf16_t*)(ws + WS_WD + (size_t)(l * 2 + f) * SZ_WD); for (int k = lane; k < DFF; k += 64) s += bf2f(HB[(size_t)row * DFF + k]) * bf2f(W[(size_t)col * DFF + k]); mul = 0.5f; }
        else if (a.kind == 7) { const bf16_t* W = (const bf16_t*)(ws + WS_WO) + (size_t)(l - NPOOL) * DM * DM; for (int k = lane; k < DM; k += 64) s += bf2f(T1[(size_t)row * DM + k]) * bf2f(W[(size_t)col * DM + k]); mul = 1.0f; }
        else { const int gg = col >> 9, d = col & 511; const bf16_t* W = (const bf16_t*)(ws + WS_WPOOL + (size_t)l * SZ_WPOOL) + (size_t)gg * 512 * 512; for (int c = lane; c < 512; c += 64) s += bf2f(T1[(size_t)row * DM + gg * 512 + c]) * bf2f(W[(size_t)d * 512 + c]); mul = a.in[11][l * DM + col]; }
        s = wsum(s); const float bv = (a.kind == 2 && firstD) ? a.in[0][(size_t)row * DM + col] : bf2f(XOLD[(size_t)row * DM + col]); const float ref = bv + mul * s;
        if (lane == 0) { rec(res, a.phase, bf2f(XB[(size_t)row * DM + col]), bfr(ref), 0.05f); if (a.phase == N_PHASES - 1) rec(res, a.phase, a.out[(size_t)row * DM + col], ref, 0.05f); }
        float sq = 0.f; for (int k = lane; k < DM; k += 64) { const float v = bf2f(XB[(size_t)row * DM + k]); sq += v * v; } sq = wsum(sq);
        float sp = lane < 32 ? SSQ[(size_t)row * 32 + lane] : 0.f; sp = wsum(sp); if (lane == 0) rec(res, a.phase, sp, sq, 1e-3f);
        return;
    }
    if (a.kind == 3) {
        const int t = (gw & 1) ? (h0 % 40) : (h0 % SEQ), c = hash32(h0 + 1) % DM, w = 2 << (c >> 9); float sum = 0.f, self = 0.f;
        for (int s = t - w + 1; s <= t; ++s) if (s >= 0) { const float rs = row_rstd_b(XB, s, lane); const float z = bf2f(XB[(size_t)s * DM + c]) * rs; sum += z; if (s == t) self = z; }
        const int cnt = (t + 1 < w) ? t + 1 : w; if (lane == 0) rec(res, a.phase, bf2f(T1[(size_t)t * DM + c]), sum / cnt - self, 0.02f);
        return;
    }
    if (a.kind == 5 || a.kind == 8) {
        const int row = h0 % SEQ, hh = hash32(h0 + 1) % NH, which = (a.kind == 8) ? (int)(hash32(h0 + 2) & 1) : 0;
        const float rs = row_rstd_b(XB, row, lane);
        const bf16_t* W = (a.kind == 5) ? (const bf16_t*)(ws + WS_WQ) + (size_t)(l - NPOOL) * DM * DM : (const bf16_t*)(ws + WS_WKV) + (size_t)which * DM * DM;
        const float* gain = (a.kind == 5) ? a.in[17] + (l - NPOOL) * HD : a.in[15];
        const bf16_t* O = (const bf16_t*)(ws + (a.kind == 5 ? WS_QH : (which ? WS_VH : WS_KH)));
        float v0 = 0.f, v1 = 0.f;
        for (int k = 0; k < DM; ++k) { const float xv = bf2f(XB[(size_t)row * DM + k]); v0 += xv * bf2f(W[(size_t)(hh * HD + lane) * DM + k]); v1 += xv * bf2f(W[(size_t)(hh * HD + lane + 64) * DM + k]); }
        v0 *= rs; v1 *= rs;
        if (!(a.kind == 8 && which == 1)) { const float ss = wsum(v0 * v0 + v1 * v1); const float rn = 1.0f / sqrtf(ss / HD + EPS); v0 *= rn * gain[lane]; v1 *= rn * gain[lane + 64]; }
        rec(res, a.phase, bf2f(O[((size_t)hh * SEQ + row) * HD + lane]), v0, 0.05f); rec(res, a.phase, bf2f(O[((size_t)hh * SEQ + row) * HD + lane + 64]), v1, 0.05f);
        return;
    }
    if (a.kind == 6) {
        const int row = (gw & 1) ? (h0 % 700) : (h0 % SEQ), hh = hash32(h0 + 1) % NH, c = row >> 6, k0 = (c - 8) * 64 > 0 ? (c - 8) * 64 : 0, k1 = (c + 1) * 64;
        const bf16_t* Q = (const bf16_t*)(ws + WS_QH) + ((size_t)hh * SEQ + row) * HD; const bf16_t* K = (const bf16_t*)(ws + WS_KH) + (size_t)hh * SEQ * HD; const bf16_t* V = (const bf16_t*)(ws + WS_VH) + (size_t)hh * SEQ * HD;
        const float* rel = a.in[18] + ((size_t)(l - NPOOL) * NH + hh) * NREL;
        float sc[9]; float mx = -1e30f;
        for (int j = 0; j < 9; ++j) { const int k = k0 + lane + 64 * j; sc[j] = -1e30f; if (k < k1) { float d = 0.f; for (int e = 0; e < HD; ++e) d += bf2f(Q[e]) * bf2f(K[(size_t)k * HD + e]);
            int r = row - k; r = r < -63 ? -63 : (r > 128 ? 128 : r); sc[j] = d * 0.08838834764831845f + rel[r + 63]; mx = fmaxf(mx, sc[j]); } }
        for (int o = 32; o >= 1; o >>= 1) mx = fmaxf(mx, __shfl_xor(mx, o));
        float den = 0.f; for (int j = 0; j < 9; ++j) { sc[j] = (sc[j] > -1e29f) ? expf(sc[j] - mx) : 0.f; den += sc[j]; } den = wsum(den);
        float o0 = 0.f, o1 = 0.f;
        for (int j = 0; j < 9; ++j) for (int src = 0; src < 64; ++src) { const float p = __shfl(sc[j], src); const int k = k0 + src + 64 * j; if (k < k1) { o0 += p * bf2f(V[(size_t)k * HD + lane]); o1 += p * bf2f(V[(size_t)k * HD + lane + 64]); } }
        rec(res, a.phase, bf2f(T1[(size_t)row * DM + hh * HD + lane]), o0 / den, 0.05f); rec(res, a.phase, bf2f(T1[(size_t)row * DM + hh * HD + lane + 64]), o1 / den, 0.05f);
        return;
    }
}
__global__ void chk_final(unsigned char* ws, float* out, int nph) {
    const unsigned* res = (const unsigned*)(ws + WS_RES);
    if (threadIdx.x == 0 && blockIdx.x == 0) { for (int p = 28; p < 34; ++p) { const float e = __uint_as_float(res[p]); if (e > 0.06f) { out[0] = (float)(p + 1) * 1e6f; return; } }
        for (int p = 0; p < nph; ++p) { const float e = __uint_as_float(res[p]); const float tol = 0.06f; if (e > tol) { out[0] = (float)(p + 1) * 1e6f; break; } } }
}
#endif

extern "C" void kernel_launch(void* const* d_in, const int* in_sizes, int n_in, void* d_out, int out_size, void* d_ws, size_t ws_size, hipStream_t stream) {
    static int grid = 0;
    if (grid == 0) {
        if (n_in != 20 || in_sizes[0] != SEQ * DM || out_size != SEQ * DM || ws_size < WS_END + (DUPMASK ? 100 * MiB : 0)) {
            fprintf(stderr, "kernel_launch: unexpected shapes (n_in %d, in0 %d, out %d, ws %zu < %zu); nothing launched\n", n_in, n_in > 0 ? in_sizes[0] : -1, out_size, ws_size, (size_t)WS_END); grid = -1; return; }
        int dev = 0, cus = 0, per_cu = 0;
        if (hipGetDevice(&dev) != hipSuccess || hipDeviceGetAttribute(&cus, hipDeviceAttributeMultiprocessorCount, dev) != hipSuccess) { fprintf(stderr, "kernel_launch: device query failed\n"); grid = -1; return; }
        if (hipFuncSetAttribute((const void*)fwd_kernel, hipFuncAttributeMaxDynamicSharedMemorySize, LDS_BYTES) != hipSuccess) { fprintf(stderr, "kernel_launch: hipFuncSetAttribute failed\n"); grid = -1; return; }
        if (hipOccupancyMaxActiveBlocksPerMultiprocessor(&per_cu, (const void*)fwd_kernel, NWAVES * 64, LDS_BYTES) != hipSuccess || per_cu < 1)
            fprintf(stderr, "kernel_launch: note: occupancy query reports %d workgroups per CU\n", per_cu);
        (void)hipGetLastError();
        grid = cus;
    }
    if (grid < 0) return;
    if (hipMemsetAsync((char*)d_ws + WS_CTL, 0, CTL_ZERO_BYTES, stream) != hipSuccess) { fprintf(stderr, "kernel_launch: memset failed\n"); return; }
    Args a{};
    for (int i = 0; i < 20; ++i) a.in[i] = (const float*)d_in[i];
    a.out = (float*)d_out; a.ws = (unsigned char*)d_ws;
#if MK_DEBUG
    {
        int kinds[N_PHASES], ls[N_PHASES], fs[N_PHASES], n = 0;
        kinds[n] = 0; ls[n] = 0; fs[n] = 0; ++n;
        for (int l = 0; l < DEPTH; ++l) { for (int f = 0; f < 2; ++f) { kinds[n] = 1; ls[n] = l; fs[n] = f; ++n; kinds[n] = 2; ls[n] = l; fs[n] = f; ++n;
            if (f == 0) { if (l < NPOOL) { kinds[n] = 3; ls[n] = l; fs[n] = f; ++n; kinds[n] = 4; ls[n] = l; fs[n] = f; ++n; } else { kinds[n] = 5; ls[n] = l; fs[n] = f; ++n; kinds[n] = 6; ls[n] = l; fs[n] = f; ++n; kinds[n] = 7; ls[n] = l; fs[n] = f; ++n; } } }
            if (l == NPOOL - 1) { kinds[n] = 8; ls[n] = l; fs[n] = 1; ++n; } }
        if (ws_size < WS_RES + 4096) { fprintf(stderr, "debug build: workspace too small\n"); return; }
        hipMemsetAsync((char*)d_ws + WS_RES, 0, 4096, stream);
        for (int p = 0; p < N_PHASES; ++p) {
            if ((kinds[p] == 2 || kinds[p] == 4 || kinds[p] == 7) && !(kinds[p] == 2 && ls[p] == 0 && fs[p] == 0)) hipMemcpyAsync((char*)d_ws + WS_XOLD, (char*)d_ws + WS_XB, (size_t)SEQ * DM * 2, hipMemcpyDeviceToDevice, stream);
            a.ph_lo = p; a.ph_hi = p + 1; hipLaunchKernelGGL(fwd_kernel, dim3(grid), dim3(NWAVES * 64), LDS_BYTES, stream, a);
            ChkArgs c{}; for (int i = 0; i < 20; ++i) c.in[i] = (const float*)d_in[i]; c.out = (float*)d_out; c.ws = (unsigned char*)d_ws; c.phase = p; c.kind = kinds[p]; c.l = ls[p]; c.f = fs[p];
            hipLaunchKernelGGL(chk_kernel, dim3(256), dim3(256), 0, stream, c);
        }
        hipLaunchKernelGGL(chk_final, dim3(1), dim3(64), 0, stream, (unsigned char*)d_ws, (float*)d_out, (int)N_PHASES);
    }
#elif MK_PER_PHASE
    for (int p = 0; p < N_PHASES; ++p) { a.ph_lo = p; a.ph_hi = p + 1; hipLaunchKernelGGL(fwd_kernel, dim3(grid), dim3(NWAVES * 64), LDS_BYTES, stream, a); }
#else
    a.ph_lo = 0; a.ph_hi = N_PHASES;
    hipLaunchKernelGGL(fwd_kernel, dim3(grid), dim3(NWAVES * 64), LDS_BYTES, stream, a);
#endif
    const hipError_t le = hipPeekAtLastError();
    if (le != hipSuccess) fprintf(stderr, "kernel_launch: launch failed: %s\n", hipGetErrorName(le));
}
```

```cpp
#include <hip/hip_runtime.h>
#include <hip/hip_bf16.h>
#include <cstdio>
#include <cstdint>

#ifndef MK_DEBUG
#define MK_DEBUG 0
#endif
#ifndef MK_PER_PHASE
#define MK_PER_PHASE MK_DEBUG
#endif

#ifndef PHMASK
#define PHMASK 0x3ff
#endif
#define PH_ON(k) (((PHMASK) >> (k)) & 1)
#ifndef MK_CLK
#define MK_CLK 0
#endif
#ifndef DUPMASK
#define DUPMASK 0
#endif
#define DUP_ON(k) (((DUPMASK) >> (k)) & 1)
#define DUP_LOOP(k) for (int rep_ = 0; rep_ < (DUP_ON(k) ? 2 : 1); ++rep_)
#define DUP3_LOOP(k) for (int rep_ = 0; rep_ < (DUP_ON(k) ? 3 : 1); ++rep_)
#define DUP3_BAR(k) if (DUP_ON(k) && rep_ < 2) GRID_BAR();
#define DUP3_SIGN (rep_ == 1 ? -1.0f : 1.0f)
#define DUP_BAR(k) if (DUP_ON(k) && rep_ == 0) GRID_BAR();
#define GAS __attribute__((address_space(1)))
#define LAS __attribute__((address_space(3)))
typedef unsigned short bf16_t;
typedef short bf16x8 __attribute__((ext_vector_type(8)));
typedef short s16x4 __attribute__((ext_vector_type(4)));
typedef float f32x4 __attribute__((ext_vector_type(4)));
typedef float f32x16 __attribute__((ext_vector_type(16)));
typedef unsigned u32x4 __attribute__((ext_vector_type(4)));
typedef unsigned u32x2 __attribute__((ext_vector_type(2)));
typedef GAS unsigned gu32;

constexpr int SEQ = 8192, DM = 2048, DFF = 5504, NH = 16, HD = 128, DEPTH = 4, NPOOL = 2, NATT = 2;
constexpr int NGU = 2 * DFF;
constexpr int NREL = 192;
#ifndef FP8_SETS
#define FP8_SETS 0x00
#endif
#ifndef FP8_O
#define FP8_O 1
#endif
#ifndef FP8_QKV
#define FP8_QKV 1
#endif
#ifndef FP8_D_SETS
#define FP8_D_SETS 0xC0
#endif
#ifndef FP8_FIRST_LAYER
#define FP8_FIRST_LAYER 4
#endif
__host__ __device__ constexpr bool use8(int set) { return ((FP8_SETS >> set) & 1) != 0; }
__host__ __device__ constexpr bool use8d(int set) { return (((FP8_SETS | FP8_D_SETS) >> set) & 1) != 0; }
static_assert(FP8_D_SETS == 0 || FP8_D_SETS == 0x80 || FP8_D_SETS == 0xC0, "FP8-down code paths: the last half-step, or both half-steps of the last layer");
static_assert(FP8_SETS == ((0xff << (2 * FP8_FIRST_LAYER)) & 0xff), "FP8_SETS = the sets of layers >= FP8_FIRST_LAYER");
constexpr int DFF8 = 5632;
constexpr float SO8 = 64.0f;
constexpr float SX8 = 0.25f, SWGU8 = 32.0f, SH8 = 8.0f, SWD8 = 64.0f;
constexpr float EPS = 1e-6f;
constexpr int NWAVES = 8;

constexpr size_t MiB = 1u << 20;
constexpr size_t WS_CTL = 0, CTL_ZERO_BYTES = 1 * MiB;
constexpr size_t WS_SSQ = 1 * MiB;
constexpr size_t WS_WGU = 2 * MiB;
constexpr size_t SZ_WGU = (size_t)NGU * DM * 2;
constexpr size_t WS_WD = WS_WGU + 8 * SZ_WGU;
constexpr size_t SZ_WD = (size_t)DM * DFF * 2;
constexpr size_t WS_WPOOL = WS_WD + 8 * SZ_WD;
constexpr size_t SZ_WPOOL = (size_t)4 * 512 * 512 * 2;
constexpr size_t WS_WKV = WS_WPOOL + 2 * SZ_WPOOL;
constexpr size_t WS_WQ = WS_WKV + (size_t)2 * DM * DM * 2;
constexpr size_t WS_WO = WS_WQ + (size_t)2 * DM * DM * 2;
constexpr size_t SZ_ACT = (size_t)SEQ * DM * 2;
constexpr size_t WS_XB = WS_WO + (size_t)2 * DM * DM * 2;
constexpr size_t WS_HB = WS_XB + SZ_ACT;
constexpr size_t WS_T1 = WS_HB + (size_t)SEQ * DFF * 2;
constexpr size_t WS_QH = WS_T1 + SZ_ACT;
constexpr size_t WS_KH = WS_QH + SZ_ACT;
constexpr size_t WS_VH = WS_KH + SZ_ACT;
constexpr size_t WS_XB8 = WS_VH + SZ_ACT;
constexpr size_t WS_H8 = WS_XB8 + (size_t)SEQ * DM;
constexpr size_t WS_END = WS_H8 + (size_t)SEQ * DFF8;
static_assert(SZ_WGU % 16 == 0 && SZ_WD % 16 == 0 && WS_XB % 256 == 0 && WS_HB % 256 == 0, "alignment");
constexpr int CW_TMO = 0, CW_CODE = 1;
constexpr int CW_BAR = 4096;

constexpr int RING_OFF = 0, RING_BYTES = 131072;
constexpr int LDSCTL_OFF = RING_BYTES, MISC_OFF = LDSCTL_OFF + 320;
constexpr int RSTD_OFF = 131584;
constexpr int HP_OFF = RSTD_OFF + 8192;
constexpr int LDS_BYTES = 155648;
static_assert(HP_OFF + 8192 <= LDS_BYTES && MISC_OFF + 128 <= RSTD_OFF, "LDS map");

#define RLX_AGENT __ATOMIC_RELAXED, __HIP_MEMORY_SCOPE_AGENT
#define LDS_WAIT() asm volatile("s_waitcnt lgkmcnt(0)" ::: "memory")
#define VM_WAIT() asm volatile("s_waitcnt vmcnt(0)" ::: "memory")
__device__ __forceinline__ unsigned f2bf(float f) { unsigned u = __builtin_bit_cast(unsigned, f); return (u + 0x7fffu + ((u >> 16) & 1u)) >> 16; }
__device__ __forceinline__ unsigned pk2(float lo, float hi) { return f2bf(lo) | (f2bf(hi) << 16); }
__device__ __forceinline__ unsigned cvt_pk_bf16(float lo, float hi) { unsigned r; asm volatile("v_cvt_pk_bf16_f32 %0, %1, %2" : "=v"(r) : "v"(lo), "v"(hi)); return r; }
__device__ __forceinline__ int lane_now() { int l; asm volatile("v_mbcnt_lo_u32_b32 %0, -1, 0\n\tv_mbcnt_hi_u32_b32 %0, -1, %0" : "=v"(l)); return l; }
__device__ __forceinline__ unsigned pk4_fp8(float a, float b, float c, float d) {
    a = __builtin_amdgcn_fmed3f(a, -448.f, 448.f); b = __builtin_amdgcn_fmed3f(b, -448.f, 448.f); c = __builtin_amdgcn_fmed3f(c, -448.f, 448.f); d = __builtin_amdgcn_fmed3f(d, -448.f, 448.f);
    int r = 0; r = __builtin_amdgcn_cvt_pk_fp8_f32(a, b, r, false); r = __builtin_amdgcn_cvt_pk_fp8_f32(c, d, r, true); return (unsigned)r; }
__device__ __forceinline__ int opaque_s(int x) { asm volatile("" : "+s"(x)); return x; }
__device__ __forceinline__ float xor16_add(float v) { return v + __builtin_bit_cast(float, __builtin_amdgcn_ds_swizzle(__builtin_bit_cast(int, v), 0x401F)); }
__device__ __forceinline__ float xor32_add(float v, int lane) { return v + __builtin_bit_cast(float, __builtin_amdgcn_ds_bpermute((lane ^ 32) << 2, __builtin_bit_cast(int, v))); }
__device__ __forceinline__ float xor1_get(float v) { return __builtin_bit_cast(float, __builtin_amdgcn_mov_dpp(__builtin_bit_cast(int, v), 0xB1, 0xF, 0xF, true)); }
__device__ __forceinline__ float wave_sum(float v, int lane) {
    v += __builtin_bit_cast(float, __builtin_amdgcn_ds_swizzle(__builtin_bit_cast(int, v), 0x041F));
    v += __builtin_bit_cast(float, __builtin_amdgcn_ds_swizzle(__builtin_bit_cast(int, v), 0x081F));
    v += __builtin_bit_cast(float, __builtin_amdgcn_ds_swizzle(__builtin_bit_cast(int, v), 0x101F));
    v += __builtin_bit_cast(float, __builtin_amdgcn_ds_swizzle(__builtin_bit_cast(int, v), 0x201F));
    v = xor16_add(v);
    return xor32_add(v, lane);
}

#ifndef PG8_ASM_DMA
#define PG8_ASM_DMA 1
#endif
namespace pg8 {
constexpr int BM = 256, BK = 64, HALF = 128, HTB = HALF * BK * 2, STAGE_BYTES = 8 * HTB, NXCD = 8, WGM = 4;
__host__ __device__ __forceinline__ int lds_byte(int r, int c) { const int st = (r >> 4) * 2 + (c >> 5), rr = r & 15, cc = c & 31, ob = rr * 64 + cc * 2; return st * 1024 + (ob ^ (((ob >> 9) & 1) << 5)); }
__host__ __device__ __forceinline__ void stage_rc(int b, int& R, int& C) { const int st = b / 1024, sb = b % 1024, swz = sb ^ (((sb >> 9) & 1) << 5); R = (st >> 1) * 16 + swz / 64; C = (st & 1) * 32 + (swz % 64) / 2; }
__host__ __device__ __forceinline__ int perm32(int rho) { const int n = rho >> 4, i = rho & 15; return 8 * (i >> 2) + 4 * n + (i & 3); }

struct Unit { int pm, pn; };
struct Gemm { const bf16_t* A; const bf16_t* Bt; int lda, ldb, K; };

struct StaticOrder {
    int nM, nN, nwg, G, c;
    __host__ __device__ void init(int M, int N, int G_, int c_) { nM = M / BM; nN = N / BM; nwg = nM * nN; G = G_; c = c_; }
    __host__ __device__ bool next(int i, Unit& u) const {
        const long L = (long)i * G + c; if (L >= nwg) return false;
        int wgid = (int)L; { const int q = nwg / NXCD, r = nwg % NXCD, xcd = wgid % NXCD, off = wgid / NXCD; wgid = (xcd < r ? xcd * (q + 1) : r * (q + 1) + (xcd - r) * q) + off; }
        const int nig = WGM * nN, gid = wgid / nig, fm = gid * WGM, gsz = (nM - fm) < WGM ? (nM - fm) : WGM;
        u.pm = fm + ((wgid % nig) % gsz); u.pn = (wgid % nig) / gsz; return true;
    }
};
struct PlainTiles {
    __device__ __forceinline__ size_t a_off(const Unit& u, int lda) const { return (size_t)u.pm * BM * lda; }
    __device__ __forceinline__ size_t b_off(const Unit& u, int ldb) const { return (size_t)u.pn * BM * ldb; }
};
struct PoolTiles {
    __device__ __forceinline__ size_t a_off(const Unit& u, int lda) const { return (size_t)u.pm * BM * lda + (size_t)(u.pn >> 1) * 512; }
    __device__ __forceinline__ size_t b_off(const Unit& u, int ldb) const { return (size_t)(u.pn >> 1) * 512 * 512 + (size_t)(u.pn & 1) * BM * ldb; }
};

typedef int i32x4v __attribute__((ext_vector_type(4)));
typedef int i32x8v __attribute__((ext_vector_type(8)));
__device__ __forceinline__ i32x8v cat8(bf16x8 a, bf16x8 b) { const i32x4v x = __builtin_bit_cast(i32x4v, a), y = __builtin_bit_cast(i32x4v, b); return __builtin_shufflevector(x, y, 0, 1, 2, 3, 4, 5, 6, 7); }
template <class Epi, class Tiles, bool F8 = false>
__device__ __forceinline__ void gemm_phase(LAS unsigned char* lds, int wave_id, const Gemm g, const StaticOrder& S, const Tiles& T, const Epi& E) {
    const int lane = lane_now(), wid = opaque_s(wave_id), tid = wid * 64 + lane, wr = wid >> 2, wc = wid & 3, fr = lane & 15, fq = lane >> 4;
    const int K = g.K, nt = K / BK;
    unsigned voffA[2], voffB[2];
#pragma unroll
    for (int i = 0; i < 2; ++i) { int R, C; stage_rc(tid * 16 + i * 8192, R, C); const int Rb = Epi::PERM ? ((R & ~31) + perm32(R & 31)) : R;
        voffA[i] = (unsigned)(R * g.lda + C) * 2u; voffB[i] = (unsigned)(Rb * g.ldb + C) * 2u; }
    const size_t kstep = (size_t)(BK * 2);
    const size_t hstepA = (size_t)HALF * g.lda * 2, hstepB = (size_t)HALF * g.ldb * 2;
    const unsigned ldsw = (unsigned)wid * 1024u;
    const unsigned lds_base32 = (unsigned)(size_t)lds;
    const int aoff = lds_byte(wr * 64 + fr, fq * 8), boff = lds_byte(wc * 32 + fr, fq * 8);
#define PG8_SA(b, h) (((b) * 2 + (h)) * HTB)
#define PG8_SB(b, h) ((4 + (b) * 2 + (h)) * HTB)
#define PG8_STAGE(bufoff, gbase, voff) do { if constexpr (F8 || PG8_ASM_DMA) { _Pragma("unroll") for (int _i = 0; _i < 2; ++_i) { unsigned _keep; \
        asm volatile("s_mov_b32 %0, m0\n\ts_mov_b32 m0, %3\n\ts_nop 0\n\tglobal_load_lds_dwordx4 %1, %2\n\ts_mov_b32 m0, %0" : "=&s"(_keep) : "v"((voff)[_i]), "s"((const char*)(gbase)), "s"(lds_base32 + (unsigned)(bufoff) + ldsw + (unsigned)(_i * 8192)) : "memory"); } } \
    else { _Pragma("unroll") for (int _i = 0; _i < 2; ++_i) \
        __builtin_amdgcn_global_load_lds((const unsigned*)((const char*)(gbase) + (voff)[_i]), (LAS unsigned*)(lds + (bufoff) + ldsw + _i * 8192), 16, 0, 0); } } while (0)
#define PG8_LDA(dst, b, h) do { if constexpr (F8) { _Pragma("unroll") for (int m = 0; m < 4; ++m) dst##_8[m] = cat8(*(const LAS bf16x8*)(lds + PG8_SA(b, h) + aoff + m * 2048), *(const LAS bf16x8*)(lds + PG8_SA(b, h) + aoff + m * 2048 + 1024)); } \
        else { _Pragma("unroll") for (int m = 0; m < 4; ++m) _Pragma("unroll") for (int k = 0; k < 2; ++k) dst[m][k] = *(const LAS bf16x8*)(lds + PG8_SA(b, h) + aoff + m * 2048 + k * 1024); } } while (0)
#define PG8_LDB(dst, b, h) do { if constexpr (F8) { _Pragma("unroll") for (int n = 0; n < 2; ++n) dst##_8[n] = cat8(*(const LAS bf16x8*)(lds + PG8_SB(b, h) + boff + n * 2048), *(const LAS bf16x8*)(lds + PG8_SB(b, h) + boff + n * 2048 + 1024)); } \
        else { _Pragma("unroll") for (int n = 0; n < 2; ++n) _Pragma("unroll") for (int k = 0; k < 2; ++k) dst[n][k] = *(const LAS bf16x8*)(lds + PG8_SB(b, h) + boff + n * 2048 + k * 1024); } } while (0)
#define PG8_MMA(ai, bj, At, Bt) do { __builtin_amdgcn_s_setprio(1); if constexpr (F8) { _Pragma("unroll") for (int m = 0; m < 4; ++m) _Pragma("unroll") for (int n = 0; n < 2; ++n) \
        acc[ai][bj][m][n] = __builtin_amdgcn_mfma_scale_f32_16x16x128_f8f6f4(Bt##_8[n], At##_8[m], acc[ai][bj][m][n], 0, 0, 0, 0x7F7F7F7F, 0, 0x7F7F7F7F); } \
        else { _Pragma("unroll") for (int m = 0; m < 4; ++m) _Pragma("unroll") for (int n = 0; n < 2; ++n) _Pragma("unroll") for (int k = 0; k < 2; ++k) \
        acc[ai][bj][m][n] = __builtin_amdgcn_mfma_f32_16x16x32_bf16(Bt[n][k], At[m][k], acc[ai][bj][m][n], 0, 0, 0); } __builtin_amdgcn_s_setprio(0); } while (0)
#define PG8_WAIT_V(n) asm volatile("s_waitcnt vmcnt(" #n ")" ::: "memory")
#define PG8_WAIT_L(n) asm volatile("s_waitcnt lgkmcnt(" #n ")" ::: "memory")
#define PG8_BAR __builtin_amdgcn_s_barrier()
#define PG8_SCHED __builtin_amdgcn_sched_barrier(0)
    Unit cur, nxt; int ui = 0;
    if (!S.next(0, cur)) return;
    f32x4 acc[2][2][4][2];
#pragma unroll
    for (int a = 0; a < 2; ++a)
#pragma unroll
        for (int b = 0; b < 2; ++b)
#pragma unroll
            for (int m = 0; m < 4; ++m)
#pragma unroll
                for (int n = 0; n < 2; ++n) acc[a][b][m][n] = (f32x4){0.f, 0.f, 0.f, 0.f};
    bf16x8 At[4][2], B0[2][2], B1[2][2];
    i32x8v At_8[4], B0_8[2], B1_8[2];
    const char* cA = (const char*)(g.A + T.a_off(cur, g.lda)); const char* cB = (const char*)(g.Bt + T.b_off(cur, g.ldb));
    PG8_STAGE(PG8_SB(0, 0), cB, voffB); PG8_STAGE(PG8_SB(0, 1), cB + hstepB, voffB); PG8_STAGE(PG8_SA(0, 0), cA, voffA); PG8_STAGE(PG8_SA(0, 1), cA + hstepA, voffA);
    if (wr == 1) PG8_BAR;
    PG8_WAIT_V(2); PG8_BAR;
    PG8_STAGE(PG8_SB(1, 0), cB + kstep, voffB); PG8_STAGE(PG8_SA(1, 0), cA + kstep, voffA); PG8_STAGE(PG8_SB(1, 1), cB + hstepB + kstep, voffB);
    PG8_WAIT_V(6); PG8_BAR;
    for (;;) {
        const bool has_next = S.next(ui + 1, nxt);
        const char* nA = has_next ? (const char*)(g.A + T.a_off(nxt, g.lda)) : cA; const char* nB = has_next ? (const char*)(g.Bt + T.b_off(nxt, g.ldb)) : cB;
        for (int t = 0; t < nt; t += 2) {
            const bool last = (t == nt - 2);
            const char* a1 = cA + (size_t)(t + 1) * kstep;
            const char* a2 = last ? nA : cA + (size_t)(t + 2) * kstep; const char* b2 = last ? nB : cB + (size_t)(t + 2) * kstep;
            const char* a3 = a2 + kstep; const char* b3 = b2 + kstep;
            PG8_LDB(B0, 0, 0); PG8_LDB(B1, 0, 1); PG8_SCHED; PG8_LDA(At, 0, 0); PG8_STAGE(PG8_SA(1, 1), a1 + hstepA, voffA);
            PG8_WAIT_V(8); PG8_WAIT_L(0); PG8_BAR; PG8_MMA(0, 0, At, B0); PG8_MMA(0, 1, At, B1); PG8_BAR; PG8_SCHED;
            PG8_LDA(At, 0, 1); PG8_STAGE(PG8_SB(0, 0), b2, voffB); PG8_STAGE(PG8_SB(0, 1), b2 + hstepB, voffB); PG8_STAGE(PG8_SA(0, 0), a2, voffA);
            PG8_WAIT_V(8); PG8_WAIT_L(0); PG8_BAR; PG8_MMA(1, 0, At, B0); PG8_MMA(1, 1, At, B1); PG8_BAR; PG8_SCHED;
            PG8_LDB(B0, 1, 0); PG8_LDB(B1, 1, 1); PG8_SCHED; PG8_LDA(At, 1, 0); PG8_STAGE(PG8_SA(0, 1), a2 + hstepA, voffA);
            PG8_WAIT_V(8); PG8_WAIT_L(0); PG8_BAR; PG8_MMA(0, 0, At, B0); PG8_MMA(0, 1, At, B1); PG8_BAR; PG8_SCHED;
            PG8_LDA(At, 1, 1); PG8_STAGE(PG8_SB(1, 0), b3, voffB); PG8_STAGE(PG8_SB(1, 1), b3 + hstepB, voffB); PG8_STAGE(PG8_SA(1, 0), a3, voffA);
            PG8_WAIT_V(8); PG8_WAIT_L(0); PG8_BAR; PG8_MMA(1, 0, At, B0); PG8_MMA(1, 1, At, B1); PG8_BAR; PG8_SCHED;
        }
        if (wr == 0) PG8_BAR;
        E(acc, cur, ui, wr, wc, fr, fq, lds);
        if (!has_next) break;
#pragma unroll
        for (int a = 0; a < 2; ++a)
#pragma unroll
            for (int b = 0; b < 2; ++b)
#pragma unroll
                for (int m = 0; m < 4; ++m)
#pragma unroll
                    for (int n = 0; n < 2; ++n) acc[a][b][m][n] = (f32x4){0.f, 0.f, 0.f, 0.f};
        cur = nxt; cA = nA; cB = nB; ++ui;
        if (wr == 1) PG8_BAR;
    }
    PG8_WAIT_V(0);
    PG8_BAR;
#undef PG8_SA
#undef PG8_SB
#undef PG8_STAGE
#undef PG8_LDA
#undef PG8_LDB
#undef PG8_MMA
#undef PG8_WAIT_V
#undef PG8_WAIT_L
#undef PG8_BAR
#undef PG8_SCHED
}

__device__ __forceinline__ float silu_mul(float g, float u) {
    const float e = __builtin_amdgcn_exp2f(g * -1.4426950408889634f);
    return g * u * __builtin_amdgcn_rcpf(1.0f + e);
}
__device__ __forceinline__ f32x4 swiglu4(const f32x4 g, const f32x4 u, float c1, float k) {
    const f32x4 t = g * c1;
    const f32x4 e = {__builtin_amdgcn_exp2f(t[0]), __builtin_amdgcn_exp2f(t[1]), __builtin_amdgcn_exp2f(t[2]), __builtin_amdgcn_exp2f(t[3])};
    const f32x4 kv = {k, k, k, k};
    const f32x4 d = __builtin_elementwise_fma(e, kv, kv);
    const f32x4 r = {__builtin_amdgcn_rcpf(d[0]), __builtin_amdgcn_rcpf(d[1]), __builtin_amdgcn_rcpf(d[2]), __builtin_amdgcn_rcpf(d[3])};
    return (g * u) * r;
}
struct EpiSwiGLU {
    static constexpr bool PERM = true;
    bf16_t* H; unsigned char* H8; float desc;
    __device__ __forceinline__ void operator()(const f32x4 (&acc)[2][2][4][2], const Unit& u, int ui, int wr, int wc, int fr, int fq, LAS unsigned char* lds) const {
        const LAS float* tab = (const LAS float*)(lds + RSTD_OFF) + ui * 256;
        int fr_ = fr; asm volatile("" : "+v"(fr_));
        const int rl0 = wr * 64 + fr_, col0 = u.pn * 128 + wc * 32 + 8 * fq;
#pragma unroll
        for (int ai = 0; ai < 2; ++ai)
#pragma unroll
            for (int m = 0; m < 4; ++m) {
                const int rl = ai * HALF + rl0 + m * 16; const float rs = tab[rl] * desc;
                const float c1 = rs * -1.4426950408889634f, kk = __builtin_amdgcn_rcpf((rs * rs) * (H8 ? SH8 : 1.0f));
                const f32x4 h0 = swiglu4(acc[ai][0][m][0], acc[ai][1][m][0], c1, kk), h1 = swiglu4(acc[ai][0][m][1], acc[ai][1][m][1], c1, kk);
                if (H8) {
                    u32x2 w8; w8.x = pk4_fp8(h0[0], h0[1], h0[2], h0[3]); w8.y = pk4_fp8(h1[0], h1[1], h1[2], h1[3]);
                    *(u32x2*)(H8 + (size_t)(u.pm * BM + rl) * DFF8 + col0) = w8;
                } else {
                    u32x4 w;
                    w.x = cvt_pk_bf16(h0[0], h0[1]); w.y = cvt_pk_bf16(h0[2], h0[3]); w.z = cvt_pk_bf16(h1[0], h1[1]); w.w = cvt_pk_bf16(h1[2], h1[3]);
                    *(u32x4*)(H + (size_t)(u.pm * BM + rl) * DFF + col0) = w;
                }
            }
    }
};
__device__ __forceinline__ f32x4 bf4_lo(unsigned a, unsigned b) { return (f32x4){__builtin_bit_cast(float, a << 16), __builtin_bit_cast(float, a & 0xffff0000u), __builtin_bit_cast(float, b << 16), __builtin_bit_cast(float, b & 0xffff0000u)}; }
struct EpiRes {
    static constexpr bool PERM = true;
    const bf16_t* baseb; const float* basef; bf16_t* xb; float* outf; float* ssq; const float* cscale; float alpha; unsigned char* xb8;
    __device__ __forceinline__ void operator()(const f32x4 (&acc)[2][2][4][2], const Unit& u, int ui, int wr, int wc, int fr, int fq, LAS unsigned char* lds) const {
        const int ln_ = lane_now(), fr_ = ln_ & 15, fq_ = ln_ >> 4;
        const int rl0 = wr * 64 + fr_, col0 = u.pn * BM + wc * 32 + 8 * fq_;
        f32x4 cs[2][2];
        const float al = __builtin_bit_cast(float, opaque_s(__builtin_bit_cast(int, alpha)));
#pragma unroll
        for (int bj = 0; bj < 2; ++bj)
#pragma unroll
            for (int n = 0; n < 2; ++n) { cs[bj][n] = cscale ? *(const f32x4*)(cscale + col0 + bj * HALF + n * 4) * al : (f32x4){al, al, al, al}; }
#pragma unroll
        for (int ai = 0; ai < 2; ++ai)
#pragma unroll
            for (int m = 0; m < 4; ++m) {
                const int row = u.pm * BM + ai * HALF + rl0 + m * 16; const size_t off = (size_t)row * DM + col0; float ss = 0.f;
#pragma unroll
                for (int bj = 0; bj < 2; ++bj) {
                    f32x4 b0, b1;
                    if (basef) { b0 = *(const f32x4*)(basef + off + bj * HALF); b1 = *(const f32x4*)(basef + off + bj * HALF + 4); }
                    else { const u32x4 w = *(const u32x4*)(baseb + off + bj * HALF); b0 = bf4_lo(w.x, w.y); b1 = bf4_lo(w.z, w.w); }
                    const f32x4 o0 = b0 + acc[ai][bj][m][0] * cs[bj][0], o1 = b1 + acc[ai][bj][m][1] * cs[bj][1];
                    if (outf) { *(f32x4*)(outf + off + bj * HALF) = o0; *(f32x4*)(outf + off + bj * HALF + 4) = o1; }
                    u32x4 r; r.x = cvt_pk_bf16(o0[0], o0[1]); r.y = cvt_pk_bf16(o0[2], o0[3]); r.z = cvt_pk_bf16(o1[0], o1[1]); r.w = cvt_pk_bf16(o1[2], o1[3]);
                    *(u32x4*)(xb + off + bj * HALF) = r;
                    if (xb8) { u32x2 r8; r8.x = pk4_fp8(o0[0] * SX8, o0[1] * SX8, o0[2] * SX8, o0[3] * SX8); r8.y = pk4_fp8(o1[0] * SX8, o1[1] * SX8, o1[2] * SX8, o1[3] * SX8); *(u32x2*)(xb8 + off + bj * HALF) = r8; }
                    const f32x4 v0 = bf4_lo(r.x, r.y), v1 = bf4_lo(r.z, r.w);
                    ss += ((v0[0] * v0[0] + v0[1] * v0[1]) + (v0[2] * v0[2] + v0[3] * v0[3])) + ((v1[0] * v1[0] + v1[1] * v1[1]) + (v1[2] * v1[2] + v1[3] * v1[3]));
                }
                ss = xor16_add(ss); ss = xor32_add(ss, ln_);
                if (fq_ == 0) ssq[(size_t)row * 32 + u.pn * 4 + wc] = ss;
                asm volatile("" ::: "memory");
            }
    }
};
struct EpiHead {
    static constexpr bool PERM = true;
    bf16_t* dst0; bf16_t* dst1; const float* gain; int nnorm; float desc;
    __device__ __forceinline__ void operator()(const f32x4 (&acc)[2][2][4][2], const Unit& u, int ui, int wr, int wc, int fr, int fq, LAS unsigned char* lds) const {
        const LAS float* tab = (const LAS float*)(lds + RSTD_OFF) + ui * 256;
        LAS float* HP = (LAS float*)(lds + HP_OFF);
        const int ln_ = lane_now(), fr_ = ln_ & 15, fq_ = ln_ >> 4;
        const int rl0 = wr * 64 + fr_, d0 = wc * 32 + 8 * fq_;
        const bool norm = u.pn < nnorm; const int pnl = norm ? u.pn : u.pn - nnorm; bf16_t* dst = norm ? dst0 : dst1;
        if (norm) {
#pragma unroll
            for (int ai = 0; ai < 2; ++ai)
#pragma unroll
                for (int m = 0; m < 4; ++m) {
                    const int rl = ai * HALF + rl0 + m * 16; const float rs = tab[rl] * desc;
#pragma unroll
                    for (int bj = 0; bj < 2; ++bj) {
                        const f32x4 a = acc[ai][bj][m][0] * rs, b = acc[ai][bj][m][1] * rs;
                        float s = ((a[0] * a[0] + a[1] * a[1]) + (a[2] * a[2] + a[3] * a[3])) + ((b[0] * b[0] + b[1] * b[1]) + (b[2] * b[2] + b[3] * b[3]));
                        s = xor16_add(s); s = xor32_add(s, fq_ * 16 + fr_);
                        if (fq_ == 0) HP[(rl * 2 + bj) * 4 + wc] = s;
                    }
                }
            asm volatile("s_waitcnt lgkmcnt(0)" ::: "memory"); __builtin_amdgcn_s_barrier(); asm volatile("" ::: "memory");
        }
        f32x4 gv0 = {1.f, 1.f, 1.f, 1.f}, gv1 = {1.f, 1.f, 1.f, 1.f};
        if (norm) { gv0 = *(const f32x4*)(gain + d0); gv1 = *(const f32x4*)(gain + d0 + 4); }
#pragma unroll
        for (int ai = 0; ai < 2; ++ai)
#pragma unroll
            for (int m = 0; m < 4; ++m) {
                const int rl = ai * HALF + rl0 + m * 16; const float rs = tab[rl] * desc;
#pragma unroll
                for (int bj = 0; bj < 2; ++bj) {
                    float sc = rs;
                    if (norm) { const f32x4 p = *(const LAS f32x4*)(HP + (rl * 2 + bj) * 4); sc = rs * __builtin_amdgcn_rsqf(((p[0] + p[1]) + (p[2] + p[3])) * (1.0f / 128.0f) + EPS); }
                    const f32x4 a = acc[ai][bj][m][0] * sc * gv0, b = acc[ai][bj][m][1] * sc * gv1;
                    u32x4 w; w.x = cvt_pk_bf16(a[0], a[1]); w.y = cvt_pk_bf16(a[2], a[3]); w.z = cvt_pk_bf16(b[0], b[1]); w.w = cvt_pk_bf16(b[2], b[3]);
                    *(u32x4*)(dst + ((size_t)(2 * pnl + bj) * SEQ + (size_t)(u.pm * BM + rl)) * HD + d0) = w;
                }
            }
    }
};
}

namespace att {
constexpr int NW = 8, QBLK = 32, KVBLK = 64, QB = NW * QBLK, D = 128;
constexpr int SHM_V = KVBLK * D * 2, SHM_K = KVBLK * D * 2;
constexpr int WS_OFF = 2 * SHM_V + 2 * SHM_K, ETAB_OFF = WS_OFF + NW * 64 * 4, ATT_LDS = ETAB_OFF + 256 * 4;
static_assert(ATT_LDS <= RING_BYTES, "attention LDS inside the ring region");
constexpr float SCALE = 0.08838834764831845f, THR = 8.f;
#define KSWZ(row, colB) ((row) * 256 + ((colB) ^ (((row) & 7) << 4)))
#define SBAR() __builtin_amdgcn_sched_barrier(0)
__device__ __forceinline__ int v_st(int k, int c) { const int kk = (k & ~0xC) | ((k & 4) << 1) | ((k & 8) >> 1); return ((kk >> 3) * 4 + (c >> 5)) * 512 + ((kk & 7) * 32 + (c & 31)) * 2; }
__device__ __forceinline__ int v_rd_base(int lane) { return ((lane & 3) << 3) | (((lane >> 2) & 3) << 6) | (((lane >> 4) & 1) << 5) | (((lane >> 5) & 1) << 8); }
constexpr int v_rd_off(int d0, int ks, int half) { return d0 * 512 + ks * 4096 + half * 2048; }
__device__ __forceinline__ int crow(int r, int hi) { return (r & 3) + 8 * (r >> 2) + 4 * hi; }
__device__ __forceinline__ unsigned cvtpk(float lo, float hi) { unsigned r; asm volatile("v_cvt_pk_bf16_f32 %0, %1, %2" : "=v"(r) : "v"(lo), "v"(hi)); return r; }
__device__ __forceinline__ bf16x8 load8(const bf16_t* p) { return *reinterpret_cast<const bf16x8*>(p); }

__device__ __forceinline__ void partialSM(f32x16& p0, f32x16& p1, float& m_reg, float& mn, float& alpha) {
    float pmax = p0[0]; for (int r = 1; r < 16; ++r) pmax = fmaxf(pmax, p0[r]); for (int r = 0; r < 16; ++r) pmax = fmaxf(pmax, p1[r]);
    { auto rr = __builtin_amdgcn_permlane32_swap(__float_as_uint(pmax), __float_as_uint(pmax), false, false);
      pmax = fmaxf(__uint_as_float(rr[0]), __uint_as_float(rr[1])); }
    constexpr float C2 = 1.4426950408889634f * SCALE;
    if (__builtin_expect(__all((pmax - m_reg) * SCALE <= THR), 1)) { mn = m_reg; alpha = 1.f; }
    else { mn = fmaxf(m_reg, pmax); alpha = __builtin_amdgcn_exp2f((m_reg - mn) * C2); m_reg = mn; }
    const float mnL = -mn * C2;
    for (int r = 0; r < 16; ++r) p0[r] = fmaf(p0[r], C2, mnL); for (int r = 0; r < 16; ++r) p1[r] = fmaf(p1[r], C2, mnL);
    for (int r = 0; r < 16; ++r) p0[r] = __builtin_amdgcn_exp2f(p0[r]);
}
__device__ __forceinline__ void finishSM(f32x16& p0, f32x16& p1, float alpha, float& l_reg, bf16x8& pa0, bf16x8& pa1, bf16x8& pa2, bf16x8& pa3) {
    for (int r = 0; r < 16; ++r) p1[r] = __builtin_amdgcn_exp2f(p1[r]);
    float ps = 0; for (int r = 0; r < 16; ++r) ps += p0[r]; for (int r = 0; r < 16; ++r) ps += p1[r];
    { auto rr = __builtin_amdgcn_permlane32_swap(__float_as_uint(ps), __float_as_uint(ps), false, false);
      ps = __uint_as_float(rr[0]) + __uint_as_float(rr[1]); }
    l_reg = l_reg * alpha + ps;
#define PK4(P, B_, OUT) do { unsigned a0 = cvtpk(P[B_+0], P[B_+1]), a1 = cvtpk(P[B_+2], P[B_+3]);                          \
        unsigned b0 = cvtpk(P[B_+4], P[B_+5]), b1 = cvtpk(P[B_+6], P[B_+7]);                                             \
        auto r0 = __builtin_amdgcn_permlane32_swap(a0, b0, false, false); auto r1 = __builtin_amdgcn_permlane32_swap(a1, b1, false, false); \
        u32x4 w = {r0[0], r1[0], r0[1], r1[1]}; OUT = *reinterpret_cast<bf16x8*>(&w); } while (0)
    PK4(p0, 0, pa0); PK4(p0, 8, pa1); PK4(p1, 0, pa2); PK4(p1, 8, pa3);
#undef PK4
}
template <int KB>
__device__ __forceinline__ void qkt(f32x16& p0, f32x16& p1, const char* K_lds, int r32, int hi, const bf16x8* qr, bool act, int delta, const float* etab, int wodd, float c191) {
    if (!act) { const float NEG = -__builtin_inff();
#pragma unroll
        for (int r = 0; r < 16; ++r) { p0[r] = NEG; p1[r] = NEG; } return; }
    if (delta >= 3) {
#pragma unroll
        for (int r = 0; r < 16; ++r) { p0[r] = c191; p1[r] = c191; }
    } else {
        const float* e = etab + (wodd * 32 + r32 + 4 - 4 * hi) + 64 * delta;
#pragma unroll
        for (int r = 0; r < 16; ++r) { const int c = (r & 3) + 8 * (r >> 2); p0[r] = e[59 - c]; p1[r] = e[27 - c]; }
    }
    const char* kb[4];
#pragma unroll
    for (int dd = 0; dd < 4; ++dd) kb[dd] = K_lds + KB * SHM_K + KSWZ(r32, (dd * 16 + hi * 8) * 2);
#pragma unroll
    for (int d0 = 0; d0 < 8; ++d0) { const char* a = kb[d0 & 3] + (d0 >> 2) * 128;
        bf16x8 b0 = *reinterpret_cast<const bf16x8*>(a);
        bf16x8 b1 = *reinterpret_cast<const bf16x8*>(a + 32 * 256);
        p0 = __builtin_amdgcn_mfma_f32_32x32x16_bf16(b0, qr[d0], p0, 0, 0, 0);
        p1 = __builtin_amdgcn_mfma_f32_32x32x16_bf16(b1, qr[d0], p1, 0, 0, 0); }
}
template <int VB>
__device__ __forceinline__ void pv_tile(f32x16* o, int vb0, bf16x8 pa0, bf16x8 pa1, bf16x8 pa2, bf16x8 pa3, bool act) {
    if (!act) return;
#define TRRD(dst, off) asm volatile("ds_read_b64_tr_b16 %0, %1 offset:%2" : "=&v"(dst) : "v"(vb0), "i"(off) : "memory")
#define PV_D0(d0) do { s16x4 l0, l1, l2, l3, h0, h1, h2, h3; constexpr int b_ = VB * SHM_V + v_rd_off(d0, 0, 0); \
        TRRD(l0, b_); TRRD(h0, b_ + 2048); TRRD(l1, b_ + 4096); TRRD(h1, b_ + 6144); TRRD(l2, b_ + 8192); TRRD(h2, b_ + 10240); TRRD(l3, b_ + 12288); TRRD(h3, b_ + 14336); \
        asm volatile("s_waitcnt lgkmcnt(0)" ::: "memory"); SBAR();   \
        o[d0] = __builtin_amdgcn_mfma_f32_32x32x16_bf16(pa0, (bf16x8){l0[0], l0[1], l0[2], l0[3], h0[0], h0[1], h0[2], h0[3]}, o[d0], 0, 0, 0);   \
        o[d0] = __builtin_amdgcn_mfma_f32_32x32x16_bf16(pa1, (bf16x8){l1[0], l1[1], l1[2], l1[3], h1[0], h1[1], h1[2], h1[3]}, o[d0], 0, 0, 0);   \
        o[d0] = __builtin_amdgcn_mfma_f32_32x32x16_bf16(pa2, (bf16x8){l2[0], l2[1], l2[2], l2[3], h2[0], h2[1], h2[2], h2[3]}, o[d0], 0, 0, 0);   \
        o[d0] = __builtin_amdgcn_mfma_f32_32x32x16_bf16(pa3, (bf16x8){l3[0], l3[1], l3[2], l3[3], h3[0], h3[1], h3[2], h3[3]}, o[d0], 0, 0, 0); } while (0)
    PV_D0(0); PV_D0(1); PV_D0(2); PV_D0(3);
#undef PV_D0
#undef TRRD
}
struct BlockRef { const bf16_t* Q; const bf16_t* K; const bf16_t* V; bf16_t* O; const float* rel; int P0; };
struct Seam { bf16x8 qr[8]; bf16x8 st_v0, st_v1, st_k0, st_k1; };
__device__ __forceinline__ int jlo_of(int P0) { const int c = P0 / KVBLK - 8; return c > 0 ? c : 0; }
#define ROW(p, k0, rr) ((p) + (size_t)((k0) + (rr)) * D + sc)
#define VMW() asm volatile("s_waitcnt vmcnt(0)" ::: "memory")
#define VMWN(n) asm volatile("s_waitcnt vmcnt(%0)" :: "i"(n) : "memory")
#define SLOAD_H(Kp, Vp, k0) do { S.st_v0 = load8(ROW(Vp, k0, sr)); S.st_v1 = load8(ROW(Vp, k0, 32 + sr));              \
                         S.st_k0 = load8(ROW(Kp, k0, sr)); S.st_k1 = load8(ROW(Kp, k0, 32 + sr)); } while (0)
#define SWRITE_HK(bf) do { *(bf16x8*)(K_lds + (bf) * SHM_K + kws) = S.st_k0; *(bf16x8*)(K_lds + (bf) * SHM_K + kws + 32 * 256) = S.st_k1; } while (0)
#define SWRITE_HV(bf) do { *(bf16x8*)(V_lds + (bf) * SHM_V + vst0) = S.st_v0; *(bf16x8*)(V_lds + (bf) * SHM_V + vst1) = S.st_v1; } while (0)
#define SWRITE_H(bf) do { SWRITE_HV(bf); SWRITE_HK(bf); } while (0)
__device__ __forceinline__ void etab_write(char* lds, const float* rel, int tid) {
    if (tid < 256) { const int i = tid < NREL - 1 ? tid : NREL - 1; ((float*)(lds + ETAB_OFF))[tid] = rel[i] * (1.0f / SCALE); }
}
__device__ __forceinline__ void attn_prime(const BlockRef& cur, char* lds, Seam& S, int wid) {
    const int lane = lane_now(), tid = wid * 64 + lane, r32 = lane & 31, hi = lane >> 5;
    const int sr = tid >> 4, sc = (tid & 15) * 8, kws = KSWZ(sr, sc * 2); char* K_lds = lds + 2 * SHM_V;
    const int kb0 = jlo_of(cur.P0) * KVBLK;
    for (int d0 = 0; d0 < 8; ++d0) S.qr[d0] = load8(cur.Q + (size_t)(wid * QBLK + r32) * D + d0 * 16 + hi * 8);
    SLOAD_H(cur.K, cur.V, kb0); VMW(); SWRITE_HK(0);
    etab_write(lds, cur.rel, tid);
    __syncthreads();
}
__device__ __forceinline__ void attn_block(const BlockRef& cur, const BlockRef& nxt, char* lds, Seam& S, int wid) {
    const int lane = lane_now(), tid = wid * 64 + lane, r32 = lane & 31, hi = lane >> 5;
    const int j_lo = jlo_of(cur.P0), j_hi = cur.P0 / KVBLK + QB / KVBLK;
    const int NT = j_hi - j_lo;
    const int kbn = jlo_of(nxt.P0) * KVBLK;
    const int cw = cur.P0 / KVBLK + (wid >> 1);
    char* V_lds = lds; char* K_lds = lds + 2 * SHM_V;
    float* ws = (float*)(lds + WS_OFF) + wid * 64; float* li_l = ws, * al_l = ws + 32;
    const float* etab = (const float*)(lds + ETAB_OFF); const int wodd = wid & 1;
    const float c191 = __builtin_bit_cast(float, __builtin_amdgcn_readfirstlane(__builtin_bit_cast(int, etab[255])));
    float m_reg = -1e30f, l_reg = 0; f32x16 o[4] = {};
    const int sr = tid >> 4, sc = (tid & 15) * 8, vst0 = v_st(sr, sc), vst1 = v_st(32 + sr, sc), kws = KSWZ(sr, sc * 2);
    const int vb0 = (int)(uintptr_t)V_lds + v_rd_base(lane);
    const bf16_t* Kh = cur.K; const bf16_t* Vh = cur.V;
#define RESC(a) do { if (__any((a) < 1.f)) { if (hi == 0) al_l[r32] = (a); asm volatile("s_waitcnt lgkmcnt(0)" ::: "memory");              \
                     for (int d_ = 0; d_ < 4; ++d_) for (int r = 0; r < 16; ++r) o[d_][r] *= al_l[crow(r, hi)]; } } while (0)
#define KBASE(t) ((j_lo + (t)) * KVBLK)
#define DLT(t) (cw - (j_lo + (t)))
#define ACT(t) (DLT(t) >= 0 && DLT(t) <= 8)
    constexpr int NQL = 8;
#define SEAM_K0() do { VMWN(NQL); SWRITE_HK(0); SBAR(); } while (0)
    f32x16 pA0, pA1, pB0, pB1; float mnA, mnB, alA, alB; bf16x8 pa0, pa1, pa2, pa3;
    SWRITE_HV(0); SBAR();
    if (NT > 1) { SLOAD_H(Kh, Vh, KBASE(1)); }
    SBAR(); qkt<0>(pA0, pA1, K_lds, r32, hi, S.qr, ACT(0), DLT(0), etab, wodd, c191);
    partialSM(pA0, pA1, m_reg, mnA, alA);
    if (NT > 1) { VMW(); SWRITE_H(1); }
    __syncthreads();
#define HALF_STEP(PX0, PX1, mnX, alX, PY0, PY1, alY, t, KB, VB, SB) do {                                                      \
        SBAR(); qkt<KB>(PX0, PX1, K_lds, r32, hi, S.qr, ACT(t), DLT(t), etab, wodd, c191);                                             \
        finishSM(PY0, PY1, alY, l_reg, pa0, pa1, pa2, pa3); SBAR();                                                           \
        if ((t) + 1 < NT) { SLOAD_H(Kh, Vh, KBASE((t) + 1)); SBAR(); }                                                         \
        pv_tile<VB>(o, vb0, pa0, pa1, pa2, pa3, ACT((t) - 1)); partialSM(PX0, PX1, m_reg, mnX, alX);                           \
        __syncthreads();                                                                                                      \
        if ((t) + 1 < NT) { VMW(); SWRITE_H(SB); }                                                                            \
        RESC(alX); __syncthreads(); } while (0)
    for (int t = 1; t + 1 < NT; t += 2) {
        HALF_STEP(pB0, pB1, mnB, alB, pA0, pA1, alA, t, 1, 0, 0);
        HALF_STEP(pA0, pA1, mnA, alA, pB0, pB1, alB, t + 1, 0, 1, 1);
    }
    const bool even = (NT & 1) == 0;
    if (even) { SBAR(); qkt<1>(pB0, pB1, K_lds, r32, hi, S.qr, ACT(NT - 1), DLT(NT - 1), etab, wodd, c191); SBAR(); }
    SLOAD_H(nxt.K, nxt.V, kbn); SBAR();
#pragma unroll
    for (int d0 = 0; d0 < 8; ++d0) S.qr[d0] = load8(nxt.Q + (size_t)(wid * QBLK + r32) * D + d0 * 16 + hi * 8);
    SBAR();
    finishSM(pA0, pA1, alA, l_reg, pa0, pa1, pa2, pa3); SBAR();
    pv_tile<0>(o, vb0, pa0, pa1, pa2, pa3, ACT(even ? NT - 2 : NT - 1));
    if (even) { partialSM(pB0, pB1, m_reg, mnB, alB); __syncthreads(); RESC(alB);
        finishSM(pB0, pB1, alB, l_reg, pa0, pa1, pa2, pa3); SBAR(); pv_tile<1>(o, vb0, pa0, pa1, pa2, pa3, ACT(NT - 1)); }
    SBAR(); SEAM_K0();
    if (nxt.rel != cur.rel) etab_write(lds, nxt.rel, tid);
    if (hi == 0) li_l[r32] = l_reg; asm volatile("s_waitcnt lgkmcnt(0)" ::: "memory");
    float rli[16];
#pragma unroll
    for (int r = 0; r < 16; ++r) rli[r] = __builtin_amdgcn_rcpf(li_l[crow(r, hi)]);
    if constexpr (FP8_O != 0) {
        unsigned char* Ow8 = (unsigned char*)cur.O + (size_t)(wid * QBLK) * DM;
#pragma unroll
        for (int r = 0; r < 16; ++r) { const int orow = crow(r, hi);
#pragma unroll
            for (int d0 = 0; d0 < 4; ++d0) { const float v = o[d0][r] * (rli[r] * SO8);
                const float v1 = __builtin_bit_cast(float, __builtin_amdgcn_mov_dpp(__builtin_bit_cast(int, v), 0x39, 0xF, 0xF, true));
                const float v2 = __builtin_bit_cast(float, __builtin_amdgcn_mov_dpp(__builtin_bit_cast(int, v), 0x4E, 0xF, 0xF, true));
                const float v3 = __builtin_bit_cast(float, __builtin_amdgcn_mov_dpp(__builtin_bit_cast(int, v), 0x93, 0xF, 0xF, true));
                if ((r32 & 3) == 0) *(unsigned*)(Ow8 + (size_t)orow * DM + d0 * 32 + r32) = pk4_fp8(v, v1, v2, v3); } }
    } else {
    bf16_t* Ow = cur.O + (size_t)(wid * QBLK) * DM;
#pragma unroll
    for (int r = 0; r < 16; ++r) { const int orow = crow(r, hi);
#pragma unroll
        for (int d0 = 0; d0 < 4; ++d0) { const float v = o[d0][r] * rli[r];
            const float vn = xor1_get(v);
            if ((r32 & 1) == 0) *(unsigned*)(Ow + (size_t)orow * DM + d0 * 32 + r32) = cvtpk(v, vn); } }
    }
    __syncthreads();
#undef RESC
#undef KBASE
#undef DLT
#undef ACT
#undef SEAM_K0
#undef HALF_STEP
}
#undef ROW
#undef VMW
#undef VMWN
#undef SLOAD_H
#undef SWRITE_HK
#undef SWRITE_HV
#undef SWRITE_H
}

#define XB_TMO      128
#define XB_XCNT(j)  (256  + 64 * (j))
#define XB_XSUB(j)  (1280 + 64 * (j))
#define XB_XGEN(j)  (2304 + 64 * (j))
#define XB_TOP      3328
#define XB_TOPGEN   3392
#define XCD_BAR_WORDS 3456
#define XB_SPIN_CAP (1u << 18)
__device__ __forceinline__ unsigned xb_ld(unsigned* p)              { return __hip_atomic_load(p, __ATOMIC_RELAXED, __HIP_MEMORY_SCOPE_AGENT); }
__device__ __forceinline__ unsigned xb_add(unsigned* p, unsigned v) { return __hip_atomic_fetch_add(p, v, __ATOMIC_RELAXED, __HIP_MEMORY_SCOPE_AGENT); }
__device__ __forceinline__ unsigned xb_xcc_id() { return (unsigned)__builtin_amdgcn_s_getreg((3 << 11) | 20) & 0xFu; }
#define XB_SPIN(cond, bar) do { unsigned _sp = 0; while (cond) { __builtin_amdgcn_s_sleep(1); \
    if ((++_sp & 255u) == 0u) { if (xb_ld(&(bar)[XB_TMO])) break; if (_sp > XB_SPIN_CAP) { atomicAdd(&(bar)[XB_TMO], 1u); break; } } } } while (0)
struct XcdBarrier { unsigned* bar; unsigned x; volatile LAS unsigned* st; };
__device__ __forceinline__ XcdBarrier xcd_barrier_post(unsigned* bar, volatile LAS unsigned* st, int tid0) {
    XcdBarrier b; b.bar = bar; b.x = xb_xcc_id(); b.st = st;
    if (tid0 == 0) (void)xb_add(&bar[XB_XCNT(b.x)], 1u);
    return b;
}
__device__ __forceinline__ void xcd_barrier_complete(unsigned* bar, unsigned x, unsigned& nloc, unsigned& nx) {
    const unsigned G = gridDim.x * gridDim.y * gridDim.z;
    unsigned sum, cnt, mine, sp = 0u;
    for (;;) {
        sum = 0u; cnt = 0u; mine = 0u;
#pragma unroll
        for (unsigned j = 0; j < 16; ++j) { const unsigned c = xb_ld(&bar[XB_XCNT(j)]); sum += c; cnt += (c > 0u) ? 1u : 0u; mine = (j == x) ? c : mine; }
        if (sum == G) break;
        __builtin_amdgcn_s_sleep(1);
        if ((++sp & 255u) == 0u) { if (xb_ld(&bar[XB_TMO])) break; if (sp > XB_SPIN_CAP) { atomicAdd(&bar[XB_TMO], 1u); break; } }
    }
    nloc = mine > 0u ? mine : 1u; nx = cnt > 0u ? cnt : 1u;
}
__device__ __forceinline__ void xcd_barrier(const XcdBarrier& b, int wave) {
    asm volatile("s_waitcnt vmcnt(0)" ::: "memory");
    __syncthreads();
    if (wave == 0 && lane_now() == 0) {
        unsigned* bar = b.bar;
        __builtin_amdgcn_s_waitcnt(0);
        unsigned nloc = b.st[0], nx = b.st[1];
        if (nloc == 0u) { xcd_barrier_complete(bar, b.x, nloc, nx); b.st[0] = nloc; b.st[1] = nx; }
        const unsigned old = xb_add(&bar[XB_XSUB(b.x)], 1u);
        const unsigned gen = old / nloc;
        if (old + 1u == (gen + 1u) * nloc) {
            __builtin_amdgcn_fence(__ATOMIC_RELEASE, "agent");
            asm volatile("s_waitcnt vmcnt(0)" ::: "memory");
            const unsigned og = xb_add(&bar[XB_TOP], 1u);
            const unsigned tg = og / nx;
            if (og + 1u == (tg + 1u) * nx) xb_add(&bar[XB_TOPGEN], 1u);
            else XB_SPIN(xb_ld(&bar[XB_TOPGEN]) == tg, bar);
            __builtin_amdgcn_fence(__ATOMIC_ACQUIRE, "agent");
            xb_add(&bar[XB_XGEN(b.x)], 1u);
            asm volatile("s_waitcnt vmcnt(0)" ::: "memory");
        } else {
            XB_SPIN(xb_ld(&bar[XB_XGEN(b.x)]) == gen, bar);
            __builtin_amdgcn_fence(__ATOMIC_ACQUIRE, "agent");
            asm volatile("s_waitcnt vmcnt(0)" ::: "memory");
        }
    }
    __syncthreads();
}

struct Frame {
    LAS unsigned char* lds;
    volatile LAS unsigned* MISC;
    gu32* ctl;
    int wave;
    int vcu, G;
};
struct Args { const float* in[20]; float* out; unsigned char* ws; int ph_lo, ph_hi; };
__device__ __forceinline__ const void* ldptr(LAS unsigned char* lds, int i) {
    volatile LAS unsigned* p = (volatile LAS unsigned*)(lds + LDSCTL_OFF) + 2 * i;
    const unsigned lo = __builtin_amdgcn_readfirstlane(p[0]), hi = __builtin_amdgcn_readfirstlane(p[1]);
    const GAS void* q = (const GAS void*)(((unsigned long long)hi << 32) | lo);
    return (const void*)q;
}
#define IN_PTR(i) ((const float*)ldptr(F.lds, (i)))
#define OUT_PTR() ((float*)ldptr(F.lds, 20))
#define WS_PTR() ((unsigned char*)ldptr(F.lds, 21))

struct TItem { const float* src; const float* gain; bf16_t* dst; int ldw, ldt; unsigned char* dst8; float sc8; };
constexpr int I_GU = (DM / 64) * (DFF / 32);
constexpr int I_D = (DFF / 64) * (DM / 32);
constexpr int I_FFN = 2 * I_GU + I_D;
constexpr int I_P = (512 / 64) * (512 / 32);
constexpr int I_S = (DM / 64) * (DM / 32);
constexpr int N_SMALL = 8 * I_P + 6 * I_S;
__device__ __forceinline__ TItem dec_ffn(Frame& F, int set, int r) {
    TItem t; const int l = set >> 1, f = set & 1; unsigned char* ws = WS_PTR();
    if (r < 2 * I_GU) { const int up = r >= I_GU, item = r - up * I_GU, nnb = DFF / 32, kb = item / nnb, nb = item - kb * nnb, n0 = nb * 32, k0 = kb * 64;
        t.src = IN_PTR((f ? 7 : 2) + up) + (size_t)l * DM * DFF + (size_t)k0 * DFF + n0; t.gain = IN_PTR(f ? 6 : 1) + (size_t)l * DM + k0;
        t.dst = (bf16_t*)(ws + WS_WGU + (size_t)set * SZ_WGU) + (size_t)(256 * (n0 >> 7) + (n0 & 127) + up * 128) * DM + k0; t.ldw = DFF; t.ldt = DM; t.dst8 = nullptr; t.sc8 = 1.f;
        if (use8(set)) { t.dst8 = (ws + WS_WGU + (size_t)set * SZ_WGU) + (size_t)(256 * (n0 >> 7) + (n0 & 127) + up * 128) * DM + k0; t.sc8 = SWGU8; } }
    else { const int item = r - 2 * I_GU, nnb = DM / 32, kb = item / nnb, nb = item - kb * nnb, n0 = nb * 32, k0 = kb * 64;
        t.src = IN_PTR(f ? 9 : 4) + (size_t)l * DFF * DM + (size_t)k0 * DM + n0; t.gain = nullptr;
        t.dst = (bf16_t*)(ws + WS_WD + (size_t)set * SZ_WD) + (size_t)n0 * DFF + k0; t.ldw = DM; t.ldt = DFF; t.dst8 = nullptr; t.sc8 = 1.f;
        if (use8d(set)) { t.dst8 = (ws + WS_WD + (size_t)set * SZ_WD) + (size_t)n0 * DFF8 + k0; t.ldt = DFF8; t.sc8 = SWD8; } }
    return t;
}
__device__ __forceinline__ TItem dec_small(Frame& F, int r) {
    TItem t; unsigned char* ws = WS_PTR();
    if (r < 8 * I_P) { const int q = r / I_P, item = r - q * I_P, l = q >> 2, g = q & 3, kb = item >> 4, nb = item & 15, n0 = nb * 32, k0 = kb * 64;
        t.src = IN_PTR(10) + (size_t)q * 512 * 512 + (size_t)k0 * 512 + n0; t.gain = IN_PTR(5) + (size_t)l * DM + g * 512 + k0;
        t.dst = (bf16_t*)(ws + WS_WPOOL + (size_t)l * SZ_WPOOL) + (size_t)g * 512 * 512 + (size_t)n0 * 512 + k0; t.ldw = 512; t.ldt = 512; t.dst8 = nullptr; t.sc8 = 1.f; }
    else { const int rr = r - 8 * I_P, q = rr / I_S, item = rr - q * I_S, kb = item >> 6, nb = item & 63, n0 = nb * 32, k0 = kb * 64; const float* W; const float* gn; bf16_t* WT;
        if (q == 0) { W = IN_PTR(13); gn = IN_PTR(12); WT = (bf16_t*)(ws + WS_WKV); }
        else if (q == 1) { W = IN_PTR(14); gn = IN_PTR(12); WT = (bf16_t*)(ws + WS_WKV) + (size_t)DM * DM; }
        else if (q < 4) { W = IN_PTR(16) + (size_t)(q - 2) * DM * DM; gn = IN_PTR(5) + (size_t)(NPOOL + q - 2) * DM; WT = (bf16_t*)(ws + WS_WQ) + (size_t)(q - 2) * DM * DM; }
        else { W = IN_PTR(19) + (size_t)(q - 4) * DM * DM; gn = nullptr; WT = (bf16_t*)(ws + WS_WO) + (size_t)(q - 4) * DM * DM; }
        t.src = W + (size_t)k0 * DM + n0; t.gain = gn ? gn + k0 : nullptr; t.dst = WT + (size_t)n0 * DM + k0; t.ldw = DM; t.ldt = DM; t.dst8 = nullptr; t.sc8 = 1.f;
        if (FP8_O && q >= 4) { t.dst8 = (unsigned char*)WT + (size_t)n0 * DM + k0; t.sc8 = SWGU8; }
        if (FP8_QKV && q < 4) { t.dst8 = (q == 1 ? ws + WS_WKV + (size_t)DM * DM : (unsigned char*)WT) + (size_t)n0 * DM + k0; t.sc8 = SWGU8; } }
    return t;
}
template <bool GAIN>
__device__ __forceinline__ void titem_load(const TItem& t, float (&v)[32], f32x4& g0, f32x4& g1, int lane) {
    if constexpr (GAIN) { g0 = *(const f32x4*)(t.gain + 8 * (lane & 7)); g1 = *(const f32x4*)(t.gain + 8 * (lane & 7) + 4); }
    const float* p = t.src + (size_t)(lane >> 5) * t.ldw + (lane & 31);
#pragma unroll
    for (int i = 0; i < 32; ++i) v[i] = __builtin_nontemporal_load(p + (size_t)(2 * i) * t.ldw);
}
template <bool GAIN>
__device__ __forceinline__ void titem_store(const TItem& t, const float (&v)[32], const f32x4& g0, const f32x4& g1, LAS float* scr, int lane) {
    const int c = lane & 7;
#pragma unroll
    for (int i = 0; i < 32; ++i) scr[(2 * i + (lane >> 5)) * 33 + (lane & 31)] = v[i];
    LDS_WAIT(); asm volatile("" ::: "memory");
#pragma unroll
    for (int j = 0; j < 4; ++j) { const int n = (lane >> 3) + 8 * j; const LAS float* s = scr + (8 * c) * 33 + n;
        float e[8];
#pragma unroll
        for (int q = 0; q < 8; ++q) e[q] = s[q * 33];
        if constexpr (GAIN) { e[0] *= g0[0]; e[1] *= g0[1]; e[2] *= g0[2]; e[3] *= g0[3]; e[4] *= g1[0]; e[5] *= g1[1]; e[6] *= g1[2]; e[7] *= g1[3]; }
        if ((FP8_SETS != 0 || FP8_QKV || FP8_O) && t.dst8) { u32x2 o8; o8.x = pk4_fp8(e[0] * t.sc8, e[1] * t.sc8, e[2] * t.sc8, e[3] * t.sc8); o8.y = pk4_fp8(e[4] * t.sc8, e[5] * t.sc8, e[6] * t.sc8, e[7] * t.sc8);
            *(GAS u32x2*)(t.dst8 + (size_t)n * t.ldt + 8 * c) = o8; }
        else { u32x4 o; o.x = cvt_pk_bf16(e[0], e[1]); o.y = cvt_pk_bf16(e[2], e[3]); o.z = cvt_pk_bf16(e[4], e[5]); o.w = cvt_pk_bf16(e[6], e[7]);
            *(GAS u32x4*)(t.dst + (size_t)n * t.ldt + 8 * c) = o; } }
    LDS_WAIT(); asm volatile("" ::: "memory");
}
template <bool SMALL, bool GAIN>
__device__ __forceinline__ void convert_items(Frame& F, int set, int first, int end, int stride) {
    LAS float* scr = (LAS float*)(F.lds + RING_OFF + F.wave * 16384);
    const int lane = lane_now();
    int it = first; if (it >= end) return;
    const float z_ = __builtin_bit_cast(float, opaque_s(0));
    float va[32], vb[32]; f32x4 ga0 = {z_, z_, z_, z_}, ga1 = ga0, gb0 = ga0, gb1 = ga0;
    TItem ta = SMALL ? dec_small(F, it) : dec_ffn(F, set, it);
    titem_load<GAIN>(ta, va, ga0, ga1, lane);
    for (;;) {
        const int nxt = it + stride; const bool more = nxt < end;
        const TItem tb = SMALL ? dec_small(F, more ? nxt : it) : dec_ffn(F, set, more ? nxt : it);
        titem_load<GAIN>(tb, vb, gb0, gb1, lane);
        titem_store<GAIN>(ta, va, ga0, ga1, scr, lane);
        if (!more) break;
        ta = tb; ga0 = gb0; ga1 = gb1;
#pragma unroll
        for (int i = 0; i < 32; ++i) va[i] = vb[i];
        it = nxt;
    }
}
constexpr int N_SMALL_G = 8 * I_P + 4 * I_S;
__device__ __forceinline__ void convert_ffn_gu(Frame& F, int set, int worker, int nworkers) {
    convert_items<false, true>(F, set, worker, 2 * I_GU, nworkers);
}
__device__ __forceinline__ void convert_ffn_down(Frame& F, int set, int worker, int nworkers) {
    convert_items<false, false>(F, set, 2 * I_GU + worker, I_FFN, nworkers);
    if (use8d(set)) {
        unsigned char* wd8 = WS_PTR() + WS_WD + (size_t)set * SZ_WD; const int lane = lane_now(); const unsigned z0 = (unsigned)opaque_s(0);
        for (int r = worker; r < DM; r += nworkers) if (lane < (DFF8 - DFF) / 16) *(GAS u32x4*)(wd8 + (size_t)r * DFF8 + DFF + lane * 16) = (u32x4){z0, z0, z0, z0};
    }
}
__device__ __forceinline__ void p0_prologue(Frame& F) {
    const int lane = lane_now();
    const int gw = F.vcu * NWAVES + F.wave, NGW = F.G * NWAVES;
    unsigned char* ws = WS_PTR();
    convert_ffn_gu(F, 0, gw, NGW);
    convert_items<true, true>(F, 0, gw, N_SMALL_G, NGW);
    convert_items<true, false>(F, 0, N_SMALL_G + gw, N_SMALL, NGW);
    const float* x = IN_PTR(0); bf16_t* XB = (bf16_t*)(ws + WS_XB); float* SSQ = (float*)(ws + WS_SSQ);
    for (int m = gw; m < SEQ; m += NGW) {
        const GAS f32x4* xr = (const GAS f32x4*)(x + (size_t)m * DM) + lane;
        GAS u32x2* o8 = (GAS u32x2*)(XB + (size_t)m * DM) + lane;
        float s = 0.f;
#pragma unroll
        for (int j = 0; j < 8; ++j) { const f32x4 v = xr[64 * j]; s += (v[0] * v[0] + v[1] * v[1]) + (v[2] * v[2] + v[3] * v[3]);
            u32x2 w; w.x = pk2(v[0], v[1]); w.y = pk2(v[2], v[3]); o8[64 * j] = w; }
        s = wave_sum(s, lane);
        if (lane < 32) SSQ[(size_t)m * 32 + lane] = lane == 0 ? s : 0.f;
        if ((FP8_SETS | FP8_D_SETS) != 0 && lane < (DFF8 - DFF) / 16) *(GAS u32x4*)(ws + WS_H8 + (size_t)m * DFF8 + DFF + lane * 16) = (u32x4){0u, 0u, 0u, 0u};
    }
}
__device__ __forceinline__ void tail_convert(Frame& F, const pg8::StaticOrder& S, int set) {
    const int rounds = (S.nwg + S.G - 1) / S.G, nfull = S.nwg - (rounds - 1) * S.G;
    int worker, nworkers;
    if (nfull >= S.G) { worker = S.c * NWAVES + F.wave; nworkers = S.G * NWAVES; }
    else { if (S.c < nfull) return; worker = (S.c - nfull) * NWAVES + F.wave; nworkers = (S.G - nfull) * NWAVES; }
    if (set + 1 < 2 * DEPTH) convert_ffn_gu(F, set + 1, worker, nworkers);
    convert_ffn_down(F, set, worker, nworkers);
}
__device__ __forceinline__ void prep_rstd(Frame& F, const pg8::StaticOrder& S, const float* ssq) {
    LAS float* tab = (LAS float*)(F.lds + RSTD_OFF);
    const int tid_ = F.wave * 64 + lane_now();
    const int row = tid_ >> 1, half = tid_ & 1;
    pg8::Unit u;
    int pm_prev = -1; float v_prev = 0.f;
#pragma unroll 1
    for (int i = 0; i < 8 && S.next(i, u); ++i) {
        if (u.pm != pm_prev) {
            const f32x4* p = (const f32x4*)(ssq + (size_t)(u.pm * 256 + row) * 32 + half * 16);
            const f32x4 a = p[0], b = p[1], c = p[2], d = p[3];
            float s = ((a[0] + a[1]) + (a[2] + a[3])) + ((b[0] + b[1]) + (b[2] + b[3])) + ((c[0] + c[1]) + (c[2] + c[3])) + ((d[0] + d[1]) + (d[2] + d[3]));
            s += xor1_get(s);
            v_prev = __builtin_amdgcn_rsqf(s * (1.0f / DM) + EPS); pm_prev = u.pm;
        }
        if (half == 0) tab[i * 256 + row] = v_prev;
    }
    LDS_WAIT(); __syncthreads();
}
__device__ __forceinline__ float half_sum(float v) {
    v += __builtin_bit_cast(float, __builtin_amdgcn_ds_swizzle(__builtin_bit_cast(int, v), 0x041F));
    v += __builtin_bit_cast(float, __builtin_amdgcn_ds_swizzle(__builtin_bit_cast(int, v), 0x081F));
    v += __builtin_bit_cast(float, __builtin_amdgcn_ds_swizzle(__builtin_bit_cast(int, v), 0x101F));
    v += __builtin_bit_cast(float, __builtin_amdgcn_ds_swizzle(__builtin_bit_cast(int, v), 0x201F));
    return xor16_add(v);
}
template <int W>
__device__ __forceinline__ void pool_diff_block(Frame& F, const bf16_t* x, const float* ssq, bf16_t* diff, int t0, int tid_) {
    LAS float* rt = (LAS float*)(F.lds + RING_OFF);
    const int c4 = tid_ * 4, rr = tid_ >> 5, part = tid_ & 31;
    float pv[3];
#pragma unroll
    for (int j = 0; j < 3; ++j) { const int r = t0 - 16 + rr + 16 * j; pv[j] = ssq[(size_t)(r < 0 ? 0 : r) * 32 + part]; }
    u32x2 xr[31 + W];
#pragma unroll
    for (int i = 0; i < 31 + W; ++i) { const int sr = t0 - W + 1 + i; xr[i] = *(const u32x2*)(x + (size_t)(sr < 0 ? 0 : sr) * DM + c4); }
#pragma unroll
    for (int j = 0; j < 3; ++j) { const int r = t0 - 16 + rr + 16 * j; const float sm = half_sum(pv[j]);
        if (part == 0) rt[rr + 16 * j] = r >= 0 ? __builtin_amdgcn_rsqf(sm * (1.0f / DM) + EPS) : 0.f; }
    LDS_WAIT(); __syncthreads();
    const float z_ = __builtin_bit_cast(float, opaque_s(0));
    f32x4 sum = {z_, z_, z_, z_};
#pragma unroll
    for (int i = 0; i < W - 1; ++i) sum += pg8::bf4_lo(xr[i].x, xr[i].y) * rt[17 - W + i];
    const bool head = t0 == 0;
#pragma unroll
    for (int t = 0; t < 32; ++t) {
        const f32x4 a = pg8::bf4_lo(xr[W - 1 + t].x, xr[W - 1 + t].y) * rt[16 + t];
        sum += a;
        const float inv = __builtin_bit_cast(float, opaque_s(__builtin_bit_cast(int, (t + 1 < W && head) ? 1.0f / (float)(t + 1) : 1.0f / (float)W)));
        const f32x4 o = sum * inv - a;
        u32x2 pk; pk.x = pk2(o[0], o[1]); pk.y = pk2(o[2], o[3]);
        *(u32x2*)(diff + (size_t)(t0 + t) * DM + c4) = pk;
        sum -= pg8::bf4_lo(xr[t].x, xr[t].y) * rt[17 - W + t];
    }
    __syncthreads();
}
__device__ __forceinline__ void pool_diff_phase(Frame& F, const bf16_t* x, const float* ssq, bf16_t* diff) {
    const int lane = lane_now(), tid_ = F.wave * 64 + lane;
    const int g = F.wave >> 1;
    const int vcu_ = opaque_s(F.vcu), G_ = opaque_s(F.G);
    for (int blk = vcu_; blk < SEQ / 32; blk += G_) {
        const int t0 = blk * 32;
        if (g == 0) pool_diff_block<2>(F, x, ssq, diff, t0, tid_);
        else if (g == 1) pool_diff_block<4>(F, x, ssq, diff, t0, tid_);
        else if (g == 2) pool_diff_block<8>(F, x, ssq, diff, t0, tid_);
        else pool_diff_block<16>(F, x, ssq, diff, t0, tid_);
    }
}
__device__ __forceinline__ att::BlockRef attn_ref(int l, const bf16_t* QH, const bf16_t* KH, const bf16_t* VH, bf16_t* AO, const float* rel) {
    att::BlockRef r; const int h = l >> 5, qb = l & 31;
    r.Q = QH + ((size_t)h * SEQ + (size_t)qb * att::QB) * HD; r.K = KH + (size_t)h * SEQ * HD; r.V = VH + (size_t)h * SEQ * HD;
    r.O = FP8_O ? (bf16_t*)((unsigned char*)AO + (size_t)qb * att::QB * DM + h * HD) : AO + (size_t)qb * att::QB * DM + h * HD; r.rel = rel + h * NREL; r.P0 = qb * att::QB; return r;
}
__device__ __forceinline__ void attn_phase(Frame& F, char* lds, const bf16_t* QH, const bf16_t* KH, const bf16_t* VH, bf16_t* AO, const float* rel) {
    const int total = NH * (SEQ / att::QB);
    const int G_ = opaque_s(F.G);
    int L = opaque_s(F.vcu); if (L >= total) return;
    att::BlockRef cur = attn_ref(L, QH, KH, VH, AO, rel);
    att::Seam S;
    att::attn_prime(cur, lds, S, F.wave);
    for (;;) {
        const bool more = L + G_ < total;
        const att::BlockRef nxt = more ? attn_ref(L + G_, QH, KH, VH, AO, rel) : cur;
        att::attn_block(cur, nxt, lds, S, F.wave);
        if (!more) break;
        cur = nxt; L += G_;
    }
}

__global__ void __launch_bounds__(NWAVES * 64, 2) fwd_kernel(Args args) {
    extern __shared__ __attribute__((aligned(16))) unsigned char lds[];
    Frame F;
    F.lds = (LAS unsigned char*)lds;
    F.MISC = (volatile LAS unsigned*)(F.lds + MISC_OFF);
    const int tid0 = threadIdx.x; F.wave = __builtin_amdgcn_readfirstlane(tid0 >> 6);
    F.G = gridDim.x; { const int bx = blockIdx.x; F.vcu = (F.G % 8 == 0) ? (bx % 8) * (F.G / 8) + bx / 8 : bx; }
    if (tid0 < 32) ((LAS unsigned*)(F.lds + MISC_OFF))[tid0] = 0u;
    if (tid0 >= 64 && tid0 < 64 + 44) {
        const __attribute__((address_space(4))) unsigned* ka = (const __attribute__((address_space(4))) unsigned*)__builtin_amdgcn_kernarg_segment_ptr();
        ((LAS unsigned*)(F.lds + LDSCTL_OFF))[tid0 - 64] = ka[tid0 - 64]; }
    __syncthreads();
    F.ctl = (gu32*)(WS_PTR() + WS_CTL);
#if MK_PER_PHASE
#define GRID_BAR() do { } while (0)
#else
    XcdBarrier bar = xcd_barrier_post((unsigned*)(F.ctl + CW_BAR), F.MISC + 8, tid0);
#define GRID_BAR() xcd_barrier(bar, F.wave)
#endif
    const int lo = args.ph_lo, hi = args.ph_hi;
    int pi = 0;
#define PHASE_BEGIN if (pi >= lo && pi < hi) {
#define PHASE_END   if (pi + 1 < hi) GRID_BAR(); } ++pi;
#define WSP(off) (WS_PTR() + (off))

    PHASE_BEGIN if (PH_ON(0)) DUP_LOOP(0) { p0_prologue(F); DUP_BAR(0) } PHASE_END

#define LAYER_BODY(K8, KD8, F0, F1, WITH_KV) \
        for (int f = F0; f < F1; ++f) { \
            PHASE_BEGIN if (PH_ON(1)) DUP_LOOP(1) { \
                pg8::StaticOrder S; S.init(SEQ, NGU, opaque_s(F.G), opaque_s((int)blockIdx.x)); \
                prep_rstd(F, S, (const float*)WSP(WS_SSQ)); \
                if constexpr (K8) { \
                    pg8::Gemm g{(const bf16_t*)WSP(WS_XB8), (const bf16_t*)WSP(WS_WGU + (size_t)(l * 2 + f) * SZ_WGU), DM / 2, DM / 2, DM / 2}; \
                    pg8::EpiSwiGLU E{nullptr, (unsigned char*)WSP(WS_H8), 1.0f / (SX8 * SWGU8)}; \
                    pg8::gemm_phase<pg8::EpiSwiGLU, pg8::PlainTiles, true>(F.lds + RING_OFF, F.wave, g, S, pg8::PlainTiles{}, E); \
                } else { \
                    pg8::Gemm g{(const bf16_t*)WSP(WS_XB), (const bf16_t*)WSP(WS_WGU + (size_t)(l * 2 + f) * SZ_WGU), DM, DM, DM}; \
                    pg8::EpiSwiGLU E{KD8 ? nullptr : (bf16_t*)WSP(WS_HB), KD8 ? (unsigned char*)WSP(WS_H8) : nullptr, 1.0f}; \
                    pg8::gemm_phase(F.lds + RING_OFF, F.wave, g, S, pg8::PlainTiles{}, E); \
                } \
                tail_convert(F, S, l * 2 + f); \
                DUP_BAR(1) \
            } PHASE_END \
            PHASE_BEGIN if (PH_ON(2)) DUP3_LOOP(2) { \
                pg8::StaticOrder S; S.init(SEQ, DM, opaque_s(F.G), opaque_s((int)blockIdx.x)); \
                const bool first = (l == 0 && f == 0 && rep_ == 0), lastp = (l == DEPTH - 1 && f == 1); \
                bf16_t* XB = (bf16_t*)WSP(WS_XB); \
                unsigned char* nx8 = ((f == 1 && l + 1 < DEPTH && use8((l + 1) * 2)) || (FP8_QKV && ((l == NPOOL - 1 && f == 1) || (l >= NPOOL && f == 0)))) ? (unsigned char*)WSP(WS_XB8) : nullptr; \
                if constexpr (K8 || KD8) { \
                    pg8::Gemm g{(const bf16_t*)WSP(WS_H8), (const bf16_t*)WSP(WS_WD + (size_t)(l * 2 + f) * SZ_WD), DFF8 / 2, DFF8 / 2, DFF8 / 2}; \
                    pg8::EpiRes E{first ? nullptr : (const bf16_t*)XB, first ? IN_PTR(0) : nullptr, XB, lastp ? OUT_PTR() : nullptr, (float*)WSP(WS_SSQ), nullptr, 0.5f * DUP3_SIGN / (SH8 * SWD8), nx8}; \
                    pg8::gemm_phase<pg8::EpiRes, pg8::PlainTiles, true>(F.lds + RING_OFF, F.wave, g, S, pg8::PlainTiles{}, E); \
                } else { \
                    pg8::Gemm g{(const bf16_t*)WSP(WS_HB), (const bf16_t*)WSP(WS_WD + (size_t)(l * 2 + f) * SZ_WD), DFF, DFF, DFF}; \
                    pg8::EpiRes E{first ? nullptr : (const bf16_t*)XB, first ? IN_PTR(0) : nullptr, XB, lastp ? OUT_PTR() : nullptr, (float*)WSP(WS_SSQ), nullptr, 0.5f * DUP3_SIGN, nx8}; \
                    pg8::gemm_phase(F.lds + RING_OFF, F.wave, g, S, pg8::PlainTiles{}, E); \
                } \
                DUP3_BAR(2) \
            } PHASE_END \
            if (f == 0) { \
                if (l < NPOOL) { \
                    PHASE_BEGIN if (PH_ON(3)) DUP_LOOP(3) { pool_diff_phase(F, (const bf16_t*)WSP(WS_XB), (const float*)WSP(WS_SSQ), (bf16_t*)WSP(WS_T1)); DUP_BAR(3) } PHASE_END \
                    PHASE_BEGIN if (PH_ON(4)) DUP3_LOOP(4) { \
                        pg8::StaticOrder S; S.init(SEQ, DM, opaque_s(F.G), opaque_s((int)blockIdx.x)); \
                        pg8::Gemm g{(const bf16_t*)WSP(WS_T1), (const bf16_t*)WSP(WS_WPOOL + (size_t)l * SZ_WPOOL), DM, 512, 512}; \
                        bf16_t* XB = (bf16_t*)WSP(WS_XB); \
                        pg8::EpiRes E{XB, nullptr, XB, nullptr, (float*)WSP(WS_SSQ), IN_PTR(11) + (size_t)l * DM, DUP3_SIGN, use8(l * 2 + 1) ? (unsigned char*)WSP(WS_XB8) : nullptr}; \
                        pg8::gemm_phase(F.lds + RING_OFF, F.wave, g, S, pg8::PoolTiles{}, E); \
                        DUP3_BAR(4) \
                    } PHASE_END \
                } else { \
                    const int b = l - NPOOL; \
                    PHASE_BEGIN if (PH_ON(5)) DUP_LOOP(5) { \
                        pg8::StaticOrder S; S.init(SEQ, DM, opaque_s(F.G), opaque_s((int)blockIdx.x)); \
                        prep_rstd(F, S, (const float*)WSP(WS_SSQ)); \
                        bf16_t* QH = (bf16_t*)WSP(WS_QH); \
                        if constexpr (FP8_QKV != 0) { \
                            pg8::Gemm g{(const bf16_t*)WSP(WS_XB8), (const bf16_t*)WSP(WS_WQ) + (size_t)b * DM * DM, DM / 2, DM / 2, DM / 2}; \
                            pg8::EpiHead E{QH, QH, IN_PTR(17) + (size_t)b * HD, 8, 1.0f / (SX8 * SWGU8)}; \
                            pg8::gemm_phase<pg8::EpiHead, pg8::PlainTiles, true>(F.lds + RING_OFF, F.wave, g, S, pg8::PlainTiles{}, E); \
                        } else { \
                            pg8::Gemm g{(const bf16_t*)WSP(WS_XB), (const bf16_t*)WSP(WS_WQ) + (size_t)b * DM * DM, DM, DM, DM}; \
                            pg8::EpiHead E{QH, QH, IN_PTR(17) + (size_t)b * HD, 8, 1.0f}; \
                            pg8::gemm_phase(F.lds + RING_OFF, F.wave, g, S, pg8::PlainTiles{}, E); \
                        } \
                        DUP_BAR(5) \
                    } PHASE_END \
                    PHASE_BEGIN if (PH_ON(6)) DUP_LOOP(6) { attn_phase(F, (char*)lds + RING_OFF, (const bf16_t*)WSP(WS_QH), (const bf16_t*)WSP(WS_KH), (const bf16_t*)WSP(WS_VH), (bf16_t*)WSP(WS_T1), IN_PTR(18) + (size_t)b * NH * NREL); DUP_BAR(6) } PHASE_END \
                    PHASE_BEGIN if (PH_ON(7)) DUP3_LOOP(7) { \
                        pg8::StaticOrder S; S.init(SEQ, DM, opaque_s(F.G), opaque_s((int)blockIdx.x)); \
                        bf16_t* XB = (bf16_t*)WSP(WS_XB); \
                        if constexpr (FP8_O != 0) { \
                            pg8::Gemm g{(const bf16_t*)WSP(WS_T1), (const bf16_t*)WSP(WS_WO) + (size_t)b * DM * DM, DM / 2, DM / 2, DM / 2}; \
                            pg8::EpiRes E{XB, nullptr, XB, nullptr, (float*)WSP(WS_SSQ), nullptr, DUP3_SIGN / (SO8 * SWGU8), use8(l * 2 + 1) ? (unsigned char*)WSP(WS_XB8) : nullptr}; \
                            pg8::gemm_phase<pg8::EpiRes, pg8::PlainTiles, true>(F.lds + RING_OFF, F.wave, g, S, pg8::PlainTiles{}, E); \
                        } else { \
                            pg8::Gemm g{(const bf16_t*)WSP(WS_T1), (const bf16_t*)WSP(WS_WO) + (size_t)b * DM * DM, DM, DM, DM}; \
                            pg8::EpiRes E{XB, nullptr, XB, nullptr, (float*)WSP(WS_SSQ), nullptr, DUP3_SIGN, use8(l * 2 + 1) ? (unsigned char*)WSP(WS_XB8) : nullptr}; \
                            pg8::gemm_phase(F.lds + RING_OFF, F.wave, g, S, pg8::PlainTiles{}, E); \
                        } \
                        DUP3_BAR(7) \
                    } PHASE_END \
                } \
            } \
        } \
        if (WITH_KV && l == NPOOL - 1) { \
            PHASE_BEGIN if (PH_ON(8)) DUP_LOOP(8) { \
                pg8::StaticOrder S; S.init(SEQ, 2 * DM, opaque_s(F.G), opaque_s((int)blockIdx.x)); \
                prep_rstd(F, S, (const float*)WSP(WS_SSQ)); \
                if constexpr (FP8_QKV != 0) { \
                    pg8::Gemm g{(const bf16_t*)WSP(WS_XB8), (const bf16_t*)WSP(WS_WKV), DM / 2, DM / 2, DM / 2}; \
                    pg8::EpiHead E{(bf16_t*)WSP(WS_KH), (bf16_t*)WSP(WS_VH), IN_PTR(15), 8, 1.0f / (SX8 * SWGU8)}; \
                    pg8::gemm_phase<pg8::EpiHead, pg8::PlainTiles, true>(F.lds + RING_OFF, F.wave, g, S, pg8::PlainTiles{}, E); \
                } else { \
                    pg8::Gemm g{(const bf16_t*)WSP(WS_XB), (const bf16_t*)WSP(WS_WKV), DM, DM, DM}; \
                    pg8::EpiHead E{(bf16_t*)WSP(WS_KH), (bf16_t*)WSP(WS_VH), IN_PTR(15), 8, 1.0f}; \
                    pg8::gemm_phase(F.lds + RING_OFF, F.wave, g, S, pg8::PlainTiles{}, E); \
                } \
                DUP_BAR(8) \
            } PHASE_END \
        }
#if FP8_D_SETS
    static_assert(FP8_FIRST_LAYER == DEPTH, "FP8-down of the last half-step: the layers' FFNs are otherwise bf16");
#if FP8_D_SETS == 0xC0
    for (int l = 0; l < DEPTH - 1; ++l) {
        LAYER_BODY(false, false, 0, 2, true)
    }
    {   const int l = opaque_s(DEPTH - 1);
        LAYER_BODY(false, true, 0, 2, false)
    }
#else
    for (int l = 0; l < DEPTH; ++l) {
        LAYER_BODY(false, false, 0, (l == DEPTH - 1 ? 1 : 2), true)
    }
    {   const int l = opaque_s(DEPTH - 1);
        LAYER_BODY(false, true, 1, 2, false)
    }
#endif
#else
    for (int l = 0; l < FP8_FIRST_LAYER; ++l) {
        LAYER_BODY(false, false, 0, 2, true)
    }
    for (int l = FP8_FIRST_LAYER; l < DEPTH; ++l) {
        LAYER_BODY(true, false, 0, 2, true)
    }
#endif
#undef LAYER_BODY
#undef PHASE_BEGIN
#undef PHASE_END
}
constexpr int N_PHASES = 1 + 2 * 6 + 1 + 2 * 7;


#ifndef MK_DEBUG
#define MK_DEBUG 0
#endif
#if MK_DEBUG
constexpr size_t WS_XOLD = WS_END, WS_RES = WS_END + (size_t)SEQ * DM * 4;
struct ChkArgs { const float* in[20]; float* out; unsigned char* ws; int phase, kind, l, f; };
__device__ __forceinline__ float bf2f(bf16_t b) { return __uint_as_float(((unsigned)b) << 16); }
__device__ __forceinline__ float bfr(float x) { return __uint_as_float(f2bf(x) << 16); }
__device__ __forceinline__ unsigned hash32(unsigned x) { x ^= x >> 16; x *= 0x7feb352du; x ^= x >> 15; x *= 0x846ca68bu; x ^= x >> 16; return x; }
__device__ __forceinline__ float wsum(float v) { for (int o = 32; o >= 1; o >>= 1) v += __shfl_xor(v, o); return v; }
__device__ __forceinline__ float row_rstd_b(const bf16_t* XBp, int row, int lane) { float s = 0.f; for (int k = lane; k < DM; k += 64) { const float v = bf2f(XBp[(size_t)row * DM + k]); s += v * v; } s = wsum(s); return 1.0f / sqrtf(s / DM + EPS); }
__device__ __forceinline__ float row_rstd(const float* X, int row, int lane) { float s = 0.f; for (int k = lane; k < DM; k += 64) { const float v = X[(size_t)row * DM + k]; s += v * v; } s = wsum(s); return 1.0f / sqrtf(s / DM + EPS); }
__device__ __forceinline__ void rec(unsigned* res, int phase, float got, float ref, float floor_) { float e = fabsf(got - ref) / (fabsf(ref) + floor_); if (!(e == e)) e = 1e30f; atomicMax(res + phase, __float_as_uint(e)); }
__device__ void chk_ffn_set(const ChkArgs& a, unsigned* res, int slot, int set, unsigned t) {
    unsigned char* ws = a.ws; const int ll = set >> 1, ff = set & 1;
    { const int up = t & 1; const int n = hash32(t + 1) % DFF, k = hash32(t + 2) % DM;
      const float w = a.in[(ff ? 7 : 2) + up][(size_t)ll * DM * DFF + (size_t)k * DFF + n] * a.in[ff ? 6 : 1][ll * DM + k];
      const bf16_t g = ((const bf16_t*)(ws + WS_WGU + (size_t)set * SZ_WGU))[(size_t)(256 * (n >> 7) + (n & 127) + up * 128) * DM + k]; rec(res, slot, bf2f(g), bfr(w), 1e-3f); }
    { const int n = hash32(t + 3) % DM, k = hash32(t + 4) % DFF;
      const float w = a.in[ff ? 9 : 4][(size_t)ll * DFF * DM + (size_t)k * DM + n];
      const bf16_t g = ((const bf16_t*)(ws + WS_WD + (size_t)set * SZ_WD))[(size_t)n * DFF + k]; rec(res, slot, bf2f(g), bfr(w), 1e-3f); }
}
__global__ void chk_kernel(ChkArgs a) {
    const int lane = threadIdx.x & 63, gw = blockIdx.x * (blockDim.x >> 6) + (threadIdx.x >> 6);
    unsigned char* ws = a.ws; unsigned* res = (unsigned*)(ws + WS_RES);
    const bf16_t* XOLD = (const bf16_t*)(ws + WS_XOLD);
    const bf16_t* XB = (const bf16_t*)(ws + WS_XB); const bf16_t* HB = (const bf16_t*)(ws + WS_HB); const bf16_t* T1 = (const bf16_t*)(ws + WS_T1);
    const float* SSQ = (const float*)(ws + WS_SSQ);
    const unsigned h0 = hash32(gw * 7919u + a.phase * 104729u + 17u);
    const int l = a.l, f = a.f;
    if (a.kind == 0) {
        const unsigned t = hash32(h0 + lane * 31u);
        chk_ffn_set(a, res, 28, 0, t); chk_ffn_set(a, res, 29, 0, hash32(t + 99));
        { const int q = t % 8, ll = q >> 2, gg = q & 3; const int d = hash32(t + 5) % 512, c = hash32(t + 6) % 512;
          const float w = a.in[10][(size_t)q * 512 * 512 + (size_t)c * 512 + d] * a.in[5][ll * DM + gg * 512 + c];
          const bf16_t g = ((const bf16_t*)(ws + WS_WPOOL + (size_t)ll * SZ_WPOOL))[(size_t)gg * 512 * 512 + (size_t)d * 512 + c]; rec(res, 30, bf2f(g), bfr(w), 1e-3f); }
        { const int q = t % 6; const int n = hash32(t + 7) % DM, k = hash32(t + 8) % DM; float w; bf16_t g;
          if (q == 0) { w = a.in[13][(size_t)k * DM + n] * a.in[12][k]; g = ((const bf16_t*)(ws + WS_WKV))[(size_t)n * DM + k]; }
          else if (q == 1) { w = a.in[14][(size_t)k * DM + n] * a.in[12][k]; g = ((const bf16_t*)(ws + WS_WKV))[(size_t)(DM + n) * DM + k]; }
          else if (q < 4) { w = a.in[16][(size_t)(q - 2) * DM * DM + (size_t)k * DM + n] * a.in[5][(NPOOL + q - 2) * DM + k]; g = ((const bf16_t*)(ws + WS_WQ))[(size_t)(q - 2) * DM * DM + (size_t)n * DM + k]; }
          else { w = a.in[19][(size_t)(q - 4) * DM * DM + (size_t)k * DM + n]; g = ((const bf16_t*)(ws + WS_WO))[(size_t)(q - 4) * DM * DM + (size_t)n * DM + k]; }
          rec(res, 31, bf2f(g), bfr(w), 1e-3f); }
        { const int row = h0 % SEQ; float s = 0.f, sq = 0.f; for (int k = lane; k < DM; k += 64) { const float v = a.in[0][(size_t)row * DM + k]; sq += v * v; rec(res, 32, bf2f(XB[(size_t)row * DM + k]), bfr(v), 1e-3f); }
          sq = wsum(sq); s = lane < 32 ? SSQ[(size_t)row * 32 + lane] : 0.f; s = wsum(s); if (lane == 0) rec(res, 33, s, sq, 1e-3f); }
        return;
    }
    const bool firstD = (l == 0 && f == 0);
    if (a.kind == 1) {
        const int row = h0 % SEQ, col = hash32(h0 + 1) % DFF; const float rs = firstD ? row_rstd(a.in[0], row, lane) : row_rstd_b(XB, row, lane);
        const bf16_t* W = (const bf16_t*)(ws + WS_WGU + (size_t)(l * 2 + f) * SZ_WGU); const size_t rg = (size_t)(256 * (col >> 7) + (col & 127)) * DM, ru = rg + (size_t)128 * DM;
        float g = 0.f, u = 0.f; for (int k = lane; k < DM; k += 64) { const float xv = bf2f(XB[(size_t)row * DM + k]); g += xv * bf2f(W[rg + k]); u += xv * bf2f(W[ru + k]); }
        g = wsum(g) * rs; u = wsum(u) * rs; const float hh = g / (1.f + expf(-g)) * u;
        if (lane == 0) rec(res, a.phase, bf2f(HB[(size_t)row * DFF + col]), hh, 0.05f);
        if (l * 2 + f + 1 < 2 * DEPTH) chk_ffn_set(a, res, a.phase, l * 2 + f + 1, hash32(h0 + lane * 31u));
        return;
    }
    if (a.kind == 2 || a.kind == 7 || a.kind == 4) {
        const int row = h0 % SEQ, col = hash32(h0 + 1) % DM; float s = 0.f; float mul;
        if (a.kind == 2) { const bf16_t* W = (const bf16_t*)(ws + WS_WD + (size_t)(l * 2 + f) * SZ_WD); for (int k = lane; k < DFF; k += 64) s += bf2f(HB[(size_t)row * DFF + k]) * bf2f(W[(size_t)col * DFF + k]); mul = 0.5f; }
        else if (a.kind == 7) { const bf16_t* W = (const bf16_t*)(ws + WS_WO) + (size_t)(l - NPOOL) * DM * DM; for (int k = lane; k < DM; k += 64) s += bf2f(T1[(size_t)row * DM + k]) * bf2f(W[(size_t)col * DM + k]); mul = 1.0f; }
        else { const int gg = col >> 9, d = col & 511; const bf16_t* W = (const bf16_t*)(ws + WS_WPOOL + (size_t)l * SZ_WPOOL) + (size_t)gg * 512 * 512; for (int c = lane; c < 512; c += 64) s += bf2f(T1[(size_t)row * DM + gg * 512 + c]) * bf2f(W[(size_t)d * 512 + c]); mul = a.in[11][l * DM + col]; }
        s = wsum(s); const float bv = (a.kind == 2 && firstD) ? a.in[0][(size_t)row * DM + col] : bf2f(XOLD[(size_t)row * DM + col]); const float ref = bv + mul * s;
        if (lane == 0) { rec(res, a.phase, bf2f(XB[(size_t)row * DM + col]), bfr(ref), 0.05f); if (a.phase == N_PHASES - 1) rec(res, a.phase, a.out[(size_t)row * DM + col], ref, 0.05f); }
        float sq = 0.f; for (int k = lane; k < DM; k += 64) { const float v = bf2f(XB[(size_t)row * DM + k]); sq += v * v; } sq = wsum(sq);
        float sp = lane < 32 ? SSQ[(size_t)row * 32 + lane] : 0.f; sp = wsum(sp); if (lane == 0) rec(res, a.phase, sp, sq, 1e-3f);
        return;
    }
    if (a.kind == 3) {
        const int t = (gw & 1) ? (h0 % 40) : (h0 % SEQ), c = hash32(h0 + 1) % DM, w = 2 << (c >> 9); float sum = 0.f, self = 0.f;
        for (int s = t - w + 1; s <= t; ++s) if (s >= 0) { const float rs = row_rstd_b(XB, s, lane); const float z = bf2f(XB[(size_t)s * DM + c]) * rs; sum += z; if (s == t) self = z; }
        const int cnt = (t + 1 < w) ? t + 1 : w; if (lane == 0) rec(res, a.phase, bf2f(T1[(size_t)t * DM + c]), sum / cnt - self, 0.02f);
        return;
    }
    if (a.kind == 5 || a.kind == 8) {
        const int row = h0 % SEQ, hh = hash32(h0 + 1) % NH, which = (a.kind == 8) ? (int)(hash32(h0 + 2) & 1) : 0;
        const float rs = row_rstd_b(XB, row, lane);
        const bf16_t* W = (a.kind == 5) ? (const bf16_t*)(ws + WS_WQ) + (size_t)(l - NPOOL) * DM * DM : (const bf16_t*)(ws + WS_WKV) + (size_t)which * DM * DM;
        const float* gain = (a.kind == 5) ? a.in[17] + (l - NPOOL) * HD : a.in[15];
        const bf16_t* O = (const bf16_t*)(ws + (a.kind == 5 ? WS_QH : (which ? WS_VH : WS_KH)));
        float v0 = 0.f, v1 = 0.f;
        for (int k = 0; k < DM; ++k) { const float xv = bf2f(XB[(size_t)row * DM + k]); v0 += xv * bf2f(W[(size_t)(hh * HD + lane) * DM + k]); v1 += xv * bf2f(W[(size_t)(hh * HD + lane + 64) * DM + k]); }
        v0 *= rs; v1 *= rs;
        if (!(a.kind == 8 && which == 1)) { const float ss = wsum(v0 * v0 + v1 * v1); const float rn = 1.0f / sqrtf(ss / HD + EPS); v0 *= rn * gain[lane]; v1 *= rn * gain[lane + 64]; }
        rec(res, a.phase, bf2f(O[((size_t)hh * SEQ + row) * HD + lane]), v0, 0.05f); rec(res, a.phase, bf2f(O[((size_t)hh * SEQ + row) * HD + lane + 64]), v1, 0.05f);
        return;
    }
    if (a.kind == 6) {
        const int row = (gw & 1) ? (h0 % 700) : (h0 % SEQ), hh = hash32(h0 + 1) % NH, c = row >> 6, k0 = (c - 8) * 64 > 0 ? (c - 8) * 64 : 0, k1 = (c + 1) * 64;
        const bf16_t* Q = (const bf16_t*)(ws + WS_QH) + ((size_t)hh * SEQ + row) * HD; const bf16_t* K = (const bf16_t*)(ws + WS_KH) + (size_t)hh * SEQ * HD; const bf16_t* V = (const bf16_t*)(ws + WS_VH) + (size_t)hh * SEQ * HD;
        const float* rel = a.in[18] + ((size_t)(l - NPOOL) * NH + hh) * NREL;
        float sc[9]; float mx = -1e30f;
        for (int j = 0; j < 9; ++j) { const int k = k0 + lane + 64 * j; sc[j] = -1e30f; if (k < k1) { float d = 0.f; for (int e = 0; e < HD; ++e) d += bf2f(Q[e]) * bf2f(K[(size_t)k * HD + e]);
            int r = row - k; r = r < -63 ? -63 : (r > 128 ? 128 : r); sc[j] = d * 0.08838834764831845f + rel[r + 63]; mx = fmaxf(mx, sc[j]); } }
        for (int o = 32; o >= 1; o >>= 1) mx = fmaxf(mx, __shfl_xor(mx, o));
        float den = 0.f; for (int j = 0; j < 9; ++j) { sc[j] = (sc[j] > -1e29f) ? expf(sc[j] - mx) : 0.f; den += sc[j]; } den = wsum(den);
        float o0 = 0.f, o1 = 0.f;
        for (int j = 0; j < 9; ++j) for (int src = 0; src < 64; ++src) { const float p = __shfl(sc[j], src); const int k = k0 + src + 64 * j; if (k < k1) { o0 += p * bf2f(V[(size_t)k * HD + lane]); o1 += p * bf2f(V[(size_t)k * HD + lane + 64]); } }
        rec(res, a.phase, bf2f(T1[(size_t)row * DM + hh * HD + lane]), o0 / den, 0.05f); rec(res, a.phase, bf2f(T1[(size_t)row * DM + hh * HD + lane + 64]), o1 / den, 0.05f);
        return;
    }
}
__global__ void chk_final(unsigned char* ws, float* out, int nph) {
    const unsigned* res = (const unsigned*)(ws + WS_RES);
    if (threadIdx.x == 0 && blockIdx.x == 0) { for (int p = 28; p < 34; ++p) { const float e = __uint_as_float(res[p]); if (e > 0.06f) { out[0] = (float)(p + 1) * 1e6f; return; } }
        for (int p = 0; p < nph; ++p) { const float e = __uint_as_float(res[p]); const float tol = 0.06f; if (e > tol) { out[0] = (float)(p + 1) * 1e6f; break; } } }
}
#endif

extern "C" void kernel_launch(void* const* d_in, const int* in_sizes, int n_in, void* d_out, int out_size, void* d_ws, size_t ws_size, hipStream_t stream) {
    static int grid = 0;
    if (grid == 0) {
        if (n_in != 20 || in_sizes[0] != SEQ * DM || out_size != SEQ * DM || ws_size < WS_END + (DUPMASK ? 100 * MiB : 0)) {
            fprintf(stderr, "kernel_launch: unexpected shapes (n_in %d, in0 %d, out %d, ws %zu < %zu); nothing launched\n", n_in, n_in > 0 ? in_sizes[0] : -1, out_size, ws_size, (size_t)WS_END); grid = -1; return; }
        int dev = 0, cus = 0, per_cu = 0;
        if (hipGetDevice(&dev) != hipSuccess || hipDeviceGetAttribute(&cus, hipDeviceAttributeMultiprocessorCount, dev) != hipSuccess) { fprintf(stderr, "kernel_launch: device query failed\n"); grid = -1; return; }
        if (hipFuncSetAttribute((const void*)fwd_kernel, hipFuncAttributeMaxDynamicSharedMemorySize, LDS_BYTES) != hipSuccess) { fprintf(stderr, "kernel_launch: hipFuncSetAttribute failed\n"); grid = -1; return; }
        if (hipOccupancyMaxActiveBlocksPerMultiprocessor(&per_cu, (const void*)fwd_kernel, NWAVES * 64, LDS_BYTES) != hipSuccess || per_cu < 1)
            fprintf(stderr, "kernel_launch: note: occupancy query reports %d workgroups per CU\n", per_cu);
        (void)hipGetLastError();
        grid = cus;
    }
    if (grid < 0) return;
    if (hipMemsetAsync((char*)d_ws + WS_CTL, 0, CTL_ZERO_BYTES, stream) != hipSuccess) { fprintf(stderr, "kernel_launch: memset failed\n"); return; }
    Args a{};
    for (int i = 0; i < 20; ++i) a.in[i] = (const float*)d_in[i];
    a.out = (float*)d_out; a.ws = (unsigned char*)d_ws;
#if MK_DEBUG
    {
        int kinds[N_PHASES], ls[N_PHASES], fs[N_PHASES], n = 0;
        kinds[n] = 0; ls[n] = 0; fs[n] = 0; ++n;
        for (int l = 0; l < DEPTH; ++l) { for (int f = 0; f < 2; ++f) { kinds[n] = 1; ls[n] = l; fs[n] = f; ++n; kinds[n] = 2; ls[n] = l; fs[n] = f; ++n;
            if (f == 0) { if (l < NPOOL) { kinds[n] = 3; ls[n] = l; fs[n] = f; ++n; kinds[n] = 4; ls[n] = l; fs[n] = f; ++n; } else { kinds[n] = 5; ls[n] = l; fs[n] = f; ++n; kinds[n] = 6; ls[n] = l; fs[n] = f; ++n; kinds[n] = 7; ls[n] = l; fs[n] = f; ++n; } } }
            if (l == NPOOL - 1) { kinds[n] = 8; ls[n] = l; fs[n] = 1; ++n; } }
        if (ws_size < WS_RES + 4096) { fprintf(stderr, "debug build: workspace too small\n"); return; }
        hipMemsetAsync((char*)d_ws + WS_RES, 0, 4096, stream);
        for (int p = 0; p < N_PHASES; ++p) {
            if ((kinds[p] == 2 || kinds[p] == 4 || kinds[p] == 7) && !(kinds[p] == 2 && ls[p] == 0 && fs[p] == 0)) hipMemcpyAsync((char*)d_ws + WS_XOLD, (char*)d_ws + WS_XB, (size_t)SEQ * DM * 2, hipMemcpyDeviceToDevice, stream);
            a.ph_lo = p; a.ph_hi = p + 1; hipLaunchKernelGGL(fwd_kernel, dim3(grid), dim3(NWAVES * 64), LDS_BYTES, stream, a);
            ChkArgs c{}; for (int i = 0; i < 20; ++i) c.in[i] = (const float*)d_in[i]; c.out = (float*)d_out; c.ws = (unsigned char*)d_ws; c.phase = p; c.kind = kinds[p]; c.l = ls[p]; c.f = fs[p];
            hipLaunchKernelGGL(chk_kernel, dim3(256), dim3(256), 0, stream, c);
        }
        hipLaunchKernelGGL(chk_final, dim3(1), dim3(64), 0, stream, (unsigned char*)d_ws, (float*)d_out, (int)N_PHASES);
    }
#elif MK_PER_PHASE
    for (int p = 0; p < N_PHASES; ++p) { a.ph_lo = p; a.ph_hi = p + 1; hipLaunchKernelGGL(fwd_kernel, dim3(grid), dim3(NWAVES * 64), LDS_BYTES, stream, a); }
#else
    a.ph_lo = 0; a.ph_hi = N_PHASES;
    hipLaunchKernelGGL(fwd_kernel, dim3(grid), dim3(NWAVES * 64), LDS_BYTES, stream, a);
#endif
    const hipError_t le = hipPeekAtLastError();
    if (le != hipSuccess) fprintf(stderr, "kernel_launch: launch failed: %s\n", hipGetErrorName(le));
}
```
